# Optimizing an MI355X kernel written in HIP

```python
import math
import jax, jax.numpy as jnp
from jax import lax
import numpy as np

D_MODEL = 1024
BATCH = 8
SEQ = 4096
DEPTH = 2

A_HEADS = 4
A_HEAD_DIM = 64
A_WIDTH = A_HEADS * A_HEAD_DIM
IDX_HEADS = 4
IDX_DIM = 64
TOPK_MAX = 256
B_GROUPS = 4
B_WIDTH = 256
B_GROUP_DIM = B_WIDTH // B_GROUPS
CHUNK = 128
C_HEADS = 4
C_HEAD_DIM = 32
C_V_DIM = 2 * C_HEAD_DIM
C_WIDTH = C_HEADS * C_V_DIM
N_BRANCH = 3
D_FF = 4 * D_MODEL
Q_BLOCK = 128
EPS = 1e-6
NEG = -1e30

IN_SIZES = (
    A_WIDTH, A_WIDTH, A_WIDTH,
    IDX_HEADS * IDX_DIM, IDX_DIM, IDX_HEADS,
    2 * B_WIDTH,
    C_HEADS * 2 * C_HEAD_DIM,
    C_HEADS * 2 * C_HEAD_DIM,
    C_WIDTH,
    N_BRANCH * D_MODEL,
)
N_IN = sum(IN_SIZES)

kernel_name = "hybrid_dsa_gmlp_diffattn_gated"


def rms_norm(x, g):
    xf = x.astype(jnp.float32)
    y = xf * lax.rsqrt(jnp.mean(xf * xf, axis=-1, keepdims=True) + EPS)
    return (y * g.astype(jnp.float32)).astype(x.dtype)


def layer_norm(x, g, b):
    xf = x.astype(jnp.float32)
    mu = jnp.mean(xf, axis=-1, keepdims=True)
    xc = xf - mu
    y = xc * lax.rsqrt(jnp.mean(xc * xc, axis=-1, keepdims=True) + EPS)
    return (y * g.astype(jnp.float32) + b.astype(jnp.float32)).astype(x.dtype)


def split_cols(t):
    offs = np.cumsum(np.array(IN_SIZES))[:-1].tolist()
    return jnp.split(t, offs, axis=-1)


def dsa_attention(q, k, v, q_idx, k_idx, w_idx):
    bsz, seq = q.shape[0], q.shape[1]
    n_keys = seq
    top_k = min(TOPK_MAX, n_keys // 4)
    key_pos = jnp.arange(n_keys)
    idx_scale = IDX_DIM ** -0.5
    w_scale = IDX_HEADS ** -0.5
    attn_scale = A_HEAD_DIM ** -0.5

    def block(i):
        t0 = i * Q_BLOCK
        qb = lax.dynamic_slice_in_dim(q, t0, Q_BLOCK, axis=1)
        qib = lax.dynamic_slice_in_dim(q_idx, t0, Q_BLOCK, axis=1)
        wb = lax.dynamic_slice_in_dim(w_idx, t0, Q_BLOCK, axis=1)
        q_pos = t0 + jnp.arange(Q_BLOCK)
        causal = key_pos[None, :] <= q_pos[:, None]
        dots = jnp.einsum('bqhd,bsd->bqhs', qib, k_idx).astype(jnp.float32) * idx_scale
        score = jnp.einsum('bqh,bqhs->bqs', wb.astype(jnp.float32) * w_scale, jax.nn.relu(dots))
        score = jnp.where(causal[None], score, -jnp.inf)
        _, sel = lax.top_k(score, top_k)
        valid = sel <= q_pos[None, :, None]
        kg = jax.vmap(lambda kb, ib: kb[ib])(k, sel)
        vg = jax.vmap(lambda vb, ib: vb[ib])(v, sel)
        logits = jnp.einsum('bqhd,bqkhd->bqhk', qb, kg).astype(jnp.float32) * attn_scale
        logits = jnp.where(valid[:, :, None, :], logits, NEG)
        p = jax.nn.softmax(logits, axis=-1).astype(v.dtype)
        return jnp.einsum('bqhk,bqkhd->bqhd', p, vg)

    out = lax.map(block, jnp.arange(seq // Q_BLOCK))
    return out.transpose(1, 0, 2, 3, 4).reshape(bsz, seq, A_WIDTH)


def chunked_sgu(u, v, ln_g, ln_b, w_s, b_s):
    bsz, seq = u.shape[0], u.shape[1]
    vn = layer_norm(v, ln_g, ln_b)
    vc = vn.reshape(bsz, seq // CHUNK, CHUNK, B_GROUPS, B_GROUP_DIM)
    w_causal = w_s * jnp.tril(jnp.ones((CHUNK, CHUNK), w_s.dtype))
    s = jnp.einsum('gts,bcsgd->bctgd', w_causal, vc) + b_s.T[None, None, :, :, None]
    return u * s.reshape(bsz, seq, B_WIDTH)


def diff_attention(q, k, v, lam, lambda_init, subln_g):
    bsz, seq = q.shape[0], q.shape[1]
    key_pos = jnp.arange(seq)
    scale = C_HEAD_DIM ** -0.5

    def block(i):
        t0 = i * Q_BLOCK
        qb = lax.dynamic_slice_in_dim(q, t0, Q_BLOCK, axis=1)
        q_pos = t0 + jnp.arange(Q_BLOCK)
        causal = key_pos[None, :] <= q_pos[:, None]
        logits = jnp.einsum('bqhcd,bshcd->bhcqs', qb, k).astype(jnp.float32) * scale
        logits = jnp.where(causal[None, None, None], logits, NEG)
        p = jax.nn.softmax(logits, axis=-1)
        a = p[:, :, 0] - lam * p[:, :, 1]
        return jnp.einsum('bhqs,bshe->bqhe', a.astype(v.dtype), v)

    out = lax.map(block, jnp.arange(seq // Q_BLOCK))
    out = out.transpose(1, 0, 2, 3, 4).reshape(bsz, seq, C_HEADS, C_V_DIM)
    out = rms_norm(out, subln_g) * (1.0 - lambda_init)
    return out.reshape(bsz, seq, C_WIDTH)


def setup_inputs(seed: int = 0) -> dict:
    key = jax.random.key(seed)
    ks = jax.random.split(key, 20)
    f32 = jnp.float32

    def nrm(k, shape, scale):
        return jax.random.normal(k, shape, f32) * scale

    def gain(k, shape):
        return 1.0 + 0.01 * jax.random.normal(k, shape, f32)

    return {
        "x": nrm(ks[0], (BATCH, SEQ, D_MODEL), 1.0),
        "attn_norm_g": gain(ks[1], (DEPTH, D_MODEL)),
        "w_in": nrm(ks[2], (DEPTH, D_MODEL, N_IN), D_MODEL ** -0.5),
        "idx_k_norm_g": gain(ks[3], (DEPTH, IDX_DIM)),
        "idx_k_norm_b": nrm(ks[4], (DEPTH, IDX_DIM), 0.01),
        "sgu_norm_g": gain(ks[5], (DEPTH, B_WIDTH)),
        "sgu_norm_b": nrm(ks[6], (DEPTH, B_WIDTH), 0.01),
        "sgu_w_s": nrm(ks[7], (DEPTH, B_GROUPS, CHUNK, CHUNK), CHUNK ** -0.5),
        "sgu_b_s": gain(ks[8], (DEPTH, B_GROUPS, CHUNK)),
        "diff_lambda": nrm(ks[9], (DEPTH, 4, C_HEAD_DIM), 0.1),
        "diff_subln_g": gain(ks[10], (DEPTH, C_V_DIM)),
        "w_branch_a": nrm(ks[11], (DEPTH, A_WIDTH, D_MODEL), A_WIDTH ** -0.5),
        "w_branch_b": nrm(ks[12], (DEPTH, B_WIDTH, D_MODEL), B_WIDTH ** -0.5),
        "w_branch_c": nrm(ks[13], (DEPTH, C_WIDTH, D_MODEL), C_WIDTH ** -0.5),
        "w_out": nrm(ks[14], (DEPTH, D_MODEL, D_MODEL), D_MODEL ** -0.5),
        "mlp_norm_g": gain(ks[15], (DEPTH, D_MODEL)),
        "w_ff1": nrm(ks[16], (DEPTH, D_MODEL, D_FF), D_MODEL ** -0.5),
        "w_ff2": nrm(ks[17], (DEPTH, D_FF, D_MODEL), D_FF ** -0.5),
        "final_norm_g": gain(ks[18], (D_MODEL,)),
    }


def reference(x, attn_norm_g, w_in, idx_k_norm_g, idx_k_norm_b, sgu_norm_g, sgu_norm_b,
              sgu_w_s, sgu_b_s, diff_lambda, diff_subln_g, w_branch_a, w_branch_b,
              w_branch_c, w_out, mlp_norm_g, w_ff1, w_ff2, final_norm_g):
    bsz, seq = x.shape[0], x.shape[1]
    for l in range(DEPTH):
        lambda_init = 0.8 - 0.6 * math.exp(-0.3 * l)
        h = rms_norm(x, attn_norm_g[l])
        proj = h @ w_in[l]
        (a_q, a_k, a_v, i_q, i_k, i_w, b_uv, c_q, c_k, c_v, gates) = split_cols(proj)

        y_a = dsa_attention(
            a_q.reshape(bsz, seq, A_HEADS, A_HEAD_DIM),
            a_k.reshape(bsz, seq, A_HEADS, A_HEAD_DIM),
            a_v.reshape(bsz, seq, A_HEADS, A_HEAD_DIM),
            i_q.reshape(bsz, seq, IDX_HEADS, IDX_DIM),
            layer_norm(i_k, idx_k_norm_g[l], idx_k_norm_b[l]),
            i_w)

        b_act = jax.nn.gelu(b_uv)
        u, v = jnp.split(b_act, 2, axis=-1)
        y_b = chunked_sgu(u, v, sgu_norm_g[l], sgu_norm_b[l], sgu_w_s[l], sgu_b_s[l])

        lq = diff_lambda[l].astype(jnp.float32)
        lam = jnp.exp(jnp.sum(lq[0] * lq[1])) - jnp.exp(jnp.sum(lq[2] * lq[3])) + lambda_init
        y_c = diff_attention(
            c_q.reshape(bsz, seq, C_HEADS, 2, C_HEAD_DIM),
            c_k.reshape(bsz, seq, C_HEADS, 2, C_HEAD_DIM),
            c_v.reshape(bsz, seq, C_HEADS, C_V_DIM),
            lam, lambda_init, diff_subln_g[l])

        g = jax.nn.sigmoid(gates).reshape(bsz, seq, N_BRANCH, D_MODEL)
        merged = (g[:, :, 0] * (y_a @ w_branch_a[l])
                  + g[:, :, 1] * (y_b @ w_branch_b[l])
                  + g[:, :, 2] * (y_c @ w_branch_c[l]))
        x = x + merged @ w_out[l]

        h2 = rms_norm(x, mlp_norm_g[l])
        x = x + jnp.square(jax.nn.relu(h2 @ w_ff1[l])) @ w_ff2[l]
    return rms_norm(x, final_norm_g)
```

```cpp
#define STOP_AT 0
#include <hip/hip_runtime.h>
#include <hip/hip_bf16.h>
#include <cstdio>
#include <cstdint>
#include <cmath>
namespace pg8 {
#define PG8_LAS __attribute__((address_space(3)))
typedef unsigned short bf16_t;
typedef short bf16x8 __attribute__((ext_vector_type(8)));
typedef float f32x4 __attribute__((ext_vector_type(4)));
typedef unsigned u32x4 __attribute__((ext_vector_type(4)));
constexpr int BM = 256, BK = 64, HALF = 128, HTB = HALF * BK * 2  , STAGE_BYTES = 8 * HTB, NXCD = 8, WGM = 8;

__host__ __device__ __forceinline__ int lds_byte(int r, int c) { const int st = (r >> 4) * 2 + (c >> 5), rr = r & 15, cc = c & 31, ob = rr * 64 + cc * 2; return st * 1024 + (ob ^ (((ob >> 9) & 1) << 5)); }
__host__ __device__ __forceinline__ void stage_rc(int b, int& R, int& C) { const int st = b / 1024, sb = b % 1024, swz = sb ^ (((sb >> 9) & 1) << 5); R = (st >> 1) * 16 + swz / 64; C = (st & 1) * 32 + (swz % 64) / 2; }
__host__ __device__ __forceinline__ int perm32(int rho) { const int n = rho >> 4, i = rho & 15; return 8 * (i >> 2) + 4 * n + (i & 3); }

struct Unit { int pm, pn; };
struct Gemm { const bf16_t* A; const bf16_t* Bt; int M, N, K; };

struct StaticOrder {
    int nM, nN, nwg, G, c;
    __host__ __device__ void init(int M, int N, int G_, int c_) { nM = M / BM; nN = N / BM; nwg = nM * nN; G = G_; c = c_; }
    __host__ __device__ bool next(int i, Unit& u) const {
        const long L = (long)i * G + c; if (L >= nwg) return false;
        int wgid = (int)L; { const int q = nwg / NXCD, r = nwg % NXCD, xcd = wgid % NXCD, off = wgid / NXCD; wgid = (xcd < r ? xcd * (q + 1) : r * (q + 1) + (xcd - r) * q) + off; }
        const int nig = WGM * nN, gid = wgid / nig, fm = gid * WGM, gsz = (nM - fm) < WGM ? (nM - fm) : WGM;
        u.pm = fm + ((wgid % nig) % gsz); u.pn = (wgid % nig) / gsz; return true;
    }
    __device__ __forceinline__ void a_ready(const Unit&) const {}
    __device__ __forceinline__ void done(const Unit&) const {}
};

__device__ __forceinline__ unsigned cvt_pk_bf16(float lo, float hi) { unsigned r; asm volatile("v_cvt_pk_bf16_f32 %0, %1, %2" : "=v"(r) : "v"(lo), "v"(hi)); return r; }
typedef float f32x2 __attribute__((ext_vector_type(2)));
__device__ __forceinline__ f32x2 gelu_pk(f32x2 v) {
    const f32x2 av = __builtin_elementwise_abs(v), d = av * 0.2316418882f + 1.0f;
    f32x2 t; t.x = __builtin_amdgcn_rcpf(d.x); t.y = __builtin_amdgcn_rcpf(d.y);
    f32x2 q = t * 0.5307027145f + (-0.7265760135f); q = q * t + 0.7107068705f; q = q * t + (-0.142248368f); q = q * t + 0.127414796f; q = q * t;
    const f32x2 s = (v * v) * (-0.72134752044f);
    f32x2 e; e.x = __builtin_amdgcn_exp2f(s.x); e.y = __builtin_amdgcn_exp2f(s.y);
    const f32x2 m = v * (q * e), r = v - m;
    f32x2 o; o.x = v.x < 0.f ? m.x : r.x; o.y = v.y < 0.f ? m.y : r.y; return o;
}

template <int ACT  > struct EpiBf16 {
    static constexpr bool PERM = true, AFTER_DRAIN = false; static_assert(ACT == 0 || ACT == 1, "EpiBf16: ACT is 0 (none) or 1 (gelu_pk)");
    bf16_t* O; int ldc; const float* bias; int split_cols; size_t split_stride; float scale0;
    __device__ __forceinline__ void operator()(const f32x4 (&acc)[2][2][4][2], const Unit& u, int wr, int wc, int fr, int fq) const {
        const int row0 = u.pm * BM + wr * 64 + fr; int colt = u.pn * BM; bf16_t* base = O;
        float sc = 1.f; if (split_cols) { const int t = colt / split_cols; base += (size_t)t * split_stride; colt -= t * split_cols; if (t == 0) sc = scale0; }
        const int col0 = colt + wc * 32 + 8 * fq, bcol0 = u.pn * BM + wc * 32 + 8 * fq;
        f32x4 bv[2][2];
#pragma unroll
        for (int bj = 0; bj < 2; ++bj)
#pragma unroll
            for (int n = 0; n < 2; ++n) bv[bj][n] = bias ? *(const f32x4*)(bias + bcol0 + bj * HALF + 4 * n) : (f32x4){0.f, 0.f, 0.f, 0.f};
#pragma unroll
        for (int ai = 0; ai < 2; ++ai)
#pragma unroll
            for (int m = 0; m < 4; ++m) { bf16_t* rowp = base + (size_t)(row0 + ai * HALF + m * 16) * ldc + col0;
#pragma unroll
                for (int bj = 0; bj < 2; ++bj) { f32x4 v0 = acc[ai][bj][m][0] + bv[bj][0], v1 = acc[ai][bj][m][1] + bv[bj][1];
                    if (ACT == 1) { f32x2 a = gelu_pk((f32x2){v0[0], v0[1]}), b = gelu_pk((f32x2){v0[2], v0[3]}), c = gelu_pk((f32x2){v1[0], v1[1]}), d = gelu_pk((f32x2){v1[2], v1[3]});
                        v0 = (f32x4){a.x, a.y, b.x, b.y}; v1 = (f32x4){c.x, c.y, d.x, d.y}; }
                    v0 = v0 * sc; v1 = v1 * sc; u32x4 w; w.x = cvt_pk_bf16(v0[0], v0[1]); w.y = cvt_pk_bf16(v0[2], v0[3]); w.z = cvt_pk_bf16(v1[0], v1[1]); w.w = cvt_pk_bf16(v1[2], v1[3]);
                    *(u32x4*)(rowp + bj * HALF) = w; } }
    }
};
typedef float f32x2c __attribute__((ext_vector_type(2))); typedef __bf16 bf16x2c __attribute__((ext_vector_type(2)));
__device__ __forceinline__ unsigned cvtc(float lo, float hi) { f32x2c v = {lo, hi}; bf16x2c b = __builtin_convertvector(v, bf16x2c); return __builtin_bit_cast(unsigned, b); }
__device__ __forceinline__ float bflo(unsigned w) { return __uint_as_float(w << 16); }
__device__ __forceinline__ float bfhi(unsigned w) { return __uint_as_float(w & 0xffff0000u); }
__device__ __forceinline__ float xsum16_32(float s) {
    s += __int_as_float(__builtin_amdgcn_ds_swizzle(__float_as_int(s), 0x401F));
    auto rr = __builtin_amdgcn_permlane32_swap(__float_as_uint(s), __float_as_uint(s), false, false); return __uint_as_float(rr[0]) + __uint_as_float(rr[1]); }
__device__ __forceinline__ float sigmoidf_fast(float v) { return __builtin_amdgcn_rcpf(1.0f + __builtin_amdgcn_exp2f(-1.4426950408889634f * v)); }

struct EpiProj {
    static constexpr bool PERM = true, AFTER_DRAIN = false;
    bf16_t* P; bf16_t* G; bf16_t* kidx; const float* kg; const float* kb;
    __device__ __forceinline__ void operator()(const f32x4 (&acc)[2][2][4][2], const Unit& u, int wr, int wc, int fr, int fq) const {
        const int row0 = u.pm * BM + wr * 64 + fr;
        if (u.pn < 8) {
            const int col0 = u.pn * BM + wc * 32 + 8 * fq;
#pragma unroll
            for (int ai = 0; ai < 2; ++ai)
#pragma unroll
                for (int m = 0; m < 4; ++m) { bf16_t* rowp = P + (size_t)(row0 + ai * HALF + m * 16) * 2048 + col0;
#pragma unroll
                    for (int bj = 0; bj < 2; ++bj) { const f32x4 v0 = acc[ai][bj][m][0], v1 = acc[ai][bj][m][1];
                        u32x4 w; w.x = cvtc(v0[0], v0[1]); w.y = cvtc(v0[2], v0[3]); w.z = cvtc(v1[0], v1[1]); w.w = cvtc(v1[2], v1[3]);
                        *(u32x4*)(rowp + bj * HALF) = w; } }
            if (u.pn == 3 && wc == 0) {
#pragma unroll
                for (int ai = 0; ai < 2; ++ai)
#pragma unroll
                    for (int m = 0; m < 4; ++m) {
                        float s = 0.f;
#pragma unroll
                        for (int bj = 0; bj < 2; ++bj)
#pragma unroll
                            for (int n = 0; n < 2; ++n) { const f32x4 x = acc[ai][bj][m][n]; s += (x[0] + x[1]) + (x[2] + x[3]); }
                        s = xsum16_32(s);
                        const float mu = s * (1.0f / 64.0f); float q = 0.f;
#pragma unroll
                        for (int bj = 0; bj < 2; ++bj)
#pragma unroll
                            for (int n = 0; n < 2; ++n) { const f32x4 d = acc[ai][bj][m][n] - mu; q += (d[0] * d[0] + d[1] * d[1]) + (d[2] * d[2] + d[3] * d[3]); }
                        q = xsum16_32(q);
                        const float rstd = 1.0f / sqrtf(q * (1.0f / 64.0f) + 1e-6f);
                        bf16_t* kp = kidx + (size_t)(row0 + ai * HALF + m * 16) * 64 + 8 * fq;
#pragma unroll
                        for (int bj = 0; bj < 2; ++bj) { const f32x4 g0 = *(const f32x4*)(kg + bj * 32 + 8 * fq), g1 = *(const f32x4*)(kg + bj * 32 + 8 * fq + 4), b0 = *(const f32x4*)(kb + bj * 32 + 8 * fq), b1 = *(const f32x4*)(kb + bj * 32 + 8 * fq + 4);
                            const f32x4 y0 = (acc[ai][bj][m][0] - mu) * rstd * g0 + b0, y1 = (acc[ai][bj][m][1] - mu) * rstd * g1 + b1;
                            u32x4 w; w.x = cvtc(y0[0], y0[1]); w.y = cvtc(y0[2], y0[3]); w.z = cvtc(y1[0], y1[1]); w.w = cvtc(y1[2], y1[3]);
                            *(u32x4*)(kp + bj * 32) = w; }
                        asm volatile("" ::: "memory");
                    }
            }
        } else {
            const int col0 = (u.pn - 8) * BM + wc * 32 + 8 * fq;
#pragma unroll
            for (int ai = 0; ai < 2; ++ai)
#pragma unroll
                for (int m = 0; m < 4; ++m) { bf16_t* rowp = G + (size_t)(row0 + ai * HALF + m * 16) * 3072 + col0;
#pragma unroll
                    for (int bj = 0; bj < 2; ++bj) { const f32x4 v0 = acc[ai][bj][m][0], v1 = acc[ai][bj][m][1];
                        u32x4 w; w.x = cvtc(sigmoidf_fast(v0[0]), sigmoidf_fast(v0[1])); w.y = cvtc(sigmoidf_fast(v0[2]), sigmoidf_fast(v0[3]));
                        w.z = cvtc(sigmoidf_fast(v1[0]), sigmoidf_fast(v1[1])); w.w = cvtc(sigmoidf_fast(v1[2]), sigmoidf_fast(v1[3]));
                        *(u32x4*)(rowp + bj * HALF) = w; } }
        }
    }
};
template <int ACT> struct EpiAct {
    static constexpr bool PERM = true, AFTER_DRAIN = false;
    bf16_t* O; int ldc;
    __device__ __forceinline__ void operator()(const f32x4 (&acc)[2][2][4][2], const Unit& u, int wr, int wc, int fr, int fq) const {
        const int row0 = u.pm * BM + wr * 64 + fr; const int col0 = u.pn * BM + wc * 32 + 8 * fq;
#pragma unroll
        for (int ai = 0; ai < 2; ++ai)
#pragma unroll
            for (int m = 0; m < 4; ++m) { bf16_t* rowp = O + (size_t)(row0 + ai * HALF + m * 16) * ldc + col0;
#pragma unroll
                for (int bj = 0; bj < 2; ++bj) { f32x4 v0 = acc[ai][bj][m][0], v1 = acc[ai][bj][m][1];
                    if (ACT == 1) {
#pragma unroll
                        for (int e = 0; e < 4; ++e) { const float a = fmaxf(v0[e], 0.f), b = fmaxf(v1[e], 0.f); v0[e] = a * a; v1[e] = b * b; } }
                    u32x4 w; w.x = cvtc(v0[0], v0[1]); w.y = cvtc(v0[2], v0[3]); w.z = cvtc(v1[0], v1[1]); w.w = cvtc(v1[2], v1[3]);
                    *(u32x4*)(rowp + bj * HALF) = w; } }
    }
};
struct EpiGate {
    static constexpr bool PERM = true, AFTER_DRAIN = false;
    const bf16_t* G; int goff; const bf16_t* Mi; bf16_t* Mo;
    __device__ __forceinline__ void operator()(const f32x4 (&acc)[2][2][4][2], const Unit& u, int wr, int wc, int fr, int fq) const {
        const int row0 = u.pm * BM + wr * 64 + fr; const int col0 = u.pn * BM + wc * 32 + 8 * fq;
#pragma unroll
        for (int ai = 0; ai < 2; ++ai)
#pragma unroll
            for (int m = 0; m < 4; ++m) { const size_t r = (size_t)(row0 + ai * HALF + m * 16);
#pragma unroll
                for (int bj = 0; bj < 2; ++bj) { const f32x4 v0 = acc[ai][bj][m][0], v1 = acc[ai][bj][m][1];
                    const u32x4 g = *(const u32x4*)(G + r * 3072 + goff + col0 + bj * HALF);
                    float o[8] = {bflo(g.x) * v0[0], bfhi(g.x) * v0[1], bflo(g.y) * v0[2], bfhi(g.y) * v0[3], bflo(g.z) * v1[0], bfhi(g.z) * v1[1], bflo(g.w) * v1[2], bfhi(g.w) * v1[3]};
                    if (Mi) { const u32x4 p = *(const u32x4*)(Mi + r * 1024 + col0 + bj * HALF);
                        o[0] += bflo(p.x); o[1] += bfhi(p.x); o[2] += bflo(p.y); o[3] += bfhi(p.y); o[4] += bflo(p.z); o[5] += bfhi(p.z); o[6] += bflo(p.w); o[7] += bfhi(p.w); }
                    u32x4 w; w.x = cvtc(o[0], o[1]); w.y = cvtc(o[2], o[3]); w.z = cvtc(o[4], o[5]); w.w = cvtc(o[6], o[7]);
                    *(u32x4*)(Mo + r * 1024 + col0 + bj * HALF) = w; asm volatile("" ::: "memory"); } }
    }
};
struct EpiResid {
    static constexpr bool PERM = false, AFTER_DRAIN = false;
    const float* base; float* out;
    __device__ __forceinline__ void operator()(const f32x4 (&acc)[2][2][4][2], const Unit& u, int wr, int wc, int fr, int fq) const {
        const int col0 = u.pn * BM + wc * 32 + 4 * fq;
#pragma unroll
        for (int ai = 0; ai < 2; ++ai)
#pragma unroll
            for (int m = 0; m < 4; ++m) { const size_t off = (size_t)(u.pm * BM + ai * HALF + wr * 64 + m * 16 + fr) * 1024 + col0;
#pragma unroll
                for (int bj = 0; bj < 2; ++bj)
#pragma unroll
                    for (int n = 0; n < 2; ++n) { const f32x4 bs = *(const f32x4*)(base + off + bj * HALF + n * 16); *(f32x4*)(out + off + bj * HALF + n * 16) = bs + acc[ai][bj][m][n]; }
                if (m & 1) asm volatile("" ::: "memory"); }
    }
};
template <class Epi, class Sched, bool ALIGN_EPI = false, bool SP2 = false>
__device__ __forceinline__ void gemm_phase(PG8_LAS unsigned char* lds, const Gemm g, const Sched& S, const Epi& E) {
    int tid_ = threadIdx.x; asm volatile("" : "+v"(tid_));
    const int tid = tid_, wid = __builtin_amdgcn_readfirstlane(tid >> 6), lane = tid & 63, wr = wid >> 2, wc = wid & 3, fr = lane & 15, fq = lane >> 4;
    const int K = g.K, nt = K / BK;
    unsigned voffA[2], voffB[2];
#pragma unroll
    for (int i = 0; i < 2; ++i) { int R, C; stage_rc(tid * 16 + i * 8192, R, C); const int Rb = Epi::PERM ? ((R & ~31) + perm32(R & 31)) : R;
        voffA[i] = (unsigned)(R * K + C) * 2u; voffB[i] = (unsigned)(Rb * K + C) * 2u; }
    const size_t kstep = (size_t)(BK * 2);
    const size_t hstep = (size_t)HALF * K * 2;
    const size_t tstep = 2 * hstep;
    const unsigned ldsw = (unsigned)wid * 1024u;
    const int aoff = lds_byte(wr * 64 + fr, fq * 8), boff = lds_byte(wc * 32 + fr, fq * 8);
#define PG8_SA(b, h) (((b) * 2 + (h)) * HTB)
#define PG8_SB(b, h) ((4 + (b) * 2 + (h)) * HTB)
#define PG8_STAGE(bufoff, gbase, voff) do { _Pragma("unroll") for (int _i = 0; _i < 2; ++_i) \
        __builtin_amdgcn_global_load_lds((const unsigned*)((const char*)(gbase) + (voff)[_i]), (PG8_LAS unsigned*)(lds + (bufoff) + ldsw + _i * 8192), 16, 0, 0); } while (0)
#define PG8_LDA(dst, b, h) do { _Pragma("unroll") for (int m = 0; m < 4; ++m) _Pragma("unroll") for (int k = 0; k < 2; ++k) dst[m][k] = *(const PG8_LAS bf16x8*)(lds + PG8_SA(b, h) + aoff + m * 2048 + k * 1024); } while (0)
#define PG8_LDB(dst, b, h) do { _Pragma("unroll") for (int n = 0; n < 2; ++n) _Pragma("unroll") for (int k = 0; k < 2; ++k) dst[n][k] = *(const PG8_LAS bf16x8*)(lds + PG8_SB(b, h) + boff + n * 2048 + k * 1024); } while (0)
#define PG8_MMA(ai, bj, At, Bt) do { __builtin_amdgcn_s_setprio(1); _Pragma("unroll") for (int m = 0; m < 4; ++m) _Pragma("unroll") for (int n = 0; n < 2; ++n) _Pragma("unroll") for (int k = 0; k < 2; ++k) \
        acc[ai][bj][m][n] = __builtin_amdgcn_mfma_f32_16x16x32_bf16(Bt[n][k], At[m][k], acc[ai][bj][m][n], 0, 0, 0); __builtin_amdgcn_s_setprio(0); } while (0)
#define PG8_WAIT_V(n) asm volatile("s_waitcnt vmcnt(" #n ")" ::: "memory")
#define PG8_WAIT_L(n) asm volatile("s_waitcnt lgkmcnt(" #n ")" ::: "memory")
#define PG8_BAR __builtin_amdgcn_s_barrier()
#define PG8_SCHED __builtin_amdgcn_sched_barrier(0)
    Unit cur, nxt; int ui = 0;
    if (!S.next(0, cur)) return;
    f32x4 acc[2][2][4][2];
#pragma unroll
    for (int a = 0; a < 2; ++a)
#pragma unroll
        for (int b = 0; b < 2; ++b)
#pragma unroll
            for (int m = 0; m < 4; ++m)
#pragma unroll
                for (int n = 0; n < 2; ++n) acc[a][b][m][n] = (f32x4){0.f, 0.f, 0.f, 0.f};
    bf16x8 At[4][2], B0[2][2], B1[2][2];
    const char* cA = (const char*)g.A + (size_t)cur.pm * tstep; const char* cB = (const char*)g.Bt + (size_t)cur.pn * tstep;
    S.a_ready(cur);
    if constexpr (SP2) {
        PG8_STAGE(PG8_SB(0, 0), cB, voffB); PG8_STAGE(PG8_SB(0, 1), cB + hstep, voffB); PG8_STAGE(PG8_SA(0, 0), cA, voffA); PG8_STAGE(PG8_SA(0, 1), cA + hstep, voffA);
        if (wr == 1) PG8_BAR;
        PG8_WAIT_V(2); PG8_BAR;
        PG8_STAGE(PG8_SB(1, 0), cB + kstep, voffB); PG8_STAGE(PG8_SA(1, 0), cA + kstep, voffA); PG8_STAGE(PG8_SB(1, 1), cB + hstep + kstep, voffB);
        PG8_WAIT_V(6); PG8_BAR;
    } else {
        PG8_STAGE(PG8_SB(0, 0), cB, voffB); PG8_STAGE(PG8_SA(0, 0), cA, voffA); PG8_STAGE(PG8_SB(0, 1), cB + hstep, voffB); PG8_STAGE(PG8_SA(0, 1), cA + hstep, voffA);
        if (wr == 1) PG8_BAR;
        PG8_WAIT_V(4); PG8_BAR;
        PG8_STAGE(PG8_SB(1, 0), cB + kstep, voffB); PG8_STAGE(PG8_SA(1, 0), cA + kstep, voffA); PG8_STAGE(PG8_SB(1, 1), cB + hstep + kstep, voffB);
        PG8_WAIT_V(6); PG8_BAR;
    }
    for (;;) {
        const bool has_next = S.next(ui + 1, nxt);
        const char* nA = has_next ? (const char*)g.A + (size_t)nxt.pm * tstep : cA; const char* nB = has_next ? (const char*)g.Bt + (size_t)nxt.pn * tstep : cB;
        for (int t = 0; t < nt; t += 2) {
            const bool last = (t == nt - 2);
            const char* a1 = cA + (size_t)(t + 1) * kstep;
            const char* a2 = last ? nA : cA + (size_t)(t + 2) * kstep; const char* b2 = last ? nB : cB + (size_t)(t + 2) * kstep;
            const char* a3 = a2 + kstep; const char* b3 = b2 + kstep;
            if (last && has_next) S.a_ready(nxt);
            if constexpr (SP2) {
            PG8_LDB(B0, 0, 0); PG8_LDB(B1, 0, 1); PG8_SCHED; PG8_LDA(At, 0, 0); PG8_STAGE(PG8_SA(1, 1), a1 + hstep, voffA);
            PG8_WAIT_V(8); PG8_WAIT_L(0); PG8_BAR; PG8_MMA(0, 0, At, B0); PG8_MMA(0, 1, At, B1); PG8_BAR; PG8_SCHED;
            PG8_LDA(At, 0, 1); PG8_STAGE(PG8_SB(0, 0), b2, voffB); PG8_STAGE(PG8_SB(0, 1), b2 + hstep, voffB); PG8_STAGE(PG8_SA(0, 0), a2, voffA);
            PG8_WAIT_V(8); PG8_WAIT_L(0); PG8_BAR; PG8_MMA(1, 0, At, B0); PG8_MMA(1, 1, At, B1); PG8_BAR; PG8_SCHED;
            PG8_LDB(B0, 1, 0); PG8_LDB(B1, 1, 1); PG8_SCHED; PG8_LDA(At, 1, 0); PG8_STAGE(PG8_SA(0, 1), a2 + hstep, voffA);
            PG8_WAIT_V(8); PG8_WAIT_L(0); PG8_BAR; PG8_MMA(0, 0, At, B0); PG8_MMA(0, 1, At, B1); PG8_BAR; PG8_SCHED;
            PG8_LDA(At, 1, 1); PG8_STAGE(PG8_SB(1, 0), b3, voffB); PG8_STAGE(PG8_SB(1, 1), b3 + hstep, voffB); PG8_STAGE(PG8_SA(1, 0), a3, voffA);
            PG8_WAIT_V(8); PG8_WAIT_L(0); PG8_BAR; PG8_MMA(1, 0, At, B0); PG8_MMA(1, 1, At, B1); PG8_BAR; PG8_SCHED;
            } else {
            PG8_LDB(B0, 0, 0); PG8_SCHED; PG8_LDA(At, 0, 0); PG8_STAGE(PG8_SA(1, 1), a1 + hstep, voffA);
            PG8_WAIT_L(8); PG8_BAR; PG8_WAIT_L(0); PG8_MMA(0, 0, At, B0); PG8_BAR; PG8_SCHED;
            PG8_LDB(B1, 0, 1); PG8_STAGE(PG8_SB(0, 0), b2, voffB);
            PG8_BAR; PG8_WAIT_L(0); PG8_MMA(0, 1, At, B1); PG8_BAR;
            PG8_LDA(At, 0, 1); PG8_STAGE(PG8_SA(0, 0), a2, voffA);
            PG8_BAR; PG8_WAIT_L(0); PG8_MMA(1, 0, At, B0); PG8_BAR; PG8_SCHED;
            PG8_STAGE(PG8_SB(0, 1), b2 + hstep, voffB);
            PG8_WAIT_V(6); PG8_BAR; PG8_MMA(1, 1, At, B1); PG8_BAR;
            PG8_LDB(B0, 1, 0); PG8_SCHED; PG8_LDA(At, 1, 0); PG8_STAGE(PG8_SA(0, 1), a2 + hstep, voffA);
            PG8_WAIT_L(8); PG8_BAR; PG8_WAIT_L(0); PG8_MMA(0, 0, At, B0); PG8_BAR; PG8_SCHED;
            PG8_LDB(B1, 1, 1); PG8_STAGE(PG8_SB(1, 0), b3, voffB);
            PG8_BAR; PG8_WAIT_L(0); PG8_MMA(0, 1, At, B1); PG8_BAR;
            PG8_LDA(At, 1, 1); PG8_STAGE(PG8_SA(1, 0), a3, voffA);
            PG8_BAR; PG8_WAIT_L(0); PG8_MMA(1, 0, At, B0); PG8_BAR; PG8_SCHED;
            PG8_STAGE(PG8_SB(1, 1), b3 + hstep, voffB);
            PG8_WAIT_V(6); PG8_BAR; PG8_MMA(1, 1, At, B1); PG8_BAR;
            }
        }
        if constexpr (ALIGN_EPI) { if (wr == 0) PG8_BAR; }
        if constexpr (!Epi::AFTER_DRAIN) { E(acc, cur, wr, wc, fr, fq); S.done(cur); }
        if (!has_next) break;
#pragma unroll
        for (int a = 0; a < 2; ++a)
#pragma unroll
            for (int b = 0; b < 2; ++b)
#pragma unroll
                for (int m = 0; m < 4; ++m)
#pragma unroll
                    for (int n = 0; n < 2; ++n) acc[a][b][m][n] = (f32x4){0.f, 0.f, 0.f, 0.f};
        cur = nxt; cA = nA; cB = nB; ++ui;
        if constexpr (ALIGN_EPI) { if (wr == 1) PG8_BAR; }
    }
    PG8_WAIT_V(0);
    if constexpr (!ALIGN_EPI) { if (wr == 0) PG8_BAR; }
    PG8_BAR;
    if constexpr (Epi::AFTER_DRAIN) { E.fused(acc, cur, wr, wc, fr, fq, lds, wid, lane); S.done(cur); }
#undef PG8_SA
#undef PG8_SB
#undef PG8_STAGE
#undef PG8_LDA
#undef PG8_LDB
#undef PG8_MMA
#undef PG8_WAIT_V
#undef PG8_WAIT_L
#undef PG8_BAR
#undef PG8_SCHED
}
}
#define GAS __attribute__((address_space(1)))
#define LAS __attribute__((address_space(3)))
typedef unsigned short bf16;
typedef unsigned v4u __attribute__((ext_vector_type(4)));
typedef float f32x4 __attribute__((ext_vector_type(4)));
typedef short bf16x8 __attribute__((ext_vector_type(8)));
typedef GAS unsigned gu32;
typedef GAS unsigned long long gu64;
#define RLX_AGENT __ATOMIC_RELAXED, __HIP_MEMORY_SCOPE_AGENT
#define LDS_WAIT() asm volatile("s_waitcnt lgkmcnt(0)" ::: "memory")
#define VM_WAIT() asm volatile("s_waitcnt vmcnt(0)" ::: "memory")
__device__ __forceinline__ unsigned long long rt() { return __builtin_amdgcn_s_memrealtime(); }
__device__ __forceinline__ unsigned f2bf(float f) { unsigned u = __builtin_bit_cast(unsigned, f); return (u + 0x7fffu + ((u >> 16) & 1u)) >> 16; }
__device__ __forceinline__ unsigned pk2(float lo, float hi) { return f2bf(lo) | (f2bf(hi) << 16); }

#define XB_TMO      128
#define XB_XCNT(j)  (256  + 64 * (j))
#define XB_XSUB(j)  (1280 + 64 * (j))
#define XB_XGEN(j)  (2304 + 64 * (j))
#define XB_TOP      3328
#define XB_TOPGEN   3392
#define XCD_BAR_WORDS 3456
#define XB_SPIN_CAP (1u << 22)

__device__ __forceinline__ unsigned xb_ld(unsigned* p)              { return __hip_atomic_load(p, __ATOMIC_RELAXED, __HIP_MEMORY_SCOPE_AGENT); }
__device__ __forceinline__ unsigned xb_add(unsigned* p, unsigned v) { return __hip_atomic_fetch_add(p, v, __ATOMIC_RELAXED, __HIP_MEMORY_SCOPE_AGENT); }
__device__ __forceinline__ unsigned xb_xcc_id() { return (unsigned)__builtin_amdgcn_s_getreg((3 << 11) | 20) & 0xFu; }
#define XB_SPIN(cond, bar) do { unsigned _sp = 0; while (cond) { __builtin_amdgcn_s_sleep(1); \
    if ((++_sp & 255u) == 0u) { if (xb_ld(&(bar)[XB_TMO])) break; if (_sp > XB_SPIN_CAP) { atomicAdd(&(bar)[XB_TMO], 1u); break; } } } } while (0)

struct XcdBarrier {
    unsigned* bar; unsigned x;
    volatile LAS unsigned* st;
};

__device__ __forceinline__ XcdBarrier xcd_barrier_post(unsigned* bar, volatile LAS unsigned* st) {
    XcdBarrier b; b.bar = bar; b.x = xb_xcc_id(); b.st = st;
    if (threadIdx.x == 0) (void)xb_add(&bar[XB_XCNT(b.x)], 1u);
    return b;
}
__device__ __forceinline__ void xcd_barrier_complete(unsigned* bar, unsigned x, unsigned& nloc, unsigned& nx) {
    const unsigned G = gridDim.x * gridDim.y * gridDim.z;
    unsigned sum, cnt, mine, sp = 0u;
    for (;;) {
        sum = 0u; cnt = 0u; mine = 0u;
#pragma unroll
        for (unsigned j = 0; j < 16; ++j) { const unsigned c = xb_ld(&bar[XB_XCNT(j)]); sum += c; cnt += (c > 0u) ? 1u : 0u; mine = (j == x) ? c : mine; }
        if (sum == G) break;
        __builtin_amdgcn_s_sleep(1);
        if ((++sp & 255u) == 0u) { if (xb_ld(&bar[XB_TMO])) break; if (sp > XB_SPIN_CAP) { atomicAdd(&bar[XB_TMO], 1u); break; } }
    }
    nloc = mine > 0u ? mine : 1u; nx = cnt > 0u ? cnt : 1u;
}

__device__ __forceinline__ void xcd_barrier(const XcdBarrier& b) {
    asm volatile("s_waitcnt vmcnt(0)" ::: "memory");
    __syncthreads();
    if (threadIdx.x == 0) {
        unsigned* bar = b.bar;
        __builtin_amdgcn_s_waitcnt(0);
        unsigned nloc = b.st[0], nx = b.st[1];
        if (nloc == 0u) { xcd_barrier_complete(bar, b.x, nloc, nx); b.st[0] = nloc; b.st[1] = nx; }
        const unsigned old = xb_add(&bar[XB_XSUB(b.x)], 1u);
        const unsigned gen = old / nloc;
        if (old + 1u == (gen + 1u) * nloc) {
            __builtin_amdgcn_fence(__ATOMIC_RELEASE, "agent");
            asm volatile("s_waitcnt vmcnt(0)" ::: "memory");
            const unsigned og = xb_add(&bar[XB_TOP], 1u);
            const unsigned tg = og / nx;
            if (og + 1u == (tg + 1u) * nx) xb_add(&bar[XB_TOPGEN], 1u);
            else XB_SPIN(xb_ld(&bar[XB_TOPGEN]) == tg, bar);
            __builtin_amdgcn_fence(__ATOMIC_ACQUIRE, "agent");
            xb_add(&bar[XB_XGEN(b.x)], 1u);
            asm volatile("s_waitcnt vmcnt(0)" ::: "memory");
        } else {
            XB_SPIN(xb_ld(&bar[XB_XGEN(b.x)]) == gen, bar);
            __builtin_amdgcn_fence(__ATOMIC_ACQUIRE, "agent");
            asm volatile("s_waitcnt vmcnt(0)" ::: "memory");
        }
    }
    __syncthreads();
}
constexpr int NWAVES = 8, NTHREADS = 512;
constexpr int NB = 8, SEQ = 4096, DM = 1024, MROWS = NB * SEQ, FF = 4096, NIN = 5444, DEPTH = 2;
constexpr int NPROJ = 5120;
constexpr int CA_Q = 0, CA_K = 256, CI_Q = 512, CI_W = 800, CB_U = 1024, CB_V = 1280, CC_Q = 1536, CC_K = 1792;
constexpr float LOG2E = 1.4426950408889634f;
constexpr float EPS = 1e-6f;
constexpr size_t MiB = 1u << 20;
constexpr size_t WS_CTL = 0, CTL_ZERO_BYTES = 1 * MiB;
constexpr size_t WS_WL = 1 * MiB, WL_STRIDE = 31 * MiB + 256 * 1024;
constexpr size_t WO_IN1 = 0, WO_VT = 10 * MiB, WO_B = 11 * MiB, WO_O = 13 * MiB, WO_F1 = 15 * MiB, WO_F2 = 23 * MiB, WO_S = 31 * MiB;
static_assert(WO_B + 3 * 1024 * 256 * 2 <= WO_O && WO_F2 + 8 * MiB <= WO_S && WO_S + 131072 <= WL_STRIDE && WS_WL + 2 * WL_STRIDE <= 64 * MiB, "weights map");
constexpr size_t WS_H = 64 * MiB;
constexpr size_t WS_Y = WS_H, WS_MASK = WS_H + 48 * MiB;
constexpr size_t WS_PA = 128 * MiB;
constexpr size_t WS_MA = WS_PA, WS_MB = WS_PA + 64 * MiB;
constexpr size_t WS_G = 256 * MiB;
constexpr size_t WS_ACT = 128 * MiB;
constexpr size_t WS_VTA = 448 * MiB;
constexpr size_t WS_KIDX = 480 * MiB;
constexpr size_t WS_END = 484 * MiB;
constexpr int CW_BAR = 4096;
constexpr int RING_BYTES = 131072;
constexpr int HIST_OFF = 131072, HIST_BYTES = 16384;
constexpr int MISC_OFF = HIST_OFF + HIST_BYTES;
constexpr int LDS_BYTES = MISC_OFF + 512;

#define DI __device__ __forceinline__
typedef float f32x16 __attribute__((ext_vector_type(16)));
typedef float f32x2 __attribute__((ext_vector_type(2)));
typedef __bf16 bf16x2_t __attribute__((ext_vector_type(2)));
typedef unsigned u32x2 __attribute__((ext_vector_type(2)));
#define MFMA32(a, b, c) __builtin_amdgcn_mfma_f32_32x32x16_bf16((a), (b), (c), 0, 0, 0)
DI unsigned cvtpk(float lo, float hi) { f32x2 v = {lo, hi}; bf16x2_t b = __builtin_convertvector(v, bf16x2_t); return __builtin_bit_cast(unsigned, b); }
DI float blo(unsigned w) { return __uint_as_float(w << 16); }
DI float bhi(unsigned w) { return __uint_as_float(w & 0xffff0000u); }
DI float bf1(bf16 h) { return __uint_as_float((unsigned)h << 16); }
DI float fexp2(float x) { return __builtin_amdgcn_exp2f(x); }
DI float swapmax(float m) { auto rr = __builtin_amdgcn_permlane32_swap(__float_as_uint(m), __float_as_uint(m), false, false); return fmaxf(__uint_as_float(rr[0]), __uint_as_float(rr[1])); }
DI float swapsum(float m) { auto rr = __builtin_amdgcn_permlane32_swap(__float_as_uint(m), __float_as_uint(m), false, false); return __uint_as_float(rr[0]) + __uint_as_float(rr[1]); }
#define DPPF(v, ctrl) __int_as_float(__builtin_amdgcn_update_dpp(0, __float_as_int(v), (ctrl), 0xf, 0xf, true))
DI float quad_sum(float v) { v += DPPF(v, 0xB1); v += DPPF(v, 0x4E); return v; }
DI float row_sum(float v) { v = quad_sum(v); v += DPPF(v, 0x141); v += DPPF(v, 0x140); return v; }
DI float wave_sum(float v) { v = row_sum(v);
    return __int_as_float(__builtin_amdgcn_readlane(__float_as_int(v), 0)) + __int_as_float(__builtin_amdgcn_readlane(__float_as_int(v), 16)) + (__int_as_float(__builtin_amdgcn_readlane(__float_as_int(v), 32)) + __int_as_float(__builtin_amdgcn_readlane(__float_as_int(v), 48))); }
DI float gelu_tanh(float x) {
    const float u = 0.7978845608028654f * (x + 0.044715f * x * x * x);
    return x * __builtin_amdgcn_rcpf(1.0f + fexp2(-2.0f * LOG2E * u));
}
DI void wg_barrier() { asm volatile("s_waitcnt vmcnt(0) lgkmcnt(0)" ::: "memory"); __builtin_amdgcn_s_barrier(); asm volatile("" ::: "memory"); }
DI void lds_barrier() { asm volatile("s_waitcnt lgkmcnt(0)" ::: "memory"); __builtin_amdgcn_s_barrier(); asm volatile("" ::: "memory"); }

struct Ctx {
    LAS unsigned char* lds;
    int tid, lane, wave, vcu, G;
    float* out; unsigned char* ws;
};

DI void grid_bar(XcdBarrier b) { asm volatile("" : "+s"(b.bar), "+s"(b.x)); xcd_barrier(b); }
DI void tr_item(const float* W, int ldw, int k0, int c0, int nvalid, bf16* WT, int Kd, int drow, float scale, LAS float* scr, int lane) {
#pragma unroll 8
    for (int i = 0; i < 32; ++i) { const int kk = 2 * i + (lane >> 5), n = lane & 31; scr[kk * 33 + n] = (n < nvalid) ? W[(size_t)(k0 + kk) * ldw + c0 + n] * scale : 0.f; }
    LDS_WAIT(); asm volatile("" ::: "memory");
    const int c = lane & 7;
#pragma unroll
    for (int j = 0; j < 4; ++j) { const int n = (lane >> 3) + 8 * j; const LAS float* s = scr + (8 * c) * 33 + n;
        v4u o; o.x = cvtpk(s[0 * 33], s[1 * 33]); o.y = cvtpk(s[2 * 33], s[3 * 33]); o.z = cvtpk(s[4 * 33], s[5 * 33]); o.w = cvtpk(s[6 * 33], s[7 * 33]);
        *(GAS v4u*)(WT + (size_t)(drow + n) * Kd + k0 + 8 * c) = o; }
    LDS_WAIT(); asm volatile("" ::: "memory");
}
DI void win_map(int cb, int& c0, int& nv, int& dsel, int& drow, float& sc) {
    nv = 32; dsel = 0; sc = 1.f;
    if (cb < 8)        { c0 = 0 + 32 * cb;            drow = CA_Q + 32 * cb; sc = 0.125f * LOG2E; }
    else if (cb < 16)  { c0 = 256 + 32 * (cb - 8);    drow = CA_K + 32 * (cb - 8); }
    else if (cb < 24)  { c0 = 512 + 32 * (cb - 16);   drow = 32 * (cb - 16); dsel = 1; }
    else if (cb < 32)  { c0 = 768 + 32 * (cb - 24);   drow = CI_Q + 32 * (cb - 24); sc = 0.125f; }
    else if (cb == 32) { c0 = 1024;                   drow = 768; }
    else if (cb == 33) { c0 = 1056;                   drow = 768 + 128; }
    else if (cb == 34) { c0 = 1088; nv = 4;           drow = CI_W; sc = 0.5f; }
    else if (cb < 43)  { c0 = 1092 + 32 * (cb - 35);  drow = CB_U + 32 * (cb - 35); }
    else if (cb < 51)  { c0 = 1348 + 32 * (cb - 43);  drow = CB_V + 32 * (cb - 43); }
    else if (cb < 59)  { c0 = 1604 + 32 * (cb - 51);  drow = CC_Q + 32 * (cb - 51); sc = 0.17677669529663687f * LOG2E; }
    else if (cb < 67)  { c0 = 1860 + 32 * (cb - 59);  drow = CC_K + 32 * (cb - 59); }
    else if (cb < 75)  { c0 = 2116 + 32 * (cb - 67);  drow = 256 + 32 * (cb - 67); dsel = 1; }
    else               { c0 = 2372 + 32 * (cb - 75);  drow = 2048 + 32 * (cb - 75); }
}
DI void prologue_weights(const Ctx& C, unsigned char* wsb, const float* w_in, const float* w_s, const float* wba, const float* wbb, const float* wbc, const float* w_o, const float* w_f1, const float* w_f2) {
    LAS float* scr = (LAS float*)(C.lds + C.wave * 16384);
    const int gw = C.vcu * NWAVES + C.wave, NGW = C.G * NWAVES;
    constexpr int NCB_IN = 75 + 96;
    constexpr int I_IN = NCB_IN * 16, I_B = 32 * 4, I_O = 32 * 16, I_F1 = 128 * 16, I_F2 = 32 * 64;
    constexpr int PER_LAYER = I_IN + 3 * I_B + I_O + I_F1 + I_F2;
    for (int it = gw; it < DEPTH * PER_LAYER; it += NGW) {
        const int l = it / PER_LAYER; int r = it % PER_LAYER;
        unsigned char* wl = wsb + WS_WL + (size_t)l * WL_STRIDE;
        if (r < I_IN) { const int cb = r / 16, kb = r % 16; int c0, nv, dsel, drow; float sc; win_map(cb, c0, nv, dsel, drow, sc);
            tr_item(w_in + (size_t)l * DM * NIN, NIN, 64 * kb, c0, nv, (bf16*)(wl + (dsel ? WO_VT : WO_IN1)), DM, drow, sc, scr, C.lane); continue; }
        r -= I_IN;
        if (r < 3 * I_B) { const int w = r / I_B, q = r % I_B, cb = q / 4, kb = q % 4;
            tr_item((w == 0 ? wba : (w == 1 ? wbb : wbc)) + (size_t)l * 256 * DM, DM, 64 * kb, 32 * cb, 32, (bf16*)(wl + WO_B) + (size_t)w * 1024 * 256, 256, 32 * cb, 1.f, scr, C.lane); continue; }
        r -= 3 * I_B;
        if (r < I_O) { const int cb = r / 16, kb = r % 16; tr_item(w_o + (size_t)l * DM * DM, DM, 64 * kb, 32 * cb, 32, (bf16*)(wl + WO_O), DM, 32 * cb, 1.f, scr, C.lane); continue; }
        r -= I_O;
        if (r < I_F1) { const int cb = r / 16, kb = r % 16; tr_item(w_f1 + (size_t)l * DM * FF, FF, 64 * kb, 32 * cb, 32, (bf16*)(wl + WO_F1), DM, 32 * cb, 1.f, scr, C.lane); continue; }
        r -= I_F1;
        { const int cb = r / 64, kb = r % 64; tr_item(w_f2 + (size_t)l * FF * DM, DM, 64 * kb, 32 * cb, 32, (bf16*)(wl + WO_F2), FF, 32 * cb, 1.f, scr, C.lane); }
    }
    const int gt = C.vcu * NTHREADS + C.tid, NGT = C.G * NTHREADS;
    for (int it = gt; it < DEPTH * 160 * 128; it += NGT) { const int l = it / (160 * 128), q = it % (160 * 128), rr = q / 128, ch = q % 128;
        const int row = rr < 64 ? 832 + rr : 928 + (rr - 64);
        *(GAS v4u*)((bf16*)(wsb + WS_WL + (size_t)l * WL_STRIDE + WO_IN1) + (size_t)row * DM + 8 * ch) = (v4u){0u, 0u, 0u, 0u}; }
    for (int it = gt; it < DEPTH * 4 * 128 * 128 / 2; it += NGT) { const int e = 2 * it, l = e / 65536, q = e % 65536, t = (q >> 7) & 127, s = q & 127;
        const float* src = w_s + e; const float a = (s <= t) ? src[0] : 0.f, b = (s + 1 <= t) ? src[1] : 0.f;
        *(GAS unsigned*)((bf16*)(wsb + WS_WL + (size_t)l * WL_STRIDE + WO_S) + q) = cvtpk(a, b); }
}
DI void rmsnorm_rows(const Ctx& C, const float* src, const float* g, bf16* dstb, float* dstf) {
    int tid_ = C.tid; asm volatile("" : "+v"(tid_));
    const int lane = tid_ & 63, wave = __builtin_amdgcn_readfirstlane(tid_ >> 6);
    const int gw = C.vcu * NWAVES + wave, NGW = C.G * NWAVES;
    f32x4 gv[4];
#pragma unroll
    for (int j = 0; j < 4; ++j) gv[j] = *((const GAS f32x4*)g + lane + 64 * j);
    for (int m = gw; m < MROWS; m += NGW) {
        const GAS f32x4* xr = (const GAS f32x4*)(src + (size_t)m * DM) + lane;
        f32x4 v[4]; float s = 0.f;
#pragma unroll
        for (int j = 0; j < 4; ++j) { v[j] = xr[64 * j]; s += (v[j].x * v[j].x + v[j].y * v[j].y) + (v[j].z * v[j].z + v[j].w * v[j].w); }
        const float rstd = 1.0f / sqrtf(wave_sum(s) * (1.0f / DM) + EPS);
        if (dstb) { GAS u32x2* o8 = (GAS u32x2*)(dstb + (size_t)m * DM) + lane;
#pragma unroll
            for (int j = 0; j < 4; ++j) { const f32x4 y = v[j] * rstd * gv[j]; o8[64 * j] = (u32x2){cvtpk(y.x, y.y), cvtpk(y.z, y.w)}; } }
        else { GAS f32x4* o = (GAS f32x4*)(dstf + (size_t)m * DM) + lane;
#pragma unroll
            for (int j = 0; j < 4; ++j) o[64 * j] = v[j] * rstd * gv[j]; }
    }
}

DI int pi32(int x) { return (x & 0x13) | ((x & 4) << 1) | ((x & 8) >> 1); }
DI unsigned suffix_excl(unsigned T, int lane) {
    unsigned s = T;
#pragma unroll
    for (int o = 1; o < 64; o <<= 1) { const unsigned v = (unsigned)__builtin_amdgcn_ds_bpermute(((lane + o) & 63) << 2, (int)s); if (lane + o < 64) s += v; }
    return s - T;
}
DI void select_unit(const Ctx& C, int b, int t0, const bf16* projA, const bf16* kidx, unsigned long long* mask) {
    LAS unsigned* scores = (LAS unsigned*)C.lds;
    LAS unsigned* hist = (LAS unsigned*)(C.lds + HIST_OFF);
    int tid_ = C.tid; asm volatile("" : "+v"(tid_));
    const int tid = tid_, lane = tid & 63, wave = __builtin_amdgcn_readfirstlane(tid >> 6), hi = lane >> 5, l31 = lane & 31;
    const size_t rowb = (size_t)b * SEQ;
#ifndef SEL_TRIVIAL
#define SEL_TRIVIAL 0
#endif
    if (SEL_TRIVIAL || t0 < 256) {
        const int t = t0 + wave;
        if (lane <= (t >> 6)) { const int rem = t - 64 * lane; mask[(rowb + t) * 64 + lane] = rem >= 63 ? ~0ull : ((1ull << (rem + 1)) - 1ull); }
        return;
    }
    const int nk = (t0 + 8 + 63) & ~63, ntile = nk >> 5;
    unsigned z0 = 0u; asm volatile("" : "+v"(z0)); const v4u zero4 = {z0, z0, z0, z0};
    { LAS v4u* h4 = (LAS v4u*)hist; h4[tid] = zero4; h4[tid + 512] = zero4; }
    bf16x8 qf[4];
    { const bf16* qp = projA + (rowb + t0 + (l31 >> 2)) * 2048 + CI_Q + (l31 & 3) * 64 + 8 * hi;
#pragma unroll
      for (int kk = 0; kk < 4; ++kk) qf[kk] = *(const bf16x8*)(qp + 16 * kk); }
    float coef[16];
#pragma unroll
    for (int i = 0; i < 16; ++i) coef[i] = bf1(projA[(rowb + t0 + 2 * (i >> 2) + hi) * 2048 + CI_W + (i & 3)]);
    lds_barrier();
    bf16x8 kf[4], kn[4];
    { const bf16* kp = kidx + (rowb + 32 * wave + l31) * 64 + 8 * hi;
      if (wave < ntile) {
#pragma unroll
        for (int kk = 0; kk < 4; ++kk) kf[kk] = *(const bf16x8*)(kp + 16 * kk); } }
    for (int tile = wave; tile < ntile; tile += 8) {
        const int kv0 = tile * 32;
        if (tile + 8 < ntile) { const bf16* kp = kidx + (rowb + kv0 + 256 + l31) * 64 + 8 * hi;
#pragma unroll
            for (int kk = 0; kk < 4; ++kk) kn[kk] = *(const bf16x8*)(kp + 16 * kk); }
        f32x16 acc = {};
#pragma unroll
        for (int kk = 0; kk < 4; ++kk) acc = MFMA32(qf[kk], kf[kk], acc);
        const int key = kv0 + l31;
#pragma unroll
        for (int jq = 0; jq < 4; ++jq) {
            float sc = 0.f;
#pragma unroll
            for (int h = 0; h < 4; ++h) sc = fmaf(coef[4 * jq + h], fmaxf(acc[4 * jq + h], 0.f), sc);
            const int q = 2 * jq + hi;
            float x = sc * 134217728.0f; x = fminf(fmaxf(x, -2147483648.0f), 2147483520.0f);
            unsigned u = (unsigned)(int)x ^ 0x80000000u;
            if (key > t0 + q) u = 0u;
            scores[q * 4096 + key] = u;
            const unsigned bin = u >> 22;
            __hip_atomic_fetch_add(hist + q * 512 + (bin >> 1), 1u << (16 * (bin & 1)), __ATOMIC_RELAXED, __HIP_MEMORY_SCOPE_WORKGROUP);
        }
#pragma unroll
        for (int kk = 0; kk < 4; ++kk) kf[kk] = kn[kk];
    }
    lds_barrier();
    {
        const int q = wave, t = t0 + q, nch = nk >> 6;
        LAS unsigned* hq = hist + q * 512; LAS unsigned* sq = scores + q * 4096;
        unsigned prefix, krem;
        {
            const v4u a = *(LAS v4u*)(hq + 8 * lane), c = *(LAS v4u*)(hq + 8 * lane + 4);
            unsigned cnt[16] = {a.x & 0xffffu, a.x >> 16, a.y & 0xffffu, a.y >> 16, a.z & 0xffffu, a.z >> 16, a.w & 0xffffu, a.w >> 16,
                                c.x & 0xffffu, c.x >> 16, c.y & 0xffffu, c.y >> 16, c.z & 0xffffu, c.z >> 16, c.w & 0xffffu, c.w >> 16};
            unsigned T = 0;
#pragma unroll
            for (int i = 0; i < 16; ++i) T += cnt[i];
            const unsigned above = suffix_excl(T, lane);
            const bool mine = above < 256u && above + T >= 256u;
            unsigned run = above, dsel = 0, ksel = 0; bool found = false;
#pragma unroll
            for (int i = 15; i >= 0; --i) { if (!found && run + cnt[i] >= 256u) { found = true; dsel = (unsigned)i; ksel = 256u - run; } if (!found) run += cnt[i]; }
            const unsigned long long bm = __ballot(mine); const int src = (int)__builtin_ctzll(bm);
            prefix = (unsigned)__builtin_amdgcn_readlane((int)(16u * (unsigned)lane + dsel), src); krem = (unsigned)__builtin_amdgcn_readlane((int)ksel, src);
        }
#pragma unroll
        for (int pass = 0; pass < 3; ++pass) {
            const int width = pass == 2 ? 6 : 8, shift = pass == 0 ? 14 : (pass == 1 ? 6 : 0);
            *(LAS v4u*)(hq + 4 * lane) = zero4;
            for (int c = 0; c < nch; ++c) { const unsigned key = sq[64 * c + lane];
                if ((key >> (shift + width)) == prefix) __hip_atomic_fetch_add(hq + ((key >> shift) & ((1u << width) - 1u)), 1u, __ATOMIC_RELAXED, __HIP_MEMORY_SCOPE_WORKGROUP); }
            const v4u a = *(LAS v4u*)(hq + 4 * lane);
            unsigned cnt[4] = {a.x, a.y, a.z, a.w};
            const unsigned T = cnt[0] + cnt[1] + cnt[2] + cnt[3];
            const unsigned above = suffix_excl(T, lane);
            const bool mine = above < krem && above + T >= krem;
            unsigned run = above, dsel = 0, ksel = 0; bool found = false;
#pragma unroll
            for (int i = 3; i >= 0; --i) { if (!found && run + cnt[i] >= krem) { found = true; dsel = (unsigned)i; ksel = krem - run; } if (!found) run += cnt[i]; }
            const unsigned long long bm = __ballot(mine); const int src = (int)__builtin_ctzll(bm);
            const unsigned d = (unsigned)__builtin_amdgcn_readlane((int)(4u * (unsigned)lane + dsel), src); krem = (unsigned)__builtin_amdgcn_readlane((int)ksel, src);
            prefix = (prefix << width) | d;
        }
        unsigned long long myword = 0ull; unsigned taken = 0;
        const unsigned long long lt = (1ull << lane) - 1ull;
        for (int c = 0; c < nch; ++c) { const unsigned key = sq[64 * c + lane];
            const bool eq = key == prefix; const unsigned long long beq = __ballot(eq);
            const bool sel = key > prefix || (eq && taken + (unsigned)__builtin_popcountll(beq & lt) < krem);
            taken += (unsigned)__builtin_popcountll(beq);
            const unsigned long long w = __ballot(sel);
            if (lane == c) myword = w; }
        if (lane < nch) mask[(rowb + t) * 64 + lane] = myword;
        (void)t;
    }
    lds_barrier();
}

constexpr int AT_STAGE = 16384;
struct AttnArgs { const bf16* projA; const bf16* VT; const unsigned long long* mask; bf16* Y; int qcol, kcol, vrow; float lam, oscale; const float* subg; };
template <int MODE>
DI void attn_unit(const Ctx& C, const AttnArgs& A, int b, int h, int qb) {
    LAS unsigned char* lds = C.lds;
    int tid_ = C.tid; asm volatile("" : "+v"(tid_));
    const int tid = tid_, lane = tid & 63, wave = __builtin_amdgcn_readfirstlane(tid >> 6), hi = lane >> 5, l31 = lane & 31;
    const size_t rowb = (size_t)b * SEQ; const int q0 = qb * 256, qw0 = q0 + 32 * wave, tq = qw0 + l31;
    const int nkt = (q0 + 256) >> 6;
    const int sk = tid >> 3, sp = tid & 7;
    const bf16* kg = A.projA + (rowb + sk) * 2048 + A.kcol + h * 64 + 8 * sp;
    const bf16* vg = A.VT + (size_t)(A.vrow + h * 64 + sk) * MROWS + rowb + 8 * sp;
    const int kdst = ((sk >> 5) * 8 + sp) * 512 + ((pi32(sk & 31) ^ sp) * 16);
    const int vdst = 8192 + ((sk >> 5) * 8 + sp) * 512 + (((sk & 31) ^ sp) * 16);
    bf16x8 qf[4];
    { const bf16* qp = A.projA + (rowb + tq) * 2048 + A.qcol + h * 64 + 8 * hi;
#pragma unroll
      for (int kk = 0; kk < 4; ++kk) qf[kk] = *(const bf16x8*)(qp + 16 * kk); }
    constexpr int NC = MODE == 1 ? 2 : 1;
    f32x16 O[NC][2]; float mref[NC], lsum[NC];
#pragma unroll
    for (int c = 0; c < NC; ++c) { O[c][0] = f32x16{}; O[c][1] = f32x16{}; mref[c] = -1e30f; lsum[c] = 0.f; }
    { const v4u kr = *(const GAS v4u*)kg, vr = *(const GAS v4u*)vg;
      *(LAS v4u*)(lds + kdst) = kr; *(LAS v4u*)(lds + vdst) = vr; }
    unsigned long long mw = 0ull;
    if (MODE == 0) mw = A.mask[(rowb + tq) * 64];
    lds_barrier();
    for (int kt = 0; kt < nkt; ++kt) {
        const int kv0 = kt * 64; LAS unsigned char* st = lds + (kt & 1) * AT_STAGE;
        v4u kr = {}, vr = {}; unsigned long long mwn = 0ull;
        const bool more = kt + 1 < nkt;
        if (more) { kr = *(const GAS v4u*)(kg + (size_t)(kv0 + 64) * 2048); vr = *(const GAS v4u*)(vg + kv0 + 64); if (MODE == 0) mwn = A.mask[(rowb + tq) * 64 + kt + 1]; }
        if (kv0 <= qw0 + 31) {
            const bool diag = kv0 + 63 > qw0;
#pragma unroll
            for (int c = 0; c < NC; ++c) {
                __builtin_amdgcn_sched_barrier(0);
                f32x16 S0 = {}, S1 = {};
                if (MODE == 0) {
#pragma unroll
                    for (int kk = 0; kk < 4; ++kk) { const int pb = kk * 2 + hi;
                        const bf16x8 k0 = *(const LAS bf16x8*)(st + (0 * 8 + pb) * 512 + ((l31 ^ pb) * 16)), k1 = *(const LAS bf16x8*)(st + (1 * 8 + pb) * 512 + ((l31 ^ pb) * 16));
                        S0 = MFMA32(k0, qf[kk], S0); S1 = MFMA32(k1, qf[kk], S1); }
                } else {
#pragma unroll
                    for (int k2 = 0; k2 < 2; ++k2) { const int kk = 2 * c + k2, pb = kk * 2 + hi;
                        const bf16x8 k0 = *(const LAS bf16x8*)(st + (0 * 8 + pb) * 512 + ((l31 ^ pb) * 16)), k1 = *(const LAS bf16x8*)(st + (1 * 8 + pb) * 512 + ((l31 ^ pb) * 16));
                        S0 = MFMA32(k0, qf[kk], S0); S1 = MFMA32(k1, qf[kk], S1); }
                }
                if (MODE == 0) {
                    const unsigned long long sh = mw >> (8 * hi); const unsigned lo = (unsigned)sh, hw = (unsigned)(sh >> 32);
#pragma unroll
                    for (int r = 0; r < 16; ++r) { const int pos = 16 * (r >> 3) + (r & 7);
                        if (!((lo >> pos) & 1u)) S0[r] = -INFINITY; if (!((hw >> pos) & 1u)) S1[r] = -INFINITY; }
                } else if (diag) {
                    const int kb = kv0 + 8 * hi;
#pragma unroll
                    for (int r = 0; r < 16; ++r) { const int key = kb + 16 * (r >> 3) + (r & 7);
                        if (key > tq) S0[r] = -INFINITY; if (key + 32 > tq) S1[r] = -INFINITY; }
                }
                float mx = fmaxf(S0[0], S1[0]);
#pragma unroll
                for (int r = 1; r < 16; ++r) mx = fmaxf(mx, fmaxf(S0[r], S1[r]));
                mx = swapmax(mx);
                if (__any(mx > mref[c] + 8.0f)) {
                    const float mnew = fmaxf(mref[c], mx), alpha = fexp2(mref[c] - mnew);
                    mref[c] = mnew; lsum[c] *= alpha;
#pragma unroll
                    for (int r = 0; r < 16; ++r) { O[c][0][r] *= alpha; O[c][1][r] *= alpha; }
                }
                float ls = 0.f;
#pragma unroll
                for (int r = 0; r < 16; ++r) { S0[r] = fexp2(S0[r] - mref[c]); S1[r] = fexp2(S1[r] - mref[c]); ls += S0[r] + S1[r]; }
                lsum[c] += ls;
                __builtin_amdgcn_sched_barrier(0);
                bf16x8 pf[4];
                { v4u w;
                  w = (v4u){cvtpk(S0[0], S0[1]), cvtpk(S0[2], S0[3]), cvtpk(S0[4], S0[5]), cvtpk(S0[6], S0[7])};     pf[0] = __builtin_bit_cast(bf16x8, w);
                  w = (v4u){cvtpk(S0[8], S0[9]), cvtpk(S0[10], S0[11]), cvtpk(S0[12], S0[13]), cvtpk(S0[14], S0[15])}; pf[1] = __builtin_bit_cast(bf16x8, w);
                  w = (v4u){cvtpk(S1[0], S1[1]), cvtpk(S1[2], S1[3]), cvtpk(S1[4], S1[5]), cvtpk(S1[6], S1[7])};     pf[2] = __builtin_bit_cast(bf16x8, w);
                  w = (v4u){cvtpk(S1[8], S1[9]), cvtpk(S1[10], S1[11]), cvtpk(S1[12], S1[13]), cvtpk(S1[14], S1[15])}; pf[3] = __builtin_bit_cast(bf16x8, w); }
#pragma unroll
                for (int dh = 0; dh < 2; ++dh)
#pragma unroll
                    for (int cc = 0; cc < 4; ++cc) { const int pb = cc * 2 + hi;
                        const bf16x8 vf = *(const LAS bf16x8*)(st + 8192 + (dh * 8 + pb) * 512 + ((l31 ^ pb) * 16));
                        O[c][dh] = MFMA32(vf, pf[cc], O[c][dh]); }
            }
        }
        if (more) { LAS unsigned char* sn = lds + ((kt + 1) & 1) * AT_STAGE; *(LAS v4u*)(sn + kdst) = kr; *(LAS v4u*)(sn + vdst) = vr; mw = mwn; }
        lds_barrier();
    }
    bf16* yp = A.Y + (rowb + tq) * 256 + h * 64 + 4 * hi;
    if (MODE == 0) {
        const float inv = 1.0f / swapsum(lsum[0]);
#pragma unroll
        for (int dh = 0; dh < 2; ++dh)
#pragma unroll
            for (int g4 = 0; g4 < 4; ++g4) { const f32x16& o = O[0][dh];
                *(u32x2*)(yp + 32 * dh + 8 * g4) = (u32x2){cvtpk(o[4 * g4] * inv, o[4 * g4 + 1] * inv), cvtpk(o[4 * g4 + 2] * inv, o[4 * g4 + 3] * inv)}; }
    } else {
        const float i1 = 1.0f / swapsum(lsum[0]), i2 = A.lam / swapsum(lsum[NC - 1]);
        float ss = 0.f;
#pragma unroll
        for (int dh = 0; dh < 2; ++dh)
#pragma unroll
            for (int r = 0; r < 16; ++r) { const float v = O[0][dh][r] * i1 - O[NC - 1][dh][r] * i2; O[0][dh][r] = v; ss += v * v; }
        ss = swapsum(ss);
        const float rstd = A.oscale / sqrtf(ss * (1.0f / 64.0f) + EPS);
#pragma unroll
        for (int dh = 0; dh < 2; ++dh)
#pragma unroll
            for (int g4 = 0; g4 < 4; ++g4) { const f32x16& o = O[0][dh]; const f32x4 gg = *(const f32x4*)(A.subg + 32 * dh + 8 * g4 + 4 * hi);
                *(u32x2*)(yp + 32 * dh + 8 * g4) = (u32x2){cvtpk(o[4 * g4] * rstd * gg[0], o[4 * g4 + 1] * rstd * gg[1]), cvtpk(o[4 * g4 + 2] * rstd * gg[2], o[4 * g4 + 3] * rstd * gg[3])}; }
    }
}

DI void sgu_unit(const Ctx& C, int b, int chunk, const bf16* projA, const bf16* Ws, const float* lng, const float* lnb, const float* bs, bf16* Yb) {
    LAS unsigned char* lds = C.lds;
    int tid_ = C.tid; asm volatile("" : "+v"(tid_));
    const int tid = tid_, lane = tid & 63, wave = __builtin_amdgcn_readfirstlane(tid >> 6), hi = lane >> 5, l31 = lane & 31;
    const size_t R0 = (size_t)b * SEQ + 128 * chunk;
    {
        const int pos = tid >> 2, g = tid & 3;
        const bf16* vp = projA + (R0 + pos) * 2048 + CB_V + 64 * g;
        float x[64]; float s = 0.f;
#pragma unroll
        for (int j = 0; j < 8; ++j) { const v4u w = *(const GAS v4u*)(vp + 8 * j);
            x[8 * j + 0] = gelu_tanh(blo(w.x)); x[8 * j + 1] = gelu_tanh(bhi(w.x)); x[8 * j + 2] = gelu_tanh(blo(w.y)); x[8 * j + 3] = gelu_tanh(bhi(w.y));
            x[8 * j + 4] = gelu_tanh(blo(w.z)); x[8 * j + 5] = gelu_tanh(bhi(w.z)); x[8 * j + 6] = gelu_tanh(blo(w.w)); x[8 * j + 7] = gelu_tanh(bhi(w.w)); }
#pragma unroll
        for (int i = 0; i < 64; ++i) s += x[i];
        s = quad_sum(s);
        const float mu = s * (1.0f / 256.0f); float q = 0.f;
#pragma unroll
        for (int i = 0; i < 64; ++i) { const float d = x[i] - mu; q += d * d; }
        q = quad_sum(q);
        const float rstd = 1.0f / sqrtf(q * (1.0f / 256.0f) + EPS);
        LAS bf16* dst = (LAS bf16*)lds;
#pragma unroll
        for (int i = 0; i < 64; ++i) { const float y = (x[i] - mu) * rstd * lng[64 * g + i] + lnb[64 * g + i];
            dst[(((g * 2 + (i >> 5)) * 16 + (pos >> 3)) * 32 + (i & 31)) * 8 + (pos & 7)] = (bf16)(cvtpk(y, 0.f) & 0xffffu); }
    }
    lds_barrier();
#pragma unroll 1
    for (int i = 0; i < 4; ++i) {
        const int id = wave * 4 + i, g = id >> 3, chh = (id >> 2) & 1, tb = id & 3;
        const int t = 32 * tb + l31;
        const bf16* wp = Ws + ((size_t)g * 128 + t) * 128 + 8 * hi;
        f32x16 acc = {};
        for (int kk = 0; kk <= 2 * tb + 1; ++kk) {
            const bf16x8 a = *(const LAS bf16x8*)(lds + (size_t)((((g * 2 + chh) * 16 + 2 * kk + hi) * 32 + l31) * 16));
            const bf16x8 bb = *(const bf16x8*)(wp + 16 * kk);
            acc = MFMA32(a, bb, acc);
        }
        const float bias = bs[g * 128 + t];
        const bf16* up = projA + (R0 + t) * 2048 + CB_U + 64 * g + 32 * chh + 4 * hi;
        bf16* yp = Yb + (R0 + t) * 256 + 64 * g + 32 * chh + 4 * hi;
#pragma unroll
        for (int g4 = 0; g4 < 4; ++g4) { const u32x2 uw = *(const u32x2*)(up + 8 * g4);
            const float u0 = gelu_tanh(blo(uw.x)), u1 = gelu_tanh(bhi(uw.x)), u2 = gelu_tanh(blo(uw.y)), u3 = gelu_tanh(bhi(uw.y));
            *(u32x2*)(yp + 8 * g4) = (u32x2){cvtpk(u0 * (acc[4 * g4] + bias), u1 * (acc[4 * g4 + 1] + bias)), cvtpk(u2 * (acc[4 * g4 + 2] + bias), u3 * (acc[4 * g4 + 3] + bias))}; }
    }
    lds_barrier();
}

#ifndef PHMASK
#define PHMASK 0xffffffffu
#endif
#define PH(k) ((PHMASK >> (k)) & 1u)
#ifndef ZEROY
#define ZEROY 0
#endif
DI void zero_fill(const Ctx& C, v4u* p, size_t n) { for (size_t i = (size_t)blockIdx.x * NTHREADS + threadIdx.x; i < n; i += (size_t)C.G * NTHREADS) *(GAS v4u*)(p + i) = (v4u){0u, 0u, 0u, 0u}; }
struct Args { const float* in[19]; float* out; unsigned char* ws; int stop; int pad; };
#ifndef STOP_AT
#define STOP_AT 0
#endif
DI void dump_fold(const bf16* src, size_t nelem, float* out, int G) {
    const size_t NOUT = (size_t)MROWS * DM;
    for (size_t i = (size_t)blockIdx.x * NTHREADS + threadIdx.x; i < NOUT; i += (size_t)G * NTHREADS) {
        float a = 0.f;
        if (nelem >= NOUT) { for (size_t j = 0; j + NOUT <= nelem; j += NOUT) a += bf1(src[i + j]); } else a = bf1(src[i % nelem]);
        *(GAS float*)(out + i) = a; }
}
#define STOPCHK(n, ptr, ne) if (K->stop == (n)) { dump_fold((const bf16*)(ptr), (size_t)(ne), OUTP, C.G); return; }
__global__ void __launch_bounds__(NTHREADS, 2) mk_fwd(Args args) {
    extern __shared__ __attribute__((aligned(16))) unsigned char lds_raw[];
    Ctx C;
    C.lds = (LAS unsigned char*)lds_raw;
    C.tid = threadIdx.x; C.lane = C.tid & 63; C.wave = __builtin_amdgcn_readfirstlane(C.tid >> 6);
    C.G = gridDim.x; { const int bx = blockIdx.x; C.vcu = (C.G % 8 == 0) ? (bx % 8) * (C.G / 8) + bx / 8 : bx; }
    C.out = nullptr; C.ws = nullptr;
    typedef const __attribute__((address_space(4))) Args* KArgs;
#define KGET() KArgs K = (KArgs)__builtin_amdgcn_kernarg_segment_ptr(); asm volatile("" : "+s"(K))
#define IN(k) ((const float*)(const GAS float*)(K->in[k]))
#define OUTP ((float*)(GAS float*)(K->out))
    volatile LAS unsigned* MISC = (volatile LAS unsigned*)(C.lds + MISC_OFF);
    if (C.tid < 64) MISC[C.tid] = 0u;
    __syncthreads();
    XcdBarrier bar = xcd_barrier_post((unsigned*)(args.ws + WS_CTL) + CW_BAR, MISC + 8);
#define WSP(T, off) ((T*)(GAS T*)(K->ws + (off)))
#define Hb   WSP(bf16, WS_H)
#define PA   WSP(bf16, WS_PA)
#define Gb   WSP(bf16, WS_G)
#define VTb  WSP(bf16, WS_VTA)
#define KIDX WSP(bf16, WS_KIDX)
#define MASK WSP(unsigned long long, WS_MASK)
#define Ya   WSP(bf16, WS_Y)
#define Yb   WSP(bf16, WS_Y + 16 * MiB)
#define Yc   WSP(bf16, WS_Y + 32 * MiB)
#define MA   WSP(bf16, WS_MA)
#define MB   WSP(bf16, WS_MB)
#define ACT  WSP(bf16, WS_ACT)
#define WL(off) ((const bf16*)(const GAS bf16*)(K->ws + WS_WL + (size_t)l * WL_STRIDE + (off)))

#if PH(0)
        asm volatile("; MARK phase 0");
    { KGET();
    prologue_weights(C, (unsigned char*)(GAS unsigned char*)K->ws, IN(2), IN(7), IN(11), IN(12), IN(13), IN(14), IN(16), IN(17));
    rmsnorm_rows(C, IN(0), IN(1), Hb, nullptr); }
#endif
    grid_bar(bar);
    { KGET(); STOPCHK(1, Hb, (size_t)MROWS * DM) }

#pragma unroll 1
    for (int l = 0; l < DEPTH; ++l) {
#if PH(1)
        asm volatile("; MARK phase 1");
        { KGET();
            pg8::Gemm g{Hb, WL(WO_IN1), MROWS, NPROJ, DM}; pg8::StaticOrder S; S.init(MROWS, NPROJ, C.G, (int)blockIdx.x);
            pg8::EpiProj E{PA, Gb, KIDX, IN(3) + l * 64, IN(4) + l * 64};
            pg8::gemm_phase<pg8::EpiProj, pg8::StaticOrder, true, true>(C.lds, g, S, E);
        }
#endif
#if PH(2)
        asm volatile("; MARK phase 2");
        { KGET();
            pg8::Gemm g{WL(WO_VT), Hb, 512, MROWS, DM}; pg8::StaticOrder S; S.init(512, MROWS, C.G, (int)blockIdx.x);
            pg8::EpiAct<0> E{VTb, MROWS};
            pg8::gemm_phase<pg8::EpiAct<0>, pg8::StaticOrder, true, true>(C.lds, g, S, E);
        }
#endif
        grid_bar(bar);
        { KGET(); if (l == 0) { STOPCHK(2, PA, (size_t)MROWS * 2048) STOPCHK(3, Gb, (size_t)MROWS * 3072) STOPCHK(4, KIDX, (size_t)MROWS * 64) STOPCHK(5, VTb, (size_t)MROWS * 512) } }
#if PH(3)
        asm volatile("; MARK phase 3");
        { KGET();
            const int bsel = C.vcu >> 5, wi = C.vcu & 31;
#pragma unroll 1
            for (int j = 0; j < 16; ++j) { const int tb = 32 * j + ((j & 1) ? 31 - wi : wi); select_unit(C, bsel, 8 * tb, PA, KIDX, MASK); }
            lds_barrier();
        }
#endif
#if PH(4)
        asm volatile("; MARK phase 4");
        if (ZEROY & 2) { KGET(); zero_fill(C, (v4u*)Yb, 16 * MiB / 16); } else
        { KGET(); sgu_unit(C, C.vcu >> 5, C.vcu & 31, PA, WL(WO_S), IN(5) + l * 256, IN(6) + l * 256, IN(8) + l * 512, Yb); }
#endif
#if PH(5)
        asm volatile("; MARK phase 5");
        { KGET();
            const float* lq = IN(9) + l * 128;
            float d1 = (C.lane < 32) ? lq[C.lane] * lq[32 + C.lane] : 0.f, d2 = (C.lane < 32) ? lq[64 + C.lane] * lq[96 + C.lane] : 0.f;
            d1 = wave_sum(d1); d2 = wave_sum(d2);
            const float lam_init = 0.8f - 0.6f * expf(-0.3f * (float)l);
            const float lam = expf(d1) - expf(d2) + lam_init;
            AttnArgs A{PA, VTb, nullptr, Yc, CC_Q, CC_K, 256, lam, 1.0f - lam_init, IN(10) + l * 64};
            const int bh = C.vcu >> 3, s8 = C.vcu & 7;
            if (ZEROY & 4) zero_fill(C, (v4u*)Yc, 16 * MiB / 16); else
#pragma unroll 1
            for (int j = 0; j < 2; ++j) attn_unit<1>(C, A, bh >> 2, bh & 3, j ? 15 - s8 : s8);
        }
#endif
        grid_bar(bar);
        { KGET(); if (l == 0) { STOPCHK(6, Yb, (size_t)MROWS * 256) STOPCHK(7, Yc, (size_t)MROWS * 256) STOPCHK(8, MASK, (size_t)MROWS * 256) } }
#if PH(6)
        asm volatile("; MARK phase 6");
        { KGET();
            AttnArgs A{PA, VTb, MASK, Ya, CA_Q, CA_K, 0, 0.f, 1.f, nullptr};
            const int bh = C.vcu >> 3, s8 = C.vcu & 7;
            if (ZEROY & 1) zero_fill(C, (v4u*)Ya, 16 * MiB / 16); else
#pragma unroll 1
            for (int j = 0; j < 2; ++j) attn_unit<0>(C, A, bh >> 2, bh & 3, j ? 15 - s8 : s8);
        }
#endif
        grid_bar(bar);
        { KGET(); if (l == 0) { STOPCHK(9, Ya, (size_t)MROWS * 256) } }
#if PH(7)
        asm volatile("; MARK phase 7");
        { KGET();
            pg8::StaticOrder S; S.init(MROWS, DM, C.G, (int)blockIdx.x);
#pragma unroll 1
            for (int i = 0; i < 3; ++i) {
                pg8::Gemm g{i == 0 ? Ya : (i == 1 ? Yb : Yc), WL(WO_B) + (size_t)i * 1024 * 256, MROWS, DM, 256};
                pg8::EpiGate E{Gb, 1024 * i, i == 0 ? nullptr : (i == 1 ? MA : MB), i == 1 ? MB : MA};
                pg8::gemm_phase<pg8::EpiGate, pg8::StaticOrder, true, true>(C.lds, g, S, E);
                wg_barrier();
            }
        }
#endif
        grid_bar(bar);
        { KGET(); if (l == 0) { STOPCHK(10, MA, (size_t)MROWS * DM) } }
#if PH(8)
        asm volatile("; MARK phase 8");
        { KGET();
            pg8::Gemm g{MA, WL(WO_O), MROWS, DM, DM}; pg8::StaticOrder S; S.init(MROWS, DM, C.G, (int)blockIdx.x);
            pg8::EpiResid E{(l == 0) ? IN(0) : (const float*)OUTP, OUTP};
            pg8::gemm_phase<pg8::EpiResid, pg8::StaticOrder, true, true>(C.lds, g, S, E);
        }
#endif
        grid_bar(bar);
        { KGET(); if (l == 0 && K->stop == 11) return; }
#if PH(9)
        asm volatile("; MARK phase 9");
        { KGET(); rmsnorm_rows(C, OUTP, IN(15) + l * DM, Hb, nullptr); }
#endif
        grid_bar(bar);
        { KGET(); if (l == 0) { STOPCHK(12, Hb, (size_t)MROWS * DM) } }
#if PH(10)
        asm volatile("; MARK phase 10");
        { KGET();
            pg8::Gemm g{Hb, WL(WO_F1), MROWS, FF, DM}; pg8::StaticOrder S; S.init(MROWS, FF, C.G, (int)blockIdx.x);
            pg8::EpiAct<1> E{ACT, FF};
            pg8::gemm_phase<pg8::EpiAct<1>, pg8::StaticOrder, true, true>(C.lds, g, S, E);
        }
#endif
        grid_bar(bar);
        { KGET(); if (l == 0) { STOPCHK(13, ACT, (size_t)MROWS * FF) } }
#if PH(11)
        asm volatile("; MARK phase 11");
        { KGET();
            pg8::Gemm g{ACT, WL(WO_F2), MROWS, DM, FF}; pg8::StaticOrder S; S.init(MROWS, DM, C.G, (int)blockIdx.x);
            pg8::EpiResid E{OUTP, OUTP};
            pg8::gemm_phase<pg8::EpiResid, pg8::StaticOrder, true, true>(C.lds, g, S, E);
        }
#endif
        grid_bar(bar);
        { KGET(); if (l == 0 && K->stop == 14) return; }
#if PH(12)
        asm volatile("; MARK phase 12");
        { KGET();
        if (l + 1 < DEPTH) { rmsnorm_rows(C, OUTP, IN(1) + (l + 1) * DM, Hb, nullptr); grid_bar(bar); }
        else rmsnorm_rows(C, OUTP, IN(18), nullptr, OUTP); }
#endif
    }
}

extern "C" void kernel_launch(void* const* d_in, const int* in_sizes, int n_in, void* d_out, int out_size, void* d_ws, size_t ws_size, hipStream_t stream) {
    static int grid = 0;
    if (grid == 0) {
        if (n_in != 19 || in_sizes[0] != MROWS * DM || out_size != MROWS * DM || ws_size < WS_END) { fprintf(stderr, "kernel_launch: unexpected shapes / workspace (n_in %d, ws %zu)\n", n_in, ws_size); grid = -1; return; }
        int dev = 0, cus = 0, per_cu = 0;
        if (hipGetDevice(&dev) != hipSuccess || hipDeviceGetAttribute(&cus, hipDeviceAttributeMultiprocessorCount, dev) != hipSuccess) { grid = -1; return; }
        if (hipFuncSetAttribute((const void*)mk_fwd, hipFuncAttributeMaxDynamicSharedMemorySize, LDS_BYTES) != hipSuccess) { fprintf(stderr, "kernel_launch: hipFuncSetAttribute failed\n"); grid = -1; return; }
        if (hipOccupancyMaxActiveBlocksPerMultiprocessor(&per_cu, (const void*)mk_fwd, NTHREADS, LDS_BYTES) != hipSuccess || per_cu < 1) fprintf(stderr, "kernel_launch: occupancy query says %d\n", per_cu);
        (void)hipGetLastError();
        grid = cus;
    }
    if (grid < 0) return;
    if (hipMemsetAsync((char*)d_ws + WS_CTL, 0, CTL_ZERO_BYTES, stream) != hipSuccess) return;
    Args a{};
    for (int i = 0; i < 19; ++i) a.in[i] = (const float*)d_in[i];
    a.out = (float*)d_out; a.ws = (unsigned char*)d_ws; a.stop = STOP_AT; a.pad = 0;
    hipLaunchKernelGGL(mk_fwd, dim3(grid), dim3(NTHREADS), LDS_BYTES, stream, a);
}
```

```cpp
#include <hip/hip_runtime.h>
#include <hip/hip_bf16.h>
#include <cstdio>
#include <cstdint>
#include <cmath>
__device__ __forceinline__ int lane_id_now() { int l; asm volatile("v_mbcnt_lo_u32_b32 %0, -1, 0\n\tv_mbcnt_hi_u32_b32 %0, -1, %0" : "=v"(l)); return l; }
namespace pg8 {
#define PG8_LAS __attribute__((address_space(3)))
typedef unsigned short bf16_t;
typedef short bf16x8 __attribute__((ext_vector_type(8)));
typedef float f32x4 __attribute__((ext_vector_type(4)));
typedef unsigned u32x4 __attribute__((ext_vector_type(4)));
constexpr int BM = 256, BK = 64, HALF = 128, HTB = HALF * BK * 2  , STAGE_BYTES = 8 * HTB, NXCD = 8, WGM = 8;

__host__ __device__ __forceinline__ int lds_byte(int r, int c) { const int st = (r >> 4) * 2 + (c >> 5), rr = r & 15, cc = c & 31, ob = rr * 64 + cc * 2; return st * 1024 + (ob ^ (((ob >> 9) & 1) << 5)); }
__host__ __device__ __forceinline__ void stage_rc(int b, int& R, int& C) { const int st = b / 1024, sb = b % 1024, swz = sb ^ (((sb >> 9) & 1) << 5); R = (st >> 1) * 16 + swz / 64; C = (st & 1) * 32 + (swz % 64) / 2; }
__host__ __device__ __forceinline__ int perm32(int rho) { const int n = rho >> 4, i = rho & 15; return 8 * (i >> 2) + 4 * n + (i & 3); }

struct Unit { int pm, pn; };
struct Gemm { const bf16_t* A; const bf16_t* Bt; int M, N, K; };

struct StaticOrder {
    int nM, nN, nwg, G, c;
    __host__ __device__ void init(int M, int N, int G_, int c_) { nM = M / BM; nN = N / BM; nwg = nM * nN; G = G_; c = c_; }
    __host__ __device__ bool next(int i, Unit& u) const {
        const long L = (long)i * G + c; if (L >= nwg) return false;
        int wgid = (int)L; { const int q = nwg / NXCD, r = nwg % NXCD, xcd = wgid % NXCD, off = wgid / NXCD; wgid = (xcd < r ? xcd * (q + 1) : r * (q + 1) + (xcd - r) * q) + off; }
        const int nig = WGM * nN, gid = wgid / nig, fm = gid * WGM, gsz = (nM - fm) < WGM ? (nM - fm) : WGM;
        u.pm = fm + ((wgid % nig) % gsz); u.pn = (wgid % nig) / gsz; return true;
    }
    __device__ __forceinline__ void a_ready(const Unit&) const {}
    __device__ __forceinline__ void done(const Unit&) const {}
};

__device__ __forceinline__ unsigned cvt_pk_bf16(float lo, float hi) { unsigned r; asm volatile("v_cvt_pk_bf16_f32 %0, %1, %2" : "=v"(r) : "v"(lo), "v"(hi)); return r; }
typedef float f32x2 __attribute__((ext_vector_type(2)));
__device__ __forceinline__ f32x2 gelu_pk(f32x2 v) {
    const f32x2 av = __builtin_elementwise_abs(v), d = av * 0.2316418882f + 1.0f;
    f32x2 t; t.x = __builtin_amdgcn_rcpf(d.x); t.y = __builtin_amdgcn_rcpf(d.y);
    f32x2 q = t * 0.5307027145f + (-0.7265760135f); q = q * t + 0.7107068705f; q = q * t + (-0.142248368f); q = q * t + 0.127414796f; q = q * t;
    const f32x2 s = (v * v) * (-0.72134752044f);
    f32x2 e; e.x = __builtin_amdgcn_exp2f(s.x); e.y = __builtin_amdgcn_exp2f(s.y);
    const f32x2 m = v * (q * e), r = v - m;
    f32x2 o; o.x = v.x < 0.f ? m.x : r.x; o.y = v.y < 0.f ? m.y : r.y; return o;
}

template <int ACT  > struct EpiBf16 {
    static constexpr bool PERM = true, AFTER_DRAIN = false; static_assert(ACT == 0 || ACT == 1, "EpiBf16: ACT is 0 (none) or 1 (gelu_pk)");
    bf16_t* O; int ldc; const float* bias; int split_cols; size_t split_stride; float scale0;
    __device__ __forceinline__ void operator()(const f32x4 (&acc)[2][2][4][2], const Unit& u, int wr, int wc, int fr, int fq) const {
        const int row0 = u.pm * BM + wr * 64 + fr; int colt = u.pn * BM; bf16_t* base = O;
        float sc = 1.f; if (split_cols) { const int t = colt / split_cols; base += (size_t)t * split_stride; colt -= t * split_cols; if (t == 0) sc = scale0; }
        const int col0 = colt + wc * 32 + 8 * fq, bcol0 = u.pn * BM + wc * 32 + 8 * fq;
        f32x4 bv[2][2];
#pragma unroll
        for (int bj = 0; bj < 2; ++bj)
#pragma unroll
            for (int n = 0; n < 2; ++n) bv[bj][n] = bias ? *(const f32x4*)(bias + bcol0 + bj * HALF + 4 * n) : (f32x4){0.f, 0.f, 0.f, 0.f};
#pragma unroll
        for (int ai = 0; ai < 2; ++ai)
#pragma unroll
            for (int m = 0; m < 4; ++m) { bf16_t* rowp = base + (size_t)(row0 + ai * HALF + m * 16) * ldc + col0;
#pragma unroll
                for (int bj = 0; bj < 2; ++bj) { f32x4 v0 = acc[ai][bj][m][0] + bv[bj][0], v1 = acc[ai][bj][m][1] + bv[bj][1];
                    if (ACT == 1) { f32x2 a = gelu_pk((f32x2){v0[0], v0[1]}), b = gelu_pk((f32x2){v0[2], v0[3]}), c = gelu_pk((f32x2){v1[0], v1[1]}), d = gelu_pk((f32x2){v1[2], v1[3]});
                        v0 = (f32x4){a.x, a.y, b.x, b.y}; v1 = (f32x4){c.x, c.y, d.x, d.y}; }
                    v0 = v0 * sc; v1 = v1 * sc; u32x4 w; w.x = cvt_pk_bf16(v0[0], v0[1]); w.y = cvt_pk_bf16(v0[2], v0[3]); w.z = cvt_pk_bf16(v1[0], v1[1]); w.w = cvt_pk_bf16(v1[2], v1[3]);
                    *(u32x4*)(rowp + bj * HALF) = w; } }
    }
};
typedef float f32x2c __attribute__((ext_vector_type(2))); typedef __bf16 bf16x2c __attribute__((ext_vector_type(2)));
__device__ __forceinline__ unsigned cvtc(float lo, float hi) { f32x2c v = {lo, hi}; bf16x2c b = __builtin_convertvector(v, bf16x2c); return __builtin_bit_cast(unsigned, b); }
__device__ __forceinline__ float bflo(unsigned w) { return __uint_as_float(w << 16); }
__device__ __forceinline__ float bfhi(unsigned w) { return __uint_as_float(w & 0xffff0000u); }
__device__ __forceinline__ float xsum16_32(float s) {
    s += __int_as_float(__builtin_amdgcn_ds_swizzle(__float_as_int(s), 0x401F));
    auto rr = __builtin_amdgcn_permlane32_swap(__float_as_uint(s), __float_as_uint(s), false, false); return __uint_as_float(rr[0]) + __uint_as_float(rr[1]); }
__device__ __forceinline__ float rstd_row(const float* rs, int row) {
    const f32x4 a = *(const f32x4*)(rs + (size_t)row * 16), b = *(const f32x4*)(rs + (size_t)row * 16 + 4), c = *(const f32x4*)(rs + (size_t)row * 16 + 8), d = *(const f32x4*)(rs + (size_t)row * 16 + 12);
    const float s = (((a[0] + a[1]) + (a[2] + a[3])) + ((b[0] + b[1]) + (b[2] + b[3]))) + (((c[0] + c[1]) + (c[2] + c[3])) + ((d[0] + d[1]) + (d[2] + d[3])));
    return 1.0f / sqrtf(s * (1.0f / 1024.0f) + 1e-6f);
}
__device__ __forceinline__ void rstd_table_rows(PG8_LAS float* rl, const float* rs, int rowbase, int lane) {
    const float* p0 = rs + (size_t)(rowbase + lane) * 16; const float* p1 = rs + (size_t)(rowbase + HALF + lane) * 16;
    const f32x4 a0 = *(const f32x4*)(p0), b0 = *(const f32x4*)(p0 + 4), c0 = *(const f32x4*)(p0 + 8), d0 = *(const f32x4*)(p0 + 12);
    const f32x4 a1 = *(const f32x4*)(p1), b1 = *(const f32x4*)(p1 + 4), c1 = *(const f32x4*)(p1 + 8), d1 = *(const f32x4*)(p1 + 12);
    const float s0 = (((a0[0] + a0[1]) + (a0[2] + a0[3])) + ((b0[0] + b0[1]) + (b0[2] + b0[3]))) + (((c0[0] + c0[1]) + (c0[2] + c0[3])) + ((d0[0] + d0[1]) + (d0[2] + d0[3])));
    const float s1 = (((a1[0] + a1[1]) + (a1[2] + a1[3])) + ((b1[0] + b1[1]) + (b1[2] + b1[3]))) + (((c1[0] + c1[1]) + (c1[2] + c1[3])) + ((d1[0] + d1[1]) + (d1[2] + d1[3])));
    rl[lane] = 1.0f / sqrtf(s0 * (1.0f / 1024.0f) + 1e-6f); rl[64 + lane] = 1.0f / sqrtf(s1 * (1.0f / 1024.0f) + 1e-6f);
}
__device__ __forceinline__ float sigmoidf_fast(float v) { return __builtin_amdgcn_rcpf(1.0f + __builtin_amdgcn_exp2f(-1.4426950408889634f * v)); }

struct EpiProj {
    static constexpr bool PERM = true, AFTER_DRAIN = false;
    bf16_t* P; bf16_t* G; bf16_t* kidx; const float* kg; const float* kb; const float* rs; PG8_LAS float* rlb; unsigned* nrm; mutable int tab_pm = -1;
    __device__ __forceinline__ void operator()(const f32x4 (&acc)[2][2][4][2], const Unit& u, int wr, int wc, int fr_, int fq_) const {
        int fr = fr_, fq = fq_; asm volatile("" : "+v"(fr), "+v"(fq));
        const int row0 = u.pm * BM + wr * 64 + fr;
        PG8_LAS float* rl = rlb + (wr * 4 + wc) * 128; if (u.pm != tab_pm) { rstd_table_rows(rl, rs, u.pm * BM + wr * 64, fr + 16 * fq); tab_pm = u.pm; }
        {
            const int col0 = u.pn * BM + wc * 32 + 8 * fq;
            const bool want = (u.pn < 2) || (u.pn >= 6);
            float mxg[2] = {0.f, 0.f};
#pragma unroll
            for (int ai = 0; ai < 2; ++ai)
#pragma unroll
                for (int m = 0; m < 4; ++m) { bf16_t* rowp = P + (size_t)(row0 + ai * HALF + m * 16) * 2048 + col0; const float rsd = rl[64 * ai + 16 * m + fr];
#pragma unroll
                    for (int bj = 0; bj < 2; ++bj) { const f32x4 v0 = acc[ai][bj][m][0] * rsd, v1 = acc[ai][bj][m][1] * rsd;
                        u32x4 w; w.x = cvtc(v0[0], v0[1]); w.y = cvtc(v0[2], v0[3]); w.z = cvtc(v1[0], v1[1]); w.w = cvtc(v1[2], v1[3]);
                        *(u32x4*)(rowp + bj * HALF) = w;
                        if (want) { float q = ((v0[0] * v0[0] + v0[1] * v0[1]) + (v0[2] * v0[2] + v0[3] * v0[3])) + ((v1[0] * v1[0] + v1[1] * v1[1]) + (v1[2] * v1[2] + v1[3] * v1[3]));
                            q = xsum16_32(q); mxg[bj] = fmaxf(mxg[bj], q); } } }
            if (want) {
#pragma unroll
                for (int bj = 0; bj < 2; ++bj) { float v = mxg[bj];
                    v = fmaxf(v, __int_as_float(__builtin_amdgcn_ds_swizzle(__float_as_int(v), 0x041F))); v = fmaxf(v, __int_as_float(__builtin_amdgcn_ds_swizzle(__float_as_int(v), 0x081F)));
                    v = fmaxf(v, __int_as_float(__builtin_amdgcn_ds_swizzle(__float_as_int(v), 0x101F))); v = fmaxf(v, __int_as_float(__builtin_amdgcn_ds_swizzle(__float_as_int(v), 0x201F)));
                    if ((fr | fq) == 0) atomicMax(nrm + (u.pm >> 4) * 64 + u.pn * 8 + bj * 4 + wc, __float_as_uint(v)); } }
            if (u.pn == 3 && wc == 0) {
                f32x4 gq[2][2], bq[2][2];
#pragma unroll
                for (int bj = 0; bj < 2; ++bj) { gq[bj][0] = *(const f32x4*)(kg + bj * 32 + 8 * fq); gq[bj][1] = *(const f32x4*)(kg + bj * 32 + 8 * fq + 4); bq[bj][0] = *(const f32x4*)(kb + bj * 32 + 8 * fq); bq[bj][1] = *(const f32x4*)(kb + bj * 32 + 8 * fq + 4); }
#pragma unroll
                for (int ai = 0; ai < 2; ++ai)
#pragma unroll
                    for (int m = 0; m < 4; ++m) {
                        const float rsd = rl[64 * ai + 16 * m + fr];
                        f32x4 xs[2][2];
#pragma unroll
                        for (int bj = 0; bj < 2; ++bj)
#pragma unroll
                            for (int n = 0; n < 2; ++n) xs[bj][n] = acc[ai][bj][m][n] * rsd;
                        float s = 0.f;
#pragma unroll
                        for (int bj = 0; bj < 2; ++bj)
#pragma unroll
                            for (int n = 0; n < 2; ++n) { const f32x4 x = xs[bj][n]; s += (x[0] + x[1]) + (x[2] + x[3]); }
                        s = xsum16_32(s);
                        const float mu = s * (1.0f / 64.0f); float q = 0.f;
#pragma unroll
                        for (int bj = 0; bj < 2; ++bj)
#pragma unroll
                            for (int n = 0; n < 2; ++n) { const f32x4 d = xs[bj][n] - mu; q += (d[0] * d[0] + d[1] * d[1]) + (d[2] * d[2] + d[3] * d[3]); }
                        q = xsum16_32(q);
                        const float rstd = 1.0f / sqrtf(q * (1.0f / 64.0f) + 1e-6f);
                        const int R = row0 + ai * HALF + m * 16;
                        bf16_t* kp = kidx + ((size_t)((R >> 5) * 8 + fq) * 32 + (R & 31)) * 8;
#pragma unroll
                        for (int bj = 0; bj < 2; ++bj) { const f32x4 g0 = gq[bj][0], g1 = gq[bj][1], b0 = bq[bj][0], b1 = bq[bj][1];
                            const f32x4 y0 = (xs[bj][0] - mu) * rstd * g0 + b0, y1 = (xs[bj][1] - mu) * rstd * g1 + b1;
                            u32x4 w; w.x = cvtc(y0[0], y0[1]); w.y = cvtc(y0[2], y0[3]); w.z = cvtc(y1[0], y1[1]); w.w = cvtc(y1[2], y1[3]);
                            *(u32x4*)(kp + bj * 4 * 32 * 8) = w; }
                        asm volatile("" ::: "memory");
                    }
            }
        }
    }
};
__device__ __forceinline__ float ub(unsigned w, int i) { return (float)((w >> (8 * i)) & 0xffu); }
__device__ __forceinline__ size_t gate_tile_off(int g, int pm, int pn, int wr, int wc, int fr, int fq) { return ((size_t)((g * 128 + pm) * 4 + pn)) * 65536 + (size_t)((wr * 4 + wc) * 8192 + (fq * 16 + fr) * 16); }
struct EpiGates {
    static constexpr bool PERM = true, AFTER_DRAIN = false;
    unsigned char* G8; float scale; const float* rs; PG8_LAS float* rlb; mutable int tab_pm = -1;
    __device__ __forceinline__ void operator()(const f32x4 (&acc)[2][2][4][2], const Unit& u, int wr, int wc, int fr_, int fq_) const {
        int fr = fr_, fq = fq_; asm volatile("" : "+v"(fr), "+v"(fq));
        PG8_LAS float* rl = rlb + (wr * 4 + wc) * 128; if (u.pm != tab_pm) { rstd_table_rows(rl, rs, u.pm * BM + wr * 64, fr + 16 * fq); tab_pm = u.pm; }
        unsigned char* tp = G8 + gate_tile_off(u.pn >> 2, u.pm, u.pn & 3, wr, wc, fr, fq);
#pragma unroll
        for (int ai = 0; ai < 2; ++ai)
#pragma unroll
            for (int m = 0; m < 4; ++m) { const float ns = -1.4426950408889634f * scale * rl[64 * ai + 16 * m + fr];
                u32x4 w;
#pragma unroll
                for (int bj = 0; bj < 2; ++bj) { const f32x4 v0 = acc[ai][bj][m][0], v1 = acc[ai][bj][m][1];
                    unsigned lo = 0u, hi = 0u;
#pragma unroll
                    for (int e2 = 0; e2 < 4; ++e2) {
                        const float ga = fmaxf(255.0f * __builtin_amdgcn_rcpf(1.0f + __builtin_amdgcn_exp2f(ns * v0[e2])), 1.0f), gb = fmaxf(255.0f * __builtin_amdgcn_rcpf(1.0f + __builtin_amdgcn_exp2f(ns * v1[e2])), 1.0f);
                        lo = __builtin_amdgcn_cvt_pk_u8_f32(ga, e2, lo); hi = __builtin_amdgcn_cvt_pk_u8_f32(gb, e2, hi); }
                    if (bj == 0) { w.x = lo; w.y = hi; } else { w.z = lo; w.w = hi; } }
                *(u32x4*)(tp + (ai * 4 + m) * 1024) = w; }
    }
};
template <int ACT> struct EpiAct {
    static constexpr bool PERM = true, AFTER_DRAIN = false;
    bf16_t* O; int ldc; const float* rs; PG8_LAS float* rlb; mutable int tab_pm = -1;
    __device__ __forceinline__ void operator()(const f32x4 (&acc)[2][2][4][2], const Unit& u, int wr, int wc, int fr_, int fq_) const {
        int fr = fr_, fq = fq_; asm volatile("" : "+v"(fr), "+v"(fq));
        const int row0 = u.pm * BM + wr * 64 + fr; const int col0 = u.pn * BM + wc * 32 + 8 * fq;
        PG8_LAS float* rl = rlb + (wr * 4 + wc) * 128; if (u.pm != tab_pm) { rstd_table_rows(rl, rs, u.pm * BM + wr * 64, fr + 16 * fq); tab_pm = u.pm; }
#pragma unroll
        for (int ai = 0; ai < 2; ++ai)
#pragma unroll
            for (int m = 0; m < 4; ++m) { bf16_t* rowp = O + (size_t)(row0 + ai * HALF + m * 16) * ldc + col0; const float rsd = rl[64 * ai + 16 * m + fr];
#pragma unroll
                for (int bj = 0; bj < 2; ++bj) { f32x4 v0 = acc[ai][bj][m][0] * rsd, v1 = acc[ai][bj][m][1] * rsd;
                    if (ACT == 1) {
#pragma unroll
                        for (int e = 0; e < 4; ++e) { const int ia = __float_as_int(v0[e]), ib = __float_as_int(v1[e]); const float a = __int_as_float(ia > 0 ? ia : 0), b = __int_as_float(ib > 0 ? ib : 0); v0[e] = a * a; v1[e] = b * b; } }
                    u32x4 w; w.x = cvtc(v0[0], v0[1]); w.y = cvtc(v0[2], v0[3]); w.z = cvtc(v1[0], v1[1]); w.w = cvtc(v1[2], v1[3]);
                    *(u32x4*)(rowp + bj * HALF) = w; } }
    }
};
struct EpiVT {
    static constexpr bool PERM = true, AFTER_DRAIN = false;
    bf16_t* O; int ldc; const float* rs; PG8_LAS float* rlb;
    __device__ __forceinline__ void operator()(const f32x4 (&acc)[2][2][4][2], const Unit& u, int wr, int wc, int fr_, int fq_) const {
        int fr = fr_, fq = fq_; asm volatile("" : "+v"(fr), "+v"(fq));
        const int row0 = u.pm * BM + wr * 64 + fr; const int col0 = u.pn * BM + wc * 32 + 8 * fq;
        PG8_LAS float* rl = rlb + (wr * 4 + wc) * 128; { const int L = fr + 16 * fq; rl[L] = rstd_row(rs, u.pn * BM + wc * 32 + (L & 31) + (L >> 5) * HALF); }
#pragma unroll
        for (int bj = 0; bj < 2; ++bj) { float rc[8];
#pragma unroll
            for (int e2 = 0; e2 < 8; ++e2) rc[e2] = rl[bj * 32 + 8 * fq + e2];
#pragma unroll
            for (int ai = 0; ai < 2; ++ai)
#pragma unroll
                for (int m = 0; m < 4; ++m) { bf16_t* rowp = O + (size_t)(row0 + ai * HALF + m * 16) * ldc + col0; const f32x4 v0 = acc[ai][bj][m][0], v1 = acc[ai][bj][m][1];
                    u32x4 w; w.x = cvtc(v0[0] * rc[0], v0[1] * rc[1]); w.y = cvtc(v0[2] * rc[2], v0[3] * rc[3]); w.z = cvtc(v1[0] * rc[4], v1[1] * rc[5]); w.w = cvtc(v1[2] * rc[6], v1[3] * rc[7]);
                    *(u32x4*)(rowp + bj * HALF) = w; } }
    }
};
struct HookGate {
    static constexpr bool ACTIVE = true;
    const unsigned char* G8;
    __device__ __forceinline__ void mid(f32x4 (&acc)[2][2][4][2], const Unit& u, int kt, int wr, int wc, int fr_, int fq_) const {
        if (kt != 4 && kt != 8) return;
        int fr = fr_, fq = fq_; asm volatile("" : "+v"(fr), "+v"(fq));
        const int g0 = kt == 4 ? 0 : 1;
        const unsigned char* np = G8 + gate_tile_off(g0, u.pm, u.pn, wr, wc, fr, fq); const unsigned char* dp = G8 + gate_tile_off(g0 + 1, u.pm, u.pn, wr, wc, fr, fq);
#pragma unroll
        for (int ai = 0; ai < 2; ++ai)
#pragma unroll
            for (int m = 0; m < 4; ++m) { const u32x4 gn = *(const u32x4*)(np + (ai * 4 + m) * 1024), gd = *(const u32x4*)(dp + (ai * 4 + m) * 1024);
                f32x4 r0, r1, r2, r3;
#pragma unroll
                for (int e2 = 0; e2 < 4; ++e2) { r0[e2] = ub(gn.x, e2) * __builtin_amdgcn_rcpf(ub(gd.x, e2)); r1[e2] = ub(gn.y, e2) * __builtin_amdgcn_rcpf(ub(gd.y, e2));
                    r2[e2] = ub(gn.z, e2) * __builtin_amdgcn_rcpf(ub(gd.z, e2)); r3[e2] = ub(gn.w, e2) * __builtin_amdgcn_rcpf(ub(gd.w, e2)); }
                acc[ai][0][m][0] *= r0; acc[ai][0][m][1] *= r1; acc[ai][1][m][0] *= r2; acc[ai][1][m][1] *= r3;
                if (m == 3) asm volatile("" ::: "memory"); }
    }
};
struct EpiGateC {
    static constexpr bool PERM = true, AFTER_DRAIN = false;
    const unsigned char* G8; bf16_t* Mo;
    __device__ __forceinline__ void operator()(const f32x4 (&acc)[2][2][4][2], const Unit& u, int wr, int wc, int fr_, int fq_) const {
        int fr = fr_, fq = fq_; asm volatile("" : "+v"(fr), "+v"(fq));
        const int row0 = u.pm * BM + wr * 64 + fr; const int col0 = u.pn * BM + wc * 32 + 8 * fq;
        const unsigned char* gp = G8 + gate_tile_off(2, u.pm, u.pn, wr, wc, fr, fq); const float s255 = 1.0f / 255.0f;
        u32x4 gall[8];
#pragma unroll
        for (int i = 0; i < 8; ++i) gall[i] = *(const u32x4*)(gp + i * 1024);
#pragma unroll
        for (int ai = 0; ai < 2; ++ai)
#pragma unroll
            for (int m = 0; m < 4; ++m) { const size_t r = (size_t)(row0 + ai * HALF + m * 16); const u32x4 g = gall[ai * 4 + m];
#pragma unroll
                for (int bj = 0; bj < 2; ++bj) { const f32x4 v0 = acc[ai][bj][m][0], v1 = acc[ai][bj][m][1]; const unsigned glo = bj ? g.z : g.x, ghi = bj ? g.w : g.y;
                    u32x4 w; w.x = cvtc(ub(glo, 0) * s255 * v0[0], ub(glo, 1) * s255 * v0[1]); w.y = cvtc(ub(glo, 2) * s255 * v0[2], ub(glo, 3) * s255 * v0[3]); w.z = cvtc(ub(ghi, 0) * s255 * v1[0], ub(ghi, 1) * s255 * v1[1]); w.w = cvtc(ub(ghi, 2) * s255 * v1[2], ub(ghi, 3) * s255 * v1[3]);
                    *(u32x4*)(Mo + r * 1024 + col0 + bj * HALF) = w; }
                asm volatile("" ::: "memory"); }
    }
};
struct EpiResid {
    static constexpr bool PERM = true, AFTER_DRAIN = false;
    const float* base32; const bf16_t* base16; bf16_t* out16; float* rs; unsigned char* out8;
    __device__ __forceinline__ void operator()(const f32x4 (&acc)[2][2][4][2], const Unit& u, int wr, int wc, int fr_, int fq_) const {
        int fr = fr_, fq = fq_; asm volatile("" : "+v"(fr), "+v"(fq));
        const int col0 = u.pn * BM + wc * 32 + 8 * fq;
        typedef unsigned u32x2g __attribute__((ext_vector_type(2)));
#pragma unroll
        for (int ai = 0; ai < 2; ++ai)
#pragma unroll
            for (int m = 0; m < 4; ++m) { const int row = u.pm * BM + ai * HALF + wr * 64 + m * 16 + fr; const size_t off = (size_t)row * 1024 + col0;
                float q = 0.f;
#pragma unroll
                for (int bj = 0; bj < 2; ++bj) { f32x4 b0, b1;
                    if (base32) { b0 = *(const f32x4*)(base32 + off + bj * HALF); b1 = *(const f32x4*)(base32 + off + bj * HALF + 4); }
                    else { const u32x4 p = *(const u32x4*)(base16 + off + bj * HALF); b0 = (f32x4){bflo(p.x), bfhi(p.x), bflo(p.y), bfhi(p.y)}; b1 = (f32x4){bflo(p.z), bfhi(p.z), bflo(p.w), bfhi(p.w)}; }
                    const f32x4 o0 = b0 + acc[ai][bj][m][0], o1 = b1 + acc[ai][bj][m][1];
                    u32x4 w; w.x = cvtc(o0[0], o0[1]); w.y = cvtc(o0[2], o0[3]); w.z = cvtc(o1[0], o1[1]); w.w = cvtc(o1[2], o1[3]);
                    *(u32x4*)(out16 + off + bj * HALF) = w;
                    if (out8) { int lo = __builtin_amdgcn_cvt_pk_fp8_f32(o0[0], o0[1], 0, false); lo = __builtin_amdgcn_cvt_pk_fp8_f32(o0[2], o0[3], lo, true);
                        int hi = __builtin_amdgcn_cvt_pk_fp8_f32(o1[0], o1[1], 0, false); hi = __builtin_amdgcn_cvt_pk_fp8_f32(o1[2], o1[3], hi, true);
                        *(u32x2g*)(out8 + off + bj * HALF) = (u32x2g){(unsigned)lo, (unsigned)hi}; }
                    q += ((o0[0] * o0[0] + o0[1] * o0[1]) + (o0[2] * o0[2] + o0[3] * o0[3])) + ((o1[0] * o1[0] + o1[1] * o1[1]) + (o1[2] * o1[2] + o1[3] * o1[3])); }
                q = xsum16_32(q);
                if (fq == 0) rs[(size_t)row * 16 + u.pn * 4 + wc] = q;
                if (m == 3) asm volatile("" ::: "memory"); }
    }
};
template <bool C, class A, class B> struct Cond_ { typedef A T; };
template <class A, class B> struct Cond_<false, A, B> { typedef B T; };
struct NoHook { static constexpr bool ACTIVE = false; __device__ __forceinline__ void mid(f32x4 (&)[2][2][4][2], const Unit&, int, int, int, int, int) const {} };
template <class Epi, class Sched, bool ALIGN_EPI = false, bool SP2 = false, int KC = 0, class Hook = NoHook, bool FP8 = false>
__device__ __forceinline__ void gemm_phase(PG8_LAS unsigned char* lds, const Gemm g, const Sched& S, const Epi& E, const Hook& H = Hook(), int wave_in = -1) {
    int tid_ = wave_in >= 0 ? wave_in * 64 + lane_id_now() : (int)threadIdx.x; asm volatile("" : "+v"(tid_));
    const int tid = tid_, wid = __builtin_amdgcn_readfirstlane(tid >> 6), lane = tid & 63, wr = wid >> 2, wc = wid & 3, fr = lane & 15, fq = lane >> 4;
    const int K = KC ? KC : g.K, nt = K / BK;
    unsigned voffA[2], voffB[2];
#pragma unroll
    for (int i = 0; i < 2; ++i) { int R, C; stage_rc(tid * 16 + i * 8192, R, C); const int Rb = Epi::PERM ? ((R & ~31) + perm32(R & 31)) : R;
        voffA[i] = (unsigned)(R * K + C) * 2u; voffB[i] = (unsigned)(Rb * K + C) * 2u; }
    const size_t kstep = (size_t)(BK * 2);
    const size_t hstep = (size_t)HALF * K * 2;
    const size_t tstep = 2 * hstep;
    const unsigned ldsw = (unsigned)wid * 1024u;
    const int aoff = lds_byte(wr * 64 + fr, fq * 8), boff = lds_byte(wc * 32 + fr, fq * 8);
#define PG8_SA(b, h) (((b) * 2 + (h)) * HTB)
#define PG8_SB(b, h) ((4 + (b) * 2 + (h)) * HTB)
#define PG8_STAGE(bufoff, gbase, voff) do { _Pragma("unroll") for (int _i = 0; _i < 2; ++_i) \
        __builtin_amdgcn_global_load_lds((const unsigned*)((const char*)(gbase) + (voff)[_i]), (PG8_LAS unsigned*)(lds + (bufoff) + ldsw + _i * 8192), 16, 0, 0); } while (0)
#define PG8_RD16(off) (*(const PG8_LAS bf16x8*)(lds + (off)))
#define PG8_CAT8(lo, hi) __builtin_shufflevector(__builtin_bit_cast(v4i_, (lo)), __builtin_bit_cast(v4i_, (hi)), 0, 1, 2, 3, 4, 5, 6, 7)
#define PG8_LDA(dst, b, h) do { _Pragma("unroll") for (int m = 0; m < 4; ++m) { if constexpr (FP8) dst[m][0] = PG8_CAT8(PG8_RD16(PG8_SA(b, h) + aoff + m * 2048), PG8_RD16(PG8_SA(b, h) + aoff + m * 2048 + 1024)); \
        else { _Pragma("unroll") for (int k = 0; k < 2; ++k) dst[m][k] = PG8_RD16(PG8_SA(b, h) + aoff + m * 2048 + k * 1024); } } } while (0)
#define PG8_LDB(dst, b, h) do { _Pragma("unroll") for (int n = 0; n < 2; ++n) { if constexpr (FP8) dst[n][0] = PG8_CAT8(PG8_RD16(PG8_SB(b, h) + boff + n * 2048), PG8_RD16(PG8_SB(b, h) + boff + n * 2048 + 1024)); \
        else { _Pragma("unroll") for (int k = 0; k < 2; ++k) dst[n][k] = PG8_RD16(PG8_SB(b, h) + boff + n * 2048 + k * 1024); } } } while (0)
#define PG8_MMA(ai, bj, At, Bt) do { __builtin_amdgcn_s_setprio(1); \
        if constexpr (FP8) { _Pragma("unroll") for (int m = 0; m < 4; ++m) _Pragma("unroll") for (int n = 0; n < 2; ++n) \
            asm volatile("v_mfma_f32_16x16x128_f8f6f4 %0, %1, %2, %0" : "+v"(acc[ai][bj][m][n]) : "v"(Bt[n][0]), "v"(At[m][0])); } \
        else { _Pragma("unroll") for (int m = 0; m < 4; ++m) _Pragma("unroll") for (int n = 0; n < 2; ++n) _Pragma("unroll") for (int k = 0; k < 2; ++k) \
            acc[ai][bj][m][n] = __builtin_amdgcn_mfma_f32_16x16x32_bf16(Bt[n][k], At[m][k], acc[ai][bj][m][n], 0, 0, 0); } \
        __builtin_amdgcn_s_setprio(0); } while (0)
#define PG8_WAIT_V(n) asm volatile("s_waitcnt vmcnt(" #n ")" ::: "memory")
#define PG8_WAIT_L(n) asm volatile("s_waitcnt lgkmcnt(" #n ")" ::: "memory")
#define PG8_BAR __builtin_amdgcn_s_barrier()
#define PG8_SCHED __builtin_amdgcn_sched_barrier(0)
    Unit cur, nxt; int ui = 0;
    if (!S.next(0, cur)) return;
    f32x4 acc[2][2][4][2];
#pragma unroll
    for (int a = 0; a < 2; ++a)
#pragma unroll
        for (int b = 0; b < 2; ++b)
#pragma unroll
            for (int m = 0; m < 4; ++m)
#pragma unroll
                for (int n = 0; n < 2; ++n) acc[a][b][m][n] = (f32x4){0.f, 0.f, 0.f, 0.f};
    typedef int v4i_ __attribute__((ext_vector_type(4))); typedef int v8i_ __attribute__((ext_vector_type(8)));
    struct FragSel { typedef v8i_ T8; typedef bf16x8 T16; };
    typedef typename Cond_<FP8, v8i_, bf16x8>::T Frag_;
    Frag_ At[4][FP8 ? 1 : 2], B0[2][FP8 ? 1 : 2], B1[2][FP8 ? 1 : 2];
    const char* cA = (const char*)g.A + (size_t)cur.pm * tstep; const char* cB = (const char*)g.Bt + (size_t)cur.pn * tstep;
    S.a_ready(cur);
    if constexpr (SP2) {
        PG8_STAGE(PG8_SB(0, 0), cB, voffB); PG8_STAGE(PG8_SB(0, 1), cB + hstep, voffB); PG8_STAGE(PG8_SA(0, 0), cA, voffA); PG8_STAGE(PG8_SA(0, 1), cA + hstep, voffA);
        if (wr == 1) PG8_BAR;
        PG8_WAIT_V(2); PG8_BAR;
        PG8_STAGE(PG8_SB(1, 0), cB + kstep, voffB); PG8_STAGE(PG8_SA(1, 0), cA + kstep, voffA); PG8_STAGE(PG8_SB(1, 1), cB + hstep + kstep, voffB);
        PG8_WAIT_V(6); PG8_BAR;
    } else {
        PG8_STAGE(PG8_SB(0, 0), cB, voffB); PG8_STAGE(PG8_SA(0, 0), cA, voffA); PG8_STAGE(PG8_SB(0, 1), cB + hstep, voffB); PG8_STAGE(PG8_SA(0, 1), cA + hstep, voffA);
        if (wr == 1) PG8_BAR;
        PG8_WAIT_V(4); PG8_BAR;
        PG8_STAGE(PG8_SB(1, 0), cB + kstep, voffB); PG8_STAGE(PG8_SA(1, 0), cA + kstep, voffA); PG8_STAGE(PG8_SB(1, 1), cB + hstep + kstep, voffB);
        PG8_WAIT_V(6); PG8_BAR;
    }
    for (;;) {
        const bool has_next = S.next(ui + 1, nxt);
        const char* nA = has_next ? (const char*)g.A + (size_t)nxt.pm * tstep : cA; const char* nB = has_next ? (const char*)g.Bt + (size_t)nxt.pn * tstep : cB;
_Pragma("unroll 1")
        for (int t = 0; t < nt; t += 2) {
            const bool last = (t == nt - 2);
            const char* a1 = cA + (size_t)(t + 1) * kstep;
            const char* a2 = last ? nA : cA + (size_t)(t + 2) * kstep; const char* b2 = last ? nB : cB + (size_t)(t + 2) * kstep;
            const char* a3 = a2 + kstep; const char* b3 = b2 + kstep;
            if (last && has_next) S.a_ready(nxt);
            if constexpr (SP2) {
            PG8_LDB(B0, 0, 0); PG8_LDB(B1, 0, 1); PG8_SCHED; PG8_LDA(At, 0, 0); PG8_STAGE(PG8_SA(1, 1), a1 + hstep, voffA);
            PG8_WAIT_V(8); PG8_WAIT_L(0); PG8_BAR; PG8_MMA(0, 0, At, B0); PG8_MMA(0, 1, At, B1); PG8_BAR; PG8_SCHED;
            PG8_LDA(At, 0, 1); PG8_STAGE(PG8_SB(0, 0), b2, voffB); PG8_STAGE(PG8_SB(0, 1), b2 + hstep, voffB); PG8_STAGE(PG8_SA(0, 0), a2, voffA);
            PG8_WAIT_V(8); PG8_WAIT_L(0); PG8_BAR; PG8_MMA(1, 0, At, B0); PG8_MMA(1, 1, At, B1); PG8_BAR; PG8_SCHED;
            PG8_LDB(B0, 1, 0); PG8_LDB(B1, 1, 1); PG8_SCHED; PG8_LDA(At, 1, 0); PG8_STAGE(PG8_SA(0, 1), a2 + hstep, voffA);
            PG8_WAIT_V(8); PG8_WAIT_L(0); PG8_BAR; PG8_MMA(0, 0, At, B0); PG8_MMA(0, 1, At, B1); PG8_BAR; PG8_SCHED;
            PG8_LDA(At, 1, 1); PG8_STAGE(PG8_SB(1, 0), b3, voffB); PG8_STAGE(PG8_SB(1, 1), b3 + hstep, voffB); PG8_STAGE(PG8_SA(1, 0), a3, voffA);
            PG8_WAIT_V(8); PG8_WAIT_L(0); PG8_BAR; PG8_MMA(1, 0, At, B0); PG8_MMA(1, 1, At, B1); PG8_BAR; PG8_SCHED;
            } else {
            PG8_LDB(B0, 0, 0); PG8_SCHED; PG8_LDA(At, 0, 0); PG8_STAGE(PG8_SA(1, 1), a1 + hstep, voffA);
            PG8_WAIT_L(8); PG8_BAR; PG8_WAIT_L(0); PG8_MMA(0, 0, At, B0); PG8_BAR; PG8_SCHED;
            PG8_LDB(B1, 0, 1); PG8_STAGE(PG8_SB(0, 0), b2, voffB);
            PG8_BAR; PG8_WAIT_L(0); PG8_MMA(0, 1, At, B1); PG8_BAR;
            PG8_LDA(At, 0, 1); PG8_STAGE(PG8_SA(0, 0), a2, voffA);
            PG8_BAR; PG8_WAIT_L(0); PG8_MMA(1, 0, At, B0); PG8_BAR; PG8_SCHED;
            PG8_STAGE(PG8_SB(0, 1), b2 + hstep, voffB);
            PG8_WAIT_V(6); PG8_BAR; PG8_MMA(1, 1, At, B1); PG8_BAR;
            PG8_LDB(B0, 1, 0); PG8_SCHED; PG8_LDA(At, 1, 0); PG8_STAGE(PG8_SA(0, 1), a2 + hstep, voffA);
            PG8_WAIT_L(8); PG8_BAR; PG8_WAIT_L(0); PG8_MMA(0, 0, At, B0); PG8_BAR; PG8_SCHED;
            PG8_LDB(B1, 1, 1); PG8_STAGE(PG8_SB(1, 0), b3, voffB);
            PG8_BAR; PG8_WAIT_L(0); PG8_MMA(0, 1, At, B1); PG8_BAR;
            PG8_LDA(At, 1, 1); PG8_STAGE(PG8_SA(1, 0), a3, voffA);
            PG8_BAR; PG8_WAIT_L(0); PG8_MMA(1, 0, At, B0); PG8_BAR; PG8_SCHED;
            PG8_STAGE(PG8_SB(1, 1), b3 + hstep, voffB);
            PG8_WAIT_V(6); PG8_BAR; PG8_MMA(1, 1, At, B1); PG8_BAR;
            }
            if constexpr (Hook::ACTIVE) { if (t + 2 < nt) H.mid(acc, cur, t + 2, wr, wc, fr, fq); }
        }
        if constexpr (FP8) asm volatile("s_nop 15\n\ts_nop 15\n\ts_nop 15\n\ts_nop 15" ::: "memory");
        if constexpr (ALIGN_EPI) { if (wr == 0) PG8_BAR; }
        if constexpr (!Epi::AFTER_DRAIN) { E(acc, cur, wr, wc, fr, fq); S.done(cur); }
        if (!has_next) break;
#pragma unroll
        for (int a = 0; a < 2; ++a)
#pragma unroll
            for (int b = 0; b < 2; ++b)
#pragma unroll
                for (int m = 0; m < 4; ++m)
#pragma unroll
                    for (int n = 0; n < 2; ++n) acc[a][b][m][n] = (f32x4){0.f, 0.f, 0.f, 0.f};
        cur = nxt; cA = nA; cB = nB; ++ui;
        if constexpr (ALIGN_EPI) { if (wr == 1) PG8_BAR; }
    }
    PG8_WAIT_V(0);
    if constexpr (!ALIGN_EPI) { if (wr == 0) PG8_BAR; }
    PG8_BAR;
    if constexpr (Epi::AFTER_DRAIN) { E.fused(acc, cur, wr, wc, fr, fq, lds, wid, lane); S.done(cur); }
#undef PG8_SA
#undef PG8_SB
#undef PG8_STAGE
#undef PG8_RD16
#undef PG8_CAT8
#undef PG8_LDA
#undef PG8_LDB
#undef PG8_MMA
#undef PG8_WAIT_V
#undef PG8_WAIT_L
#undef PG8_BAR
#undef PG8_SCHED
}
}
#define GAS __attribute__((address_space(1)))
#define LAS __attribute__((address_space(3)))
typedef unsigned short bf16;
typedef unsigned v4u __attribute__((ext_vector_type(4)));
typedef float f32x4 __attribute__((ext_vector_type(4)));
typedef short bf16x8 __attribute__((ext_vector_type(8)));
typedef GAS unsigned gu32;
typedef GAS unsigned long long gu64;
#define RLX_AGENT __ATOMIC_RELAXED, __HIP_MEMORY_SCOPE_AGENT
#define LDS_WAIT() asm volatile("s_waitcnt lgkmcnt(0)" ::: "memory")
#define VM_WAIT() asm volatile("s_waitcnt vmcnt(0)" ::: "memory")
__device__ __forceinline__ unsigned long long rt() { return __builtin_amdgcn_s_memrealtime(); }
__device__ __forceinline__ unsigned f2bf(float f) { unsigned u = __builtin_bit_cast(unsigned, f); return (u + 0x7fffu + ((u >> 16) & 1u)) >> 16; }
__device__ __forceinline__ unsigned pk2(float lo, float hi) { return f2bf(lo) | (f2bf(hi) << 16); }

#define XB_TMO      128
#define XB_XCNT(j)  (256  + 64 * (j))
#define XB_XSUB(j)  (1280 + 64 * (j))
#define XB_XGEN(j)  (2304 + 64 * (j))
#define XB_TOP      3328
#define XB_TOPGEN   3392
#define XCD_BAR_WORDS 3456
#define XB_SPIN_CAP (1u << 22)

__device__ __forceinline__ unsigned xb_ld(unsigned* p)              { return __hip_atomic_load(p, __ATOMIC_RELAXED, __HIP_MEMORY_SCOPE_AGENT); }
__device__ __forceinline__ unsigned xb_add(unsigned* p, unsigned v) { return __hip_atomic_fetch_add(p, v, __ATOMIC_RELAXED, __HIP_MEMORY_SCOPE_AGENT); }
__device__ __forceinline__ unsigned xb_xcc_id() { return (unsigned)__builtin_amdgcn_s_getreg((3 << 11) | 20) & 0xFu; }
#define XB_SPIN(cond, bar) do { unsigned _sp = 0; while (cond) { __builtin_amdgcn_s_sleep(1); \
    if ((++_sp & 255u) == 0u) { if (xb_ld(&(bar)[XB_TMO])) break; if (_sp > XB_SPIN_CAP) { atomicAdd(&(bar)[XB_TMO], 1u); break; } } } } while (0)

struct XcdBarrier {
    unsigned* bar; unsigned x; unsigned w0;
    volatile LAS unsigned* st;
};

__device__ __forceinline__ XcdBarrier xcd_barrier_post(unsigned* bar, volatile LAS unsigned* st) {
    XcdBarrier b; b.bar = bar; b.x = xb_xcc_id(); b.st = st; { unsigned wv_ = (unsigned)__builtin_amdgcn_readfirstlane((int)(threadIdx.x >> 6)); asm volatile("" : "+s"(wv_)); b.w0 = wv_; }
    if (threadIdx.x == 0) (void)xb_add(&bar[XB_XCNT(b.x)], 1u);
    return b;
}
__device__ __forceinline__ void xcd_barrier_complete(unsigned* bar, unsigned x, unsigned& nloc, unsigned& nx) {
    const unsigned G = gridDim.x * gridDim.y * gridDim.z;
    unsigned sum, cnt, mine, sp = 0u;
    for (;;) {
        sum = 0u; cnt = 0u; mine = 0u;
#pragma unroll
        for (unsigned j = 0; j < 16; ++j) { const unsigned c = xb_ld(&bar[XB_XCNT(j)]); sum += c; cnt += (c > 0u) ? 1u : 0u; mine = (j == x) ? c : mine; }
        if (sum == G) break;
        __builtin_amdgcn_s_sleep(1);
        if ((++sp & 255u) == 0u) { if (xb_ld(&bar[XB_TMO])) break; if (sp > XB_SPIN_CAP) { atomicAdd(&bar[XB_TMO], 1u); break; } }
    }
    nloc = mine > 0u ? mine : 1u; nx = cnt > 0u ? cnt : 1u;
}

__device__ __forceinline__ void xcd_barrier(const XcdBarrier& b) {
    asm volatile("s_waitcnt vmcnt(0)" ::: "memory");
    __syncthreads();
    if (b.w0 == 0u && lane_id_now() == 0) {
        unsigned* bar = b.bar;
        __builtin_amdgcn_s_waitcnt(0);
        unsigned nloc = b.st[0], nx = b.st[1];
        if (nloc == 0u) { xcd_barrier_complete(bar, b.x, nloc, nx); b.st[0] = nloc; b.st[1] = nx; }
        const unsigned old = xb_add(&bar[XB_XSUB(b.x)], 1u);
        const unsigned gen = old / nloc;
        if (old + 1u == (gen + 1u) * nloc) {
            __builtin_amdgcn_fence(__ATOMIC_RELEASE, "agent");
            asm volatile("s_waitcnt vmcnt(0)" ::: "memory");
            const unsigned og = xb_add(&bar[XB_TOP], 1u);
            const unsigned tg = og / nx;
            if (og + 1u == (tg + 1u) * nx) xb_add(&bar[XB_TOPGEN], 1u);
            else XB_SPIN(xb_ld(&bar[XB_TOPGEN]) == tg, bar);
            __builtin_amdgcn_fence(__ATOMIC_ACQUIRE, "agent");
            xb_add(&bar[XB_XGEN(b.x)], 1u);
            asm volatile("s_waitcnt vmcnt(0)" ::: "memory");
        } else {
            XB_SPIN(xb_ld(&bar[XB_XGEN(b.x)]) == gen, bar);
            __builtin_amdgcn_fence(__ATOMIC_ACQUIRE, "agent");
            asm volatile("s_waitcnt vmcnt(0)" ::: "memory");
        }
    }
    __syncthreads();
}
constexpr int NWAVES = 8, NTHREADS = 512;
constexpr int NB = 8, SEQ = 4096, DM = 1024, MROWS = NB * SEQ, FF = 4096, NIN = 5444, DEPTH = 2;
constexpr int NPROJ = 2048;
constexpr int CA_Q = 0, CA_K = 256, CI_Q = 512, CI_W = 800, CB_U = 1024, CB_V = 1280, CC_Q = 1536, CC_K = 1792;
constexpr float LOG2E = 1.4426950408889634f;
constexpr float EPS = 1e-6f;
constexpr size_t MiB = 1u << 20;
constexpr size_t WS_CTL = 0, CTL_ZERO_BYTES = 1 * MiB;
constexpr size_t WS_WL = 1 * MiB, WL_STRIDE = 31 * MiB + 256 * 1024;
constexpr size_t WO_IN1 = 0, WO_VT = 10 * MiB, WO_B = 11 * MiB, WO_O = 13 * MiB, WO_F1 = 15 * MiB, WO_F2 = 23 * MiB, WO_S = 31 * MiB;
static_assert(WO_B + 3 * 1024 * 256 * 2 <= WO_O && WO_F2 + 8 * MiB <= WO_S && WO_S + 131072 <= WL_STRIDE && WS_WL + 2 * WL_STRIDE <= 64 * MiB, "weights map");
constexpr size_t WS_H = 64 * MiB;
constexpr size_t WS_Y = WS_H, WS_MASK = WS_H + 48 * MiB;
constexpr size_t WS_PA = 128 * MiB;
constexpr size_t WS_MA = WS_PA, WS_MB = WS_PA + 64 * MiB;
constexpr size_t WS_G = 256 * MiB;
constexpr size_t WS_ACT = 128 * MiB;
constexpr size_t WS_VTA = 448 * MiB;
constexpr size_t WS_KIDX = WS_WL + 4 * MiB;
constexpr size_t WS_WG8 = WS_WL + WL_STRIDE + 4 * MiB;
constexpr size_t WS_RS = WS_WL + 8 * MiB;
constexpr size_t WS_XB = 384 * MiB;
constexpr size_t WS_H8 = 480 * MiB;
constexpr size_t WS_END = 512 * MiB;
constexpr int CW_BAR = 4096;
constexpr int CW_NRM = 16384;
constexpr int RING_BYTES = 131072;
constexpr int HIST_OFF = 131072, HIST_BYTES = 16384;
constexpr int ILIST_OFF = HIST_OFF + HIST_BYTES;
constexpr int MW_OFF = ILIST_OFF + 4096;
constexpr int MISC_OFF = MW_OFF + 4096;
constexpr int LDS_BYTES = MISC_OFF + 512;

#define DI __device__ __forceinline__
typedef float f32x16 __attribute__((ext_vector_type(16)));
typedef float f32x2 __attribute__((ext_vector_type(2)));
typedef __bf16 bf16x2_t __attribute__((ext_vector_type(2)));
typedef unsigned u32x2 __attribute__((ext_vector_type(2)));
#define MFMA32(a, b, c) __builtin_amdgcn_mfma_f32_32x32x16_bf16((a), (b), (c), 0, 0, 0)
DI unsigned cvtpk(float lo, float hi) { f32x2 v = {lo, hi}; bf16x2_t b = __builtin_convertvector(v, bf16x2_t); return __builtin_bit_cast(unsigned, b); }
DI float blo(unsigned w) { return __uint_as_float(w << 16); }
DI float bhi(unsigned w) { return __uint_as_float(w & 0xffff0000u); }
DI float bf1(bf16 h) { return __uint_as_float((unsigned)h << 16); }
DI float fexp2(float x) { return __builtin_amdgcn_exp2f(x); }
DI float swapmax(float m) { auto rr = __builtin_amdgcn_permlane32_swap(__float_as_uint(m), __float_as_uint(m), false, false); return fmaxf(__uint_as_float(rr[0]), __uint_as_float(rr[1])); }
DI float swapsum(float m) { auto rr = __builtin_amdgcn_permlane32_swap(__float_as_uint(m), __float_as_uint(m), false, false); return __uint_as_float(rr[0]) + __uint_as_float(rr[1]); }
#define DPPF(v, ctrl) __int_as_float(__builtin_amdgcn_update_dpp(0, __float_as_int(v), (ctrl), 0xf, 0xf, true))
DI float quad_sum(float v) { v += DPPF(v, 0xB1); v += DPPF(v, 0x4E); return v; }
DI float row_sum(float v) { v = quad_sum(v); v += DPPF(v, 0x141); v += DPPF(v, 0x140); return v; }
DI float wave_sum(float v) { v = row_sum(v);
    return __int_as_float(__builtin_amdgcn_readlane(__float_as_int(v), 0)) + __int_as_float(__builtin_amdgcn_readlane(__float_as_int(v), 16)) + (__int_as_float(__builtin_amdgcn_readlane(__float_as_int(v), 32)) + __int_as_float(__builtin_amdgcn_readlane(__float_as_int(v), 48))); }
DI float gelu_tanh(float x) {
    const float u = 0.7978845608028654f * (x + 0.044715f * x * x * x);
    return x * __builtin_amdgcn_rcpf(1.0f + fexp2(-2.0f * LOG2E * u));
}
DI void wg_barrier() { asm volatile("s_waitcnt vmcnt(0) lgkmcnt(0)" ::: "memory"); __builtin_amdgcn_s_barrier(); asm volatile("" ::: "memory"); }
DI void lds_barrier() { asm volatile("s_waitcnt lgkmcnt(0)" ::: "memory"); __builtin_amdgcn_s_barrier(); asm volatile("" ::: "memory"); }

struct Ctx {
    LAS unsigned char* lds;
    int tid, lane, wave, vcu, G;
    float* out; unsigned char* ws;
};

DI void grid_bar(XcdBarrier b) { asm volatile("" : "+s"(b.bar), "+s"(b.x)); xcd_barrier(b); }
struct TrItem { const float* src; bf16* dst; const float* gain; int ldw, Kd, nvalid, fp8; float scale; };
DI TrItem tr_make(const float* W, int ldw, int k0, int c0, int nvalid, bf16* WT, int Kd, int drow, float scale, int lane, int kdst = -1, const float* gain = nullptr) {
    if (kdst < 0) kdst = k0;
    TrItem t; t.gain = gain ? gain + k0 : nullptr; t.src = W + (size_t)(k0 + (lane >> 5)) * ldw + c0 + (lane & 31); t.dst = WT + (size_t)drow * Kd + kdst; t.ldw = ldw; t.Kd = Kd; t.nvalid = nvalid; t.scale = scale; t.fp8 = 0; return t;
}
DI void tr_load(const TrItem& t, float (&wv)[32], int lane) {
#pragma unroll
    for (int i = 0; i < 32; ++i) wv[i] = ((lane & 31) < t.nvalid) ? t.src[(size_t)(2 * i) * t.ldw] : 0.f;
}
DI void tr_store(const TrItem& t, const float (&wv)[32], LAS float* scr, int lane) {
#pragma unroll
    for (int i = 0; i < 32; ++i) scr[(2 * i + (lane >> 5)) * 33 + (lane & 31)] = wv[i] * t.scale;
    LDS_WAIT(); asm volatile("" ::: "memory");
    const int c = lane & 7;
    f32x4 ga = {1.f, 1.f, 1.f, 1.f}, gb = {1.f, 1.f, 1.f, 1.f};
    if (t.gain) { ga = *(const GAS f32x4*)(t.gain + 8 * c); gb = *(const GAS f32x4*)(t.gain + 8 * c + 4); }
#pragma unroll
    for (int j = 0; j < 4; ++j) { const int n = (lane >> 3) + 8 * j; const LAS float* s = scr + (8 * c) * 33 + n;
        const float e0 = s[0 * 33] * ga[0], e1 = s[1 * 33] * ga[1], e2 = s[2 * 33] * ga[2], e3 = s[3 * 33] * ga[3], e4 = s[4 * 33] * gb[0], e5 = s[5 * 33] * gb[1], e6 = s[6 * 33] * gb[2], e7 = s[7 * 33] * gb[3];
        if (t.fp8) { int lo = __builtin_amdgcn_cvt_pk_fp8_f32(e0, e1, 0, false); lo = __builtin_amdgcn_cvt_pk_fp8_f32(e2, e3, lo, true);
            int hi = __builtin_amdgcn_cvt_pk_fp8_f32(e4, e5, 0, false); hi = __builtin_amdgcn_cvt_pk_fp8_f32(e6, e7, hi, true);
            *(GAS u32x2*)((unsigned char*)t.dst + (size_t)n * t.Kd + 8 * c) = (u32x2){(unsigned)lo, (unsigned)hi}; }
        else { v4u o; o.x = cvtpk(e0, e1); o.y = cvtpk(e2, e3); o.z = cvtpk(e4, e5); o.w = cvtpk(e6, e7);
            *(GAS v4u*)(t.dst + (size_t)n * t.Kd + 8 * c) = o; } }
    LDS_WAIT(); asm volatile("" ::: "memory");
}
DI void win_map(int cb, int& c0, int& nv, int& dsel, int& drow, float& sc) {
    nv = 32; dsel = 0; sc = 1.f;
    if (cb < 8)        { c0 = 0 + 32 * cb;            drow = CA_Q + 32 * cb; sc = 0.125f * LOG2E; }
    else if (cb < 16)  { c0 = 256 + 32 * (cb - 8);    drow = CA_K + 32 * (cb - 8); }
    else if (cb < 24)  { c0 = 512 + 32 * (cb - 16);   drow = 32 * (cb - 16); dsel = 1; }
    else if (cb < 32)  { c0 = 768 + 32 * (cb - 24);   drow = CI_Q + 32 * (cb - 24); sc = 0.125f; }
    else if (cb == 32) { c0 = 1024;                   drow = 768; }
    else if (cb == 33) { c0 = 1056;                   drow = 768 + 128; }
    else if (cb == 34) { c0 = 1088; nv = 4;           drow = CI_W; sc = 0.5f; }
    else if (cb < 43)  { c0 = 1092 + 32 * (cb - 35);  drow = CB_U + 32 * (cb - 35); }
    else if (cb < 51)  { c0 = 1348 + 32 * (cb - 43);  drow = CB_V + 32 * (cb - 43); }
    else if (cb < 59)  { c0 = 1604 + 32 * (cb - 51);  drow = CC_Q + 32 * (cb - 51); sc = 0.17677669529663687f * LOG2E; }
    else if (cb < 67)  { c0 = 1860 + 32 * (cb - 59);  drow = CC_K + 32 * (cb - 59); }
    else if (cb < 75)  { c0 = 2116 + 32 * (cb - 67);  drow = 256 + 32 * (cb - 67); dsel = 1; }
    else               { c0 = 2372 + 32 * (cb - 75);  drow = 32 * (cb - 75); dsel = 2; sc = 32.0f; }
}
constexpr int NCB_IN = 75 + 96;
constexpr int I_IN = NCB_IN * 16, I_B = 32 * 4, I_O = 32 * 16, I_F1 = 128 * 16, I_F2 = 32 * 64;
constexpr int PER_LAYER = I_IN + 3 * I_B + I_O + I_F1 + I_F2;
DI TrItem tr_desc(int it, unsigned char* wsb, const float* g1, const float* g2, const float* w_in, const float* wba, const float* wbb, const float* wbc, const float* w_o, const float* w_f1, const float* w_f2, int lane) {
    const int l = it / PER_LAYER; int r = it % PER_LAYER;
    unsigned char* wl = wsb + WS_WL + (size_t)l * WL_STRIDE;
    if (r < I_IN) { const int cb = r % NCB_IN, kb = r / NCB_IN; int c0, nv, dsel, drow; float sc; win_map(cb, c0, nv, dsel, drow, sc);
        if (dsel == 2) { TrItem t = tr_make(w_in + (size_t)l * DM * NIN, NIN, 64 * kb, c0, nv, (bf16*)(wsb + WS_WG8 + (size_t)l * 3 * MiB), DM, 0, sc, lane, 0, g1 + l * DM); t.gain = g1 + l * DM + 64 * kb;
            t.dst = (bf16*)((unsigned char*)(wsb + WS_WG8 + (size_t)l * 3 * MiB) + (size_t)drow * DM + 64 * kb); t.fp8 = 1; return t; }
        return tr_make(w_in + (size_t)l * DM * NIN, NIN, 64 * kb, c0, nv, (bf16*)(wl + (dsel ? WO_VT : WO_IN1)), DM, drow, sc, lane, -1, g1 + l * DM); }
    r -= I_IN;
    if (r < 3 * I_B) { const int w = r / I_B, q = r % I_B, cb = q % 32, kb = q / 32;
        return tr_make((w == 0 ? wba : (w == 1 ? wbb : wbc)) + (size_t)l * 256 * DM, DM, 64 * kb, 32 * cb, 32, (bf16*)(wl + WO_B), 768, 32 * cb, 1.f, lane, 256 * w + 64 * kb); }
    r -= 3 * I_B;
    if (r < I_O) { const int cb = r % 32, kb = r / 32; return tr_make(w_o + (size_t)l * DM * DM, DM, 64 * kb, 32 * cb, 32, (bf16*)(wl + WO_O), DM, 32 * cb, 1.f, lane); }
    r -= I_O;
    if (r < I_F1) { const int cb = r % 128, kb = r / 128; return tr_make(w_f1 + (size_t)l * DM * FF, FF, 64 * kb, 32 * cb, 32, (bf16*)(wl + WO_F1), DM, 32 * cb, 1.f, lane, -1, g2 + l * DM); }
    r -= I_F1;
    { const int cb = r % 32, kb = r / 32; return tr_make(w_f2 + (size_t)l * FF * DM, DM, 64 * kb, 32 * cb, 32, (bf16*)(wl + WO_F2), FF, 32 * cb, 1.f, lane); }
}
DI void prologue_weights(const Ctx& C, unsigned char* wsb, const float* g1, const float* g2, const float* w_in, const float* w_s, const float* wba, const float* wbb, const float* wbc, const float* w_o, const float* w_f1, const float* w_f2) {
    LAS float* scr = (LAS float*)(C.lds + C.wave * 16384);
    const int gw = C.vcu * NWAVES + C.wave, NGW = C.G * NWAVES;
    {
        constexpr int TOTAL = DEPTH * PER_LAYER;
        float wa[32], wb[32]; TrItem ta, tb;
        int it = gw;
        if (it < TOTAL) { ta = tr_desc(it, wsb, g1, g2, w_in, wba, wbb, wbc, w_o, w_f1, w_f2, C.lane); tr_load(ta, wa, C.lane); }
        while (it < TOTAL) {
            if (it + NGW < TOTAL) { tb = tr_desc(it + NGW, wsb, g1, g2, w_in, wba, wbb, wbc, w_o, w_f1, w_f2, C.lane); tr_load(tb, wb, C.lane); }
            tr_store(ta, wa, scr, C.lane);
            it += NGW; if (it >= TOTAL) break;
            if (it + NGW < TOTAL) { ta = tr_desc(it + NGW, wsb, g1, g2, w_in, wba, wbb, wbc, w_o, w_f1, w_f2, C.lane); tr_load(ta, wa, C.lane); }
            tr_store(tb, wb, scr, C.lane);
            it += NGW;
        }
    }
    const int gt = C.vcu * NTHREADS + C.tid, NGT = C.G * NTHREADS;
    for (int it = gt; it < DEPTH * 160 * 128; it += NGT) { const int l = it / (160 * 128), q = it % (160 * 128), rr = q / 128, ch = q % 128;
        const int row = rr < 64 ? 832 + rr : 928 + (rr - 64);
        *(GAS v4u*)((bf16*)(wsb + WS_WL + (size_t)l * WL_STRIDE + WO_IN1) + (size_t)row * DM + 8 * ch) = (v4u){0u, 0u, 0u, 0u}; }
    for (int it = gt; it < DEPTH * 4 * 128 * 128 / 2; it += NGT) { const int e = 2 * it, l = e / 65536, q = e % 65536, t = (q >> 7) & 127, s = q & 127;
        const float* src = w_s + e; const float a = (s <= t) ? src[0] : 0.f, b = (s + 1 <= t) ? src[1] : 0.f;
        *(GAS unsigned*)((bf16*)(wsb + WS_WL + (size_t)l * WL_STRIDE + WO_S) + q) = cvtpk(a, b); }
}
DI void rmsnorm_rows(const Ctx& C, const float* src, const float* g, bf16* dstb, float* dstf, unsigned char* dst8 = nullptr, const bf16* src16 = nullptr) {
    int tid_ = C.wave * 64 + lane_id_now(); asm volatile("" : "+v"(tid_));
    const int lane = tid_ & 63, wave = __builtin_amdgcn_readfirstlane(tid_ >> 6);
    const int gw = C.vcu * NWAVES + wave, NGW = C.G * NWAVES;
    f32x4 gv[4];
#pragma unroll
    for (int j = 0; j < 4; ++j) gv[j] = *((const GAS f32x4*)g + lane + 64 * j);
    for (int m = gw; m < MROWS; m += NGW) {
        f32x4 v[4]; float s = 0.f;
        if (src16) { const GAS u32x2* xr = (const GAS u32x2*)(src16 + (size_t)m * DM) + lane;
#pragma unroll
            for (int j = 0; j < 4; ++j) { const u32x2 p = xr[64 * j]; v[j] = (f32x4){blo(p.x), bhi(p.x), blo(p.y), bhi(p.y)}; } }
        else { const GAS f32x4* xr = (const GAS f32x4*)(src + (size_t)m * DM) + lane;
#pragma unroll
            for (int j = 0; j < 4; ++j) v[j] = xr[64 * j]; }
#pragma unroll
        for (int j = 0; j < 4; ++j) s += (v[j].x * v[j].x + v[j].y * v[j].y) + (v[j].z * v[j].z + v[j].w * v[j].w);
        const float rstd = 1.0f / sqrtf(wave_sum(s) * (1.0f / DM) + EPS);
        if (dstb) { GAS u32x2* o8 = (GAS u32x2*)(dstb + (size_t)m * DM) + lane;
#pragma unroll
            for (int j = 0; j < 4; ++j) { const f32x4 y = v[j] * rstd * gv[j]; o8[64 * j] = (u32x2){cvtpk(y.x, y.y), cvtpk(y.z, y.w)};
                if (dst8) { int p = __builtin_amdgcn_cvt_pk_fp8_f32(y.x, y.y, 0, false); p = __builtin_amdgcn_cvt_pk_fp8_f32(y.z, y.w, p, true); *((GAS unsigned*)(dst8 + (size_t)m * DM) + lane + 64 * j) = (unsigned)p; } } }
        else { GAS f32x4* o = (GAS f32x4*)(dstf + (size_t)m * DM) + lane;
#pragma unroll
            for (int j = 0; j < 4; ++j) o[64 * j] = v[j] * rstd * gv[j]; }
    }
}

DI void prep_rows(const Ctx& C, const float* src, bf16* xb, unsigned char* x8, float* rs) {
    int tid_ = C.wave * 64 + lane_id_now(); asm volatile("" : "+v"(tid_));
    const int lane = tid_ & 63, wave = __builtin_amdgcn_readfirstlane(tid_ >> 6);
    const int gw = C.vcu * NWAVES + wave, NGW = C.G * NWAVES;
    for (int m = gw; m < MROWS; m += NGW) {
        const GAS f32x4* xr = (const GAS f32x4*)(src + (size_t)m * DM) + lane;
        f32x4 v[4]; float s = 0.f;
#pragma unroll
        for (int j = 0; j < 4; ++j) { v[j] = xr[64 * j]; s += (v[j].x * v[j].x + v[j].y * v[j].y) + (v[j].z * v[j].z + v[j].w * v[j].w); }
        s = wave_sum(s);
        GAS u32x2* o8 = (GAS u32x2*)(xb + (size_t)m * DM) + lane;
#pragma unroll
        for (int j = 0; j < 4; ++j) { o8[64 * j] = (u32x2){cvtpk(v[j].x, v[j].y), cvtpk(v[j].z, v[j].w)};
            int p = __builtin_amdgcn_cvt_pk_fp8_f32(v[j].x, v[j].y, 0, false); p = __builtin_amdgcn_cvt_pk_fp8_f32(v[j].z, v[j].w, p, true); *((GAS unsigned*)(x8 + (size_t)m * DM) + lane + 64 * j) = (unsigned)p; }
        if (lane < 16) *(GAS float*)(rs + (size_t)m * 16 + lane) = lane == 0 ? s : 0.f;
    }
}
DI float relu_bits(float x) { const int i = __float_as_int(x); return __int_as_float(i > 0 ? i : 0); }
DI int pi32(int x) { return (x & 0x13) | ((x & 4) << 1) | ((x & 8) >> 1); }
#define DPPU(v, ctrl) ((unsigned)__builtin_amdgcn_update_dpp(0, (int)(v), (ctrl), 0xf, 0xf, true))
DI unsigned suffix_excl(unsigned T, int lane) {
    unsigned s = T;
    s += DPPU(s, 0x101); s += DPPU(s, 0x102); s += DPPU(s, 0x104); s += DPPU(s, 0x108);
    const unsigned r1 = (unsigned)__builtin_amdgcn_readlane((int)s, 16), r2 = (unsigned)__builtin_amdgcn_readlane((int)s, 32), r3 = (unsigned)__builtin_amdgcn_readlane((int)s, 48);
    s += (lane < 16 ? r1 : 0u) + (lane < 32 ? r2 : 0u) + (lane < 48 ? r3 : 0u);
    return s - T;
}
#ifndef SEL_FAST_MAX
#define SEL_FAST_MAX 256u
#endif
#ifndef SEL_RANK_MAX
#define SEL_RANK_MAX 0u
#endif
constexpr int SC_OFF = 0, HR_OFF = 65536;
constexpr int CL_OFF = 131072;
DI void select_phase(const Ctx& C, int b, int wi, const bf16* projA, const bf16* kidx, unsigned long long* mask) {
    LAS unsigned short* scores = (LAS unsigned short*)(C.lds + SC_OFF);
    LAS unsigned* hist = (LAS unsigned*)(C.lds + HR_OFF);
    int tid_ = C.wave * 64 + lane_id_now(); asm volatile("" : "+v"(tid_));
    const int tid = tid_, lane = tid & 63, wave = __builtin_amdgcn_readfirstlane(tid >> 6), hi = lane >> 5, l31 = lane & 31;
    const size_t rowb = (size_t)b * SEQ;
    unsigned z0 = 0u; asm volatile("" : "+v"(z0)); const v4u zero4 = {z0, z0, z0, z0};
    { LAS v4u* h4 = (LAS v4u*)hist;
#pragma unroll
      for (int k = 0; k < 8; ++k) h4[tid + 512 * k] = zero4; }
    const bf16* kbase = kidx + (((rowb >> 5) * 8 + hi) * 32 + l31) * 8;
    { const int t = 8 * wi + wave;
      if (lane <= (t >> 6)) { const int rem = t - 64 * lane; mask[(rowb + t) * 64 + lane] = rem >= 63 ? ~0ull : ((1ull << (rem + 1)) - 1ull); } }
#define SEL_QLOAD(QF, CW, t0_) do { const bf16* qp_ = projA + (rowb + (t0_) + (l31 >> 2)) * 2048 + CI_Q + (l31 & 3) * 64 + 8 * hi; \
        _Pragma("unroll") for (int kk = 0; kk < 4; ++kk) QF[kk] = *(const bf16x8*)(qp_ + 16 * kk); \
        _Pragma("unroll") for (int jq = 0; jq < 4; ++jq) CW[jq] = *(const u32x2*)(projA + (rowb + (t0_) + 2 * jq + hi) * 2048 + CI_W); } while (0)
    bf16x8 qf[4], qfn[4]; u32x2 cw[4], cwn[4];
    SEL_QLOAD(qf, cw, 8 * (32 + 31 - wi));
    const int hbase = ((l31 & 3) * 8 + hi) * 512;
#define SEL_LOAD(K, tile) do { const bf16* kp_ = kbase + (size_t)(tile) * (8 * 32 * 8); \
        asm volatile("global_load_dwordx4 %0, %4, off\n\tglobal_load_dwordx4 %1, %4, off offset:1024\n\tglobal_load_dwordx4 %2, %4, off offset:2048\n\tglobal_load_dwordx4 %3, %4, off offset:3072" \
                     : "=&v"(K[0]), "=&v"(K[1]), "=&v"(K[2]), "=&v"(K[3]) : "v"(kp_) : "memory"); } while (0)
#define SEL_WAIT(K, n) asm volatile("s_waitcnt vmcnt(" #n ")" : "+v"(K[0]), "+v"(K[1]), "+v"(K[2]), "+v"(K[3]) :: "memory")
#define SEL_FIRST(t0x) do { const int nt_ = (((t0x) + 8 + 63) & ~63) >> 5; const int cn_ = (nt_ - wave + 7) >> 3, tl_ = wave + 8 * (cn_ - 1); SEL_LOAD(ka, wave < tl_ ? wave : tl_); SEL_LOAD(kb, (wave + 8) < tl_ ? (wave + 8) : tl_); } while (0)
    bf16x8 ka[4], kb[4];
    SEL_FIRST(8 * (32 * 1 + (31 - wi)));
    lds_barrier();
#pragma unroll 1
    for (int j = 1; j < 16; ++j) {
    const int t0 = 8 * (32 * j + ((j & 1) ? 31 - wi : wi));
    const int nk = (t0 + 8 + 63) & ~63, ntile = nk >> 5;
    float coef[16];
#pragma unroll
    for (int jq = 0; jq < 4; ++jq) { coef[4 * jq] = blo(cw[jq].x); coef[4 * jq + 1] = bhi(cw[jq].x); coef[4 * jq + 2] = blo(cw[jq].y); coef[4 * jq + 3] = bhi(cw[jq].y); }
#define SEL_COMP(K, tile) do { const int kv0_ = (tile) * 32; f32x16 acc = {}; \
        _Pragma("unroll") for (int kk = 0; kk < 4; ++kk) acc = MFMA32(qf[kk], K[kk], acc); \
        const int key = kv0_ + l31; const bool edge = kv0_ + 31 > t0; \
        _Pragma("unroll") for (int jq = 0; jq < 4; ++jq) { float sc = 0.f; \
            _Pragma("unroll") for (int h = 0; h < 4; ++h) sc = fmaf(coef[4 * jq + h], relu_bits(acc[4 * jq + h]), sc); \
            const int q = 2 * jq + hi; float x = fmaf(sc, 4096.0f, 32768.0f); x = fminf(fmaxf(x, 0.0f), 65535.0f); \
            unsigned u = (unsigned)(int)x; if (edge && key > t0 + q) u = 0u; \
            scores[q * 4096 + key] = (unsigned short)u; \
            __hip_atomic_fetch_add(hist + hbase + 1024 * jq + (u >> 7), 1u << ((u >> 2) & 16u), __ATOMIC_RELAXED, __HIP_MEMORY_SCOPE_WORKGROUP); } } while (0)
    {
        bf16x8 kc[4];
        const int cnt = (ntile - wave + 7) >> 3, tlast = wave + 8 * (cnt - 1);
#define SEL_T(i) ((wave + 8 * (i)) < tlast ? (wave + 8 * (i)) : tlast)
        for (int i = 0; i < cnt; i += 3) {
            SEL_LOAD(kc, SEL_T(i + 2)); SEL_WAIT(ka, 8); SEL_COMP(ka, wave + 8 * i);
            if (i + 1 < cnt) { SEL_LOAD(ka, SEL_T(i + 3)); SEL_WAIT(kb, 8); SEL_COMP(kb, wave + 8 * (i + 1)); }
            if (i + 2 < cnt) { SEL_LOAD(kb, SEL_T(i + 4)); SEL_WAIT(kc, 8); SEL_COMP(kc, wave + 8 * (i + 2)); }
        }
        asm volatile("s_waitcnt vmcnt(0)" : "+v"(ka[0]), "+v"(ka[1]), "+v"(ka[2]), "+v"(ka[3]), "+v"(kb[0]), "+v"(kb[1]), "+v"(kb[2]), "+v"(kb[3]), "+v"(kc[0]), "+v"(kc[1]), "+v"(kc[2]), "+v"(kc[3]) :: "memory");
#undef SEL_T
    }
#undef SEL_COMP
    lds_barrier();
    if (j + 1 < 16) { const int t0n = 8 * (32 * (j + 1) + (((j + 1) & 1) ? 31 - wi : wi)); SEL_QLOAD(qfn, cwn, t0n); SEL_FIRST(t0n); }
    {
        const int q = wave, t = t0 + q, nch = nk >> 6;
        LAS unsigned* hq = hist + q * 512;
        LAS unsigned short* sq = scores + q * 4096;
        unsigned bstar, krem, cbin;
        {
            unsigned ps = 0u;
#pragma unroll
            for (int r = 0; r < 4; ++r) { const v4u a = *(LAS v4u*)(hq + 4096 * r + 8 * lane), c = *(LAS v4u*)(hq + 4096 * r + 8 * lane + 4);
                ps += ((a.x + a.y) + (a.z + a.w)) + ((c.x + c.y) + (c.z + c.w)); }
            const unsigned T = (ps & 0xffffu) + (ps >> 16);
            const unsigned above = suffix_excl(T, lane);
            const int src = (int)__builtin_ctzll(__ballot(above < 256u && above + T >= 256u));
            const unsigned aboveS = (unsigned)__builtin_amdgcn_readlane((int)above, src);
            unsigned cb = 0u;
            if (lane < 16) {
#pragma unroll
                for (int r = 0; r < 4; ++r) cb += (unsigned)((const LAS unsigned short*)(hq + 4096 * r))[16 * src + lane]; }
            const unsigned above2 = aboveS + suffix_excl(cb, lane);
            const int is = (int)__builtin_ctzll(__ballot(lane < 16 && above2 < 256u && above2 + cb >= 256u));
            bstar = 16u * (unsigned)src + (unsigned)is; krem = 256u - (unsigned)__builtin_amdgcn_readlane((int)above2, is); cbin = (unsigned)__builtin_amdgcn_readlane((int)cb, is);
        }
        const unsigned long long lt = (1ull << lane) - 1ull;
        LAS unsigned* klist = (LAS unsigned*)(C.lds + CL_OFF) + wave * 512;
        LAS unsigned* whist = klist + 256;
        LAS unsigned short* ilist = (LAS unsigned short*)(C.lds + ILIST_OFF) + wave * 256;
        LAS unsigned long long* mwords = (LAS unsigned long long*)(C.lds + MW_OFF) + wave * 64;
        if (cbin <= SEL_FAST_MAX) {
            unsigned cbase = 0;
            unsigned wlo = 0u, whi = 0u;
            for (int c0 = 0; c0 < nch; c0 += 4) {
                unsigned key4[4]; unsigned long long wp4[4];
#pragma unroll
                for (int u = 0; u < 4; ++u) key4[u] = (unsigned)sq[64 * (c0 + u) + lane];
#pragma unroll
                for (int u = 0; u < 4; ++u) { const unsigned bin = key4[u] >> 6; const unsigned long long wa = __ballot(bin > bstar); wp4[u] = (c0 + u < nch) ? __ballot(bin == bstar) : 0ull;
                    if (lane == c0 + u) { wlo = (unsigned)wa; whi = (unsigned)(wa >> 32); } }
                if ((wp4[0] | wp4[1]) | (wp4[2] | wp4[3])) {
#pragma unroll
                    for (int u = 0; u < 4; ++u) if (wp4[u]) { const unsigned pos = cbase + (unsigned)__builtin_popcountll(wp4[u] & lt);
                        if ((key4[u] >> 6) == bstar) { klist[pos] = key4[u]; ilist[pos] = (unsigned short)(64 * (c0 + u) + lane); }
                        cbase += (unsigned)__builtin_popcountll(wp4[u]); } } }
            mwords[lane] = ((unsigned long long)whi << 32) | wlo;
            const int ncc = (int)((cbase + 63u) >> 6);
            if (cbase <= SEL_RANK_MAX) {
                const bool valid = (unsigned)lane < cbase;
                const unsigned key = valid ? klist[lane] : 0u; const unsigned idx = valid ? (unsigned)ilist[lane] : 0u;
                unsigned rank = 0;
                for (int jj = 0; jj < (int)cbase; ++jj) { const unsigned kj = (unsigned)__builtin_amdgcn_readlane((int)key, jj); rank += (kj > key || (kj == key && jj < lane)) ? 1u : 0u; }
                if (valid && rank < krem) __hip_atomic_fetch_or((LAS unsigned*)mwords + (idx >> 5), 1u << (idx & 31u), __ATOMIC_RELAXED, __HIP_MEMORY_SCOPE_WORKGROUP);
            } else {
                *(LAS unsigned*)(whist + lane) = z0;
                for (int k = 0; k < ncc; ++k) { const unsigned i = 64u * k + lane; if (i < cbase) __hip_atomic_fetch_add(whist + (klist[i] & 63u), 1u, __ATOMIC_RELAXED, __HIP_MEMORY_SCOPE_WORKGROUP); }
                const unsigned T = whist[lane];
                const unsigned above = suffix_excl(T, lane);
                const int ds = (int)__builtin_ctzll(__ballot(above < krem && above + T >= krem));
                const unsigned krem2 = krem - (unsigned)__builtin_amdgcn_readlane((int)above, ds);
                const unsigned tau = (bstar << 6) | (unsigned)ds;
                unsigned taken = 0;
                for (int k = 0; k < ncc; ++k) { const unsigned i = 64u * k + lane; const bool valid = i < cbase;
                    const unsigned key = valid ? klist[i] : 0u; const unsigned idx = valid ? (unsigned)ilist[i] : 0u;
                    const bool eq = valid && key == tau; const unsigned long long beq = __ballot(eq);
                    const bool sel = valid && (key > tau || (eq && taken + (unsigned)__builtin_popcountll(beq & lt) < krem2));
                    taken += (unsigned)__builtin_popcountll(beq);
                    if (sel) __hip_atomic_fetch_or((LAS unsigned*)mwords + (idx >> 5), 1u << (idx & 31u), __ATOMIC_RELAXED, __HIP_MEMORY_SCOPE_WORKGROUP); }
            }
            if (lane < nch) mask[(rowb + t) * 64 + lane] = mwords[lane];
        } else {
            *(LAS unsigned*)(whist + lane) = z0;
            for (int c = 0; c < nch; ++c) { const unsigned key = (unsigned)sq[64 * c + lane]; if ((key >> 6) == bstar) __hip_atomic_fetch_add(whist + (key & 63u), 1u, __ATOMIC_RELAXED, __HIP_MEMORY_SCOPE_WORKGROUP); }
            const unsigned T = whist[lane];
            const unsigned above = suffix_excl(T, lane);
            const int ds = (int)__builtin_ctzll(__ballot(above < krem && above + T >= krem));
            const unsigned krem2 = krem - (unsigned)__builtin_amdgcn_readlane((int)above, ds);
            const unsigned tau = (bstar << 6) | (unsigned)ds;
            unsigned long long myword = 0ull; unsigned taken = 0;
            for (int c = 0; c < nch; ++c) { const unsigned key = (unsigned)sq[64 * c + lane];
                const bool eq = key == tau; const unsigned long long beq = __ballot(eq);
                const bool sel = key > tau || (eq && taken + (unsigned)__builtin_popcountll(beq & lt) < krem2);
                taken += (unsigned)__builtin_popcountll(beq);
                const unsigned long long w = __ballot(sel);
                if (lane == c) myword = w; }
            if (lane < nch) mask[(rowb + t) * 64 + lane] = myword;
        }
    }
    { LAS unsigned* hq = hist + wave * 512;
#pragma unroll
      for (int r = 0; r < 4; ++r) { *(LAS v4u*)(hq + 4096 * r + 8 * lane) = zero4; *(LAS v4u*)(hq + 4096 * r + 8 * lane + 4) = zero4; } }
    asm volatile("s_waitcnt vmcnt(0)" : "+v"(ka[0]), "+v"(ka[1]), "+v"(ka[2]), "+v"(ka[3]), "+v"(kb[0]), "+v"(kb[1]), "+v"(kb[2]), "+v"(kb[3]) :: "memory");
    lds_barrier();
#pragma unroll
    for (int kk = 0; kk < 4; ++kk) { qf[kk] = qfn[kk]; cw[kk] = cwn[kk]; }
    }
#undef SEL_QLOAD
#undef SEL_FIRST
#undef SEL_WAIT
#undef SEL_LOAD
}

constexpr int AT_STAGE = 16384;
struct AttnArgs { const bf16* projA; const bf16* VT; const unsigned long long* mask; bf16* Y; int qcol, kcol, vrow; float lam, oscale; const float* subg; };
template <int MODE, int TPS, bool FAST>
DI void attn_unit(const Ctx& C, const AttnArgs& A, int b, int h, int qb) {
    LAS unsigned char* lds = C.lds;
    int tid_ = C.wave * 64 + lane_id_now(); asm volatile("" : "+v"(tid_));
    const int tid = tid_, lane = tid & 63, wave = __builtin_amdgcn_readfirstlane(tid >> 6), hi = lane >> 5, l31 = lane & 31;
    const size_t rowb = (size_t)b * SEQ; const int q0 = qb * 256, qw0 = q0 + 32 * wave, tq = qw0 + l31;
    const int nkt = (q0 + 256) >> 6;
    const int sk = tid >> 3, sp = tid & 7;
    const bf16* kg = A.projA + (rowb + sk) * 2048 + A.kcol + h * 64 + 8 * sp;
    const bf16* vg = A.VT + (size_t)(A.vrow + h * 64 + sk) * MROWS + rowb + 8 * sp;
    const int kdst = ((sk >> 5) * 8 + sp) * 512 + ((pi32(sk & 31) ^ sp) * 16);
    const int vdst = 8192 + ((sk >> 5) * 8 + sp) * 512 + (((sk & 31) ^ sp) * 16);
    bf16x8 qf[4];
    { const bf16* qp = A.projA + (rowb + tq) * 2048 + A.qcol + h * 64 + 8 * hi;
#pragma unroll
      for (int kk = 0; kk < 4; ++kk) qf[kk] = *(const bf16x8*)(qp + 16 * kk); }
    constexpr int NC = MODE == 1 ? 2 : 1;
    f32x16 O[NC][2], negm[MODE == 0 ? 1 : 1]; float mref[NC], lsum[NC];
    negm[0] = f32x16{};
#pragma unroll
    for (int c = 0; c < NC; ++c) { O[c][0] = f32x16{}; O[c][1] = f32x16{}; mref[c] = 0.f; lsum[c] = 0.f; }
    {
#pragma unroll
      for (int tt = 0; tt < TPS; ++tt) { const v4u kr = *(const GAS v4u*)(kg + (size_t)(tt * 64) * 2048), vr = *(const GAS v4u*)(vg + tt * 64);
        *(LAS v4u*)(lds + tt * AT_STAGE + kdst) = kr; *(LAS v4u*)(lds + tt * AT_STAGE + vdst) = vr; } }
    unsigned long long mw[TPS], mwn[TPS];
#pragma unroll
    for (int tt = 0; tt < TPS; ++tt) { mw[tt] = 0ull; mwn[tt] = 0ull; if (MODE == 0) mw[tt] = A.mask[(rowb + tq) * 64 + tt]; }
    lds_barrier();
    const int nst = nkt / TPS;
    if (wave >= 4) __builtin_amdgcn_s_setprio(1);
    for (int s = 0; s < nst; ++s) {
        v4u kr[TPS], vr[TPS];
        const bool more = s + 1 < nst;
        if (more) {
#pragma unroll
            for (int tt = 0; tt < TPS; ++tt) { const int kvn = ((s + 1) * TPS + tt) * 64; kr[tt] = *(const GAS v4u*)(kg + (size_t)kvn * 2048); vr[tt] = *(const GAS v4u*)(vg + kvn);
                if (MODE == 0) mwn[tt] = A.mask[(rowb + tq) * 64 + (s + 1) * TPS + tt]; } }
#pragma unroll
        for (int tt = 0; tt < TPS; ++tt) {
        const int kt = s * TPS + tt;
        const int kv0 = kt * 64; LAS unsigned char* st = lds + ((s & 1) * TPS + tt) * AT_STAGE;
        if (kv0 <= qw0 + 31) {
            const bool diag = kv0 + 63 > qw0;
#pragma unroll
            for (int c = 0; c < NC; ++c) {
                f32x16 S0, S1;
                if (MODE == 0) {
#pragma unroll
                    for (int kk = 0; kk < 4; ++kk) { const int pb = kk * 2 + hi;
                        const bf16x8 k0 = *(const LAS bf16x8*)(st + (0 * 8 + pb) * 512 + ((l31 ^ pb) * 16)), k1 = *(const LAS bf16x8*)(st + (1 * 8 + pb) * 512 + ((l31 ^ pb) * 16));
                        S0 = MFMA32(k0, qf[kk], kk == 0 ? (FAST ? f32x16{} : negm[0]) : S0); S1 = MFMA32(k1, qf[kk], kk == 0 ? (FAST ? f32x16{} : negm[0]) : S1); }
                } else {
#pragma unroll
                    for (int k2 = 0; k2 < 2; ++k2) { const int kk = 2 * c + k2, pb = kk * 2 + hi;
                        const bf16x8 k0 = *(const LAS bf16x8*)(st + (0 * 8 + pb) * 512 + ((l31 ^ pb) * 16)), k1 = *(const LAS bf16x8*)(st + (1 * 8 + pb) * 512 + ((l31 ^ pb) * 16));
                        S0 = MFMA32(k0, qf[kk], k2 == 0 ? f32x16{} : S0); S1 = MFMA32(k1, qf[kk], k2 == 0 ? f32x16{} : S1); }
                }
                if (MODE == 1 && diag) {
                    const int kb = kv0 + 8 * hi;
#pragma unroll
                    for (int r = 0; r < 16; ++r) { const int key = kb + 16 * (r >> 3) + (r & 7);
                        if (key > tq) S0[r] = -INFINITY; if (key + 32 > tq) S1[r] = -INFINITY; }
                }
                if (!FAST) {
                float mxa = fmaxf(fmaxf(S0[0], S0[1]), S1[0]), mxb = fmaxf(fmaxf(S0[2], S0[3]), S1[1]);
                mxa = fmaxf(fmaxf(mxa, S1[2]), S1[3]);
#pragma unroll
                for (int r = 4; r < 16; r += 4) { mxa = fmaxf(fmaxf(mxa, S0[r]), S0[r + 1]); mxb = fmaxf(fmaxf(mxb, S0[r + 2]), S0[r + 3]); mxa = fmaxf(fmaxf(mxa, S1[r]), S1[r + 1]); mxb = fmaxf(fmaxf(mxb, S1[r + 2]), S1[r + 3]); }
                const float mx = swapmax(fmaxf(mxa, mxb)) - (MODE == 1 ? mref[c] : 0.f);
                if (kt == 0 || __any(mx > 8.0f)) {
                    const float dl = (kt == 0) ? mx : fmaxf(mx, 0.f); const float alpha = fexp2(-dl);
                    mref[c] += dl; lsum[c] *= alpha;
#pragma unroll
                    for (int r = 0; r < 16; ++r) { O[c][0][r] *= alpha; O[c][1][r] *= alpha; }
                    if (MODE == 0) {
#pragma unroll
                        for (int r = 0; r < 16; ++r) { S0[r] -= dl; S1[r] -= dl; negm[0][r] = -mref[c]; } }
                }
                }
                if (MODE == 0 || FAST) {
#pragma unroll
                    for (int r = 0; r < 16; ++r) { S0[r] = fexp2(S0[r]); S1[r] = fexp2(S1[r]); }
                } else {
#pragma unroll
                    for (int r = 0; r < 16; ++r) { S0[r] = fexp2(S0[r] - mref[c]); S1[r] = fexp2(S1[r] - mref[c]); }
                }
                if (MODE == 0) {
                    const unsigned long long sh = mw[tt] >> (8 * hi); const int lo = (int)(unsigned)sh, hw = (int)(unsigned)(sh >> 32);
#pragma unroll
                    for (int r = 0; r < 16; ++r) { const int pos = 16 * (r >> 3) + (r & 7);
                        S0[r] = __uint_as_float(__float_as_uint(S0[r]) & (unsigned)__builtin_amdgcn_sbfe(lo, pos, 1));
                        S1[r] = __uint_as_float(__float_as_uint(S1[r]) & (unsigned)__builtin_amdgcn_sbfe(hw, pos, 1)); }
                }
                float lsa = 0.f, lsb = 0.f;
#pragma unroll
                for (int r = 0; r < 16; r += 2) { lsa += S0[r] + S1[r]; lsb += S0[r + 1] + S1[r + 1]; }
                lsum[c] += lsa + lsb;
                bf16x8 pf[4];
                { v4u w;
                  w = (v4u){cvtpk(S0[0], S0[1]), cvtpk(S0[2], S0[3]), cvtpk(S0[4], S0[5]), cvtpk(S0[6], S0[7])};     pf[0] = __builtin_bit_cast(bf16x8, w);
                  w = (v4u){cvtpk(S0[8], S0[9]), cvtpk(S0[10], S0[11]), cvtpk(S0[12], S0[13]), cvtpk(S0[14], S0[15])}; pf[1] = __builtin_bit_cast(bf16x8, w);
                  w = (v4u){cvtpk(S1[0], S1[1]), cvtpk(S1[2], S1[3]), cvtpk(S1[4], S1[5]), cvtpk(S1[6], S1[7])};     pf[2] = __builtin_bit_cast(bf16x8, w);
                  w = (v4u){cvtpk(S1[8], S1[9]), cvtpk(S1[10], S1[11]), cvtpk(S1[12], S1[13]), cvtpk(S1[14], S1[15])}; pf[3] = __builtin_bit_cast(bf16x8, w); }
#pragma unroll
                for (int dh = 0; dh < 2; ++dh)
#pragma unroll
                    for (int cc = 0; cc < 4; ++cc) { const int pb = cc * 2 + hi;
                        const bf16x8 vf = *(const LAS bf16x8*)(st + 8192 + (dh * 8 + pb) * 512 + ((l31 ^ pb) * 16));
                        O[c][dh] = MFMA32(vf, pf[cc], O[c][dh]); }
            }
        }
        }
        if (more) {
#pragma unroll
            for (int tt = 0; tt < TPS; ++tt) { LAS unsigned char* sn = lds + (((s + 1) & 1) * TPS + tt) * AT_STAGE; *(LAS v4u*)(sn + kdst) = kr[tt]; *(LAS v4u*)(sn + vdst) = vr[tt]; mw[tt] = mwn[tt]; } }
        lds_barrier();
    }
    __builtin_amdgcn_s_setprio(0);
    bf16* yp = A.Y + (rowb + tq) * 768 + h * 64 + 4 * hi;
    if (MODE == 0) {
        const float inv = 1.0f / swapsum(lsum[0]);
#pragma unroll
        for (int dh = 0; dh < 2; ++dh)
#pragma unroll
            for (int g4 = 0; g4 < 4; ++g4) { const f32x16& o = O[0][dh];
                *(u32x2*)(yp + 32 * dh + 8 * g4) = (u32x2){cvtpk(o[4 * g4] * inv, o[4 * g4 + 1] * inv), cvtpk(o[4 * g4 + 2] * inv, o[4 * g4 + 3] * inv)}; }
    } else {
        const float i1 = 1.0f / swapsum(lsum[0]), i2 = A.lam / swapsum(lsum[NC - 1]);
        float ss = 0.f;
#pragma unroll
        for (int dh = 0; dh < 2; ++dh)
#pragma unroll
            for (int r = 0; r < 16; ++r) { const float v = O[0][dh][r] * i1 - O[NC - 1][dh][r] * i2; O[0][dh][r] = v; ss += v * v; }
        ss = swapsum(ss);
        const float rstd = A.oscale / sqrtf(ss * (1.0f / 64.0f) + EPS);
#pragma unroll
        for (int dh = 0; dh < 2; ++dh)
#pragma unroll
            for (int g4 = 0; g4 < 4; ++g4) { const f32x16& o = O[0][dh]; const f32x4 gg = *(const f32x4*)(A.subg + 32 * dh + 8 * g4 + 4 * hi);
                *(u32x2*)(yp + 32 * dh + 8 * g4) = (u32x2){cvtpk(o[4 * g4] * rstd * gg[0], o[4 * g4 + 1] * rstd * gg[1]), cvtpk(o[4 * g4 + 2] * rstd * gg[2], o[4 * g4 + 3] * rstd * gg[3])}; }
    }
}

DI void sgu_unit(const Ctx& C, int b, int chunk, const bf16* projA, const bf16* Ws, const float* lng, const float* lnb, const float* bs, bf16* Yb) {
    LAS unsigned char* lds = C.lds;
    int tid_ = C.wave * 64 + lane_id_now(); asm volatile("" : "+v"(tid_));
    const int tid = tid_, lane = tid & 63, wave = __builtin_amdgcn_readfirstlane(tid >> 6), hi = lane >> 5, l31 = lane & 31;
    const size_t R0 = (size_t)b * SEQ + 128 * chunk;
    const int gw = wave >> 1, chh = wave & 1;
    bf16x8 bb[4][8]; u32x2 uw[4][4]; float bias[4];
#pragma unroll
    for (int i = 0; i < 4; ++i) { const int t = 32 * i + l31;
        const bf16* up = projA + (R0 + t) * 2048 + CB_U + 64 * gw + 32 * chh + 4 * hi;
#pragma unroll
        for (int g4 = 0; g4 < 4; ++g4) uw[i][g4] = *(const u32x2*)(up + 8 * g4);
        bias[i] = bs[gw * 128 + t]; }
    {
        const int pos = tid >> 2, g = tid & 3;
        const bf16* vp = projA + (R0 + pos) * 2048 + CB_V + 64 * g;
        float x[64]; float s = 0.f;
#pragma unroll
        for (int j = 0; j < 8; ++j) { const v4u w = *(const GAS v4u*)(vp + 8 * j);
            x[8 * j + 0] = gelu_tanh(blo(w.x)); x[8 * j + 1] = gelu_tanh(bhi(w.x)); x[8 * j + 2] = gelu_tanh(blo(w.y)); x[8 * j + 3] = gelu_tanh(bhi(w.y));
            x[8 * j + 4] = gelu_tanh(blo(w.z)); x[8 * j + 5] = gelu_tanh(bhi(w.z)); x[8 * j + 6] = gelu_tanh(blo(w.w)); x[8 * j + 7] = gelu_tanh(bhi(w.w)); }
#pragma unroll
        for (int i = 0; i < 64; ++i) s += x[i];
        s = quad_sum(s);
        const float mu = s * (1.0f / 256.0f); float q = 0.f;
#pragma unroll
        for (int i = 0; i < 64; ++i) { const float d = x[i] - mu; q += d * d; }
        q = quad_sum(q);
        const float rstd = 1.0f / sqrtf(q * (1.0f / 256.0f) + EPS);
        LAS bf16* dst = (LAS bf16*)lds;
        const int kb = pos >> 3;
#pragma unroll
        for (int i = 0; i < 64; ++i) { const float y = (x[i] - mu) * rstd * lng[64 * g + i] + lnb[64 * g + i];
            dst[(((g * 2 + (i >> 5)) * 16 + kb) * 32 + ((i & 31) ^ (kb & 7))) * 8 + (pos & 7)] = (bf16)(cvtpk(y, 0.f) & 0xffffu); }
    }
#pragma unroll
    for (int i = 0; i < 4; ++i) { const bf16* wp = Ws + ((size_t)gw * 128 + 32 * i + l31) * 128 + 8 * hi;
#pragma unroll
        for (int kk = 0; kk < 2 * i + 2; ++kk) bb[i][kk] = *(const bf16x8*)(wp + 16 * kk); }
    lds_barrier();
#pragma unroll
    for (int i = 0; i < 4; ++i) {
        const int t = 32 * i + l31;
        f32x16 acc = {};
#pragma unroll
        for (int kk = 0; kk < 2 * i + 2; ++kk) { const int kblk = 2 * kk + hi;
            const bf16x8 a = *(const LAS bf16x8*)(lds + (size_t)((((gw * 2 + chh) * 16 + kblk) * 32 + (l31 ^ (kblk & 7))) * 16));
            acc = MFMA32(a, bb[i][kk], acc); }
        bf16* yp = Yb + (R0 + t) * 768 + 64 * gw + 32 * chh + 4 * hi;
#pragma unroll
        for (int g4 = 0; g4 < 4; ++g4) {
            const float u0 = gelu_tanh(blo(uw[i][g4].x)), u1 = gelu_tanh(bhi(uw[i][g4].x)), u2 = gelu_tanh(blo(uw[i][g4].y)), u3 = gelu_tanh(bhi(uw[i][g4].y));
            *(u32x2*)(yp + 8 * g4) = (u32x2){cvtpk(u0 * (acc[4 * g4] + bias[i]), u1 * (acc[4 * g4 + 1] + bias[i])), cvtpk(u2 * (acc[4 * g4 + 2] + bias[i]), u3 * (acc[4 * g4 + 3] + bias[i]))}; }
    }
    lds_barrier();
}

struct Args { const float* in[19]; float* out; unsigned char* ws; };
__global__ void __launch_bounds__(NTHREADS, 2) mk_fwd(Args args) {
    extern __shared__ __attribute__((aligned(16))) unsigned char lds_raw[];
    if (gridDim.x != 256u) return;
    { const unsigned bx_ = blockIdx.x; __builtin_assume(bx_ < 256u); }
    Ctx C;
    C.lds = (LAS unsigned char*)lds_raw;
    C.tid = threadIdx.x; C.lane = C.tid & 63; C.wave = __builtin_amdgcn_readfirstlane(C.tid >> 6);
    C.G = gridDim.x; { const int bx = blockIdx.x; C.vcu = (C.G % 8 == 0) ? (bx % 8) * (C.G / 8) + bx / 8 : bx; }
    C.out = nullptr; C.ws = nullptr;
    typedef const __attribute__((address_space(4))) Args* KArgs;
#define KGET() KArgs K = (KArgs)__builtin_amdgcn_kernarg_segment_ptr(); asm volatile("" : "+s"(K))
#define IN(k) ((const float*)(const GAS float*)(K->in[k]))
#define OUTP ((float*)(GAS float*)(K->out))
    volatile LAS unsigned* MISC = (volatile LAS unsigned*)(C.lds + MISC_OFF);
    if (C.tid < 64) MISC[C.tid] = 0u;
    __syncthreads();
    XcdBarrier bar = xcd_barrier_post((unsigned*)(args.ws + WS_CTL) + CW_BAR, MISC + 8);
#define WSP(T, off) ((T*)(GAS T*)(K->ws + (off)))
#define Hb   WSP(bf16, WS_H)
#define PA   WSP(bf16, WS_PA)
#define Gb   WSP(bf16, WS_G)
#define VTb  WSP(bf16, WS_VTA)
#define KIDX WSP(bf16, WS_KIDX)
#define MASK WSP(unsigned long long, WS_MASK)
#define Ya   WSP(bf16, WS_Y)
#define Yb   WSP(bf16, WS_Y + 512)
#define Yc   WSP(bf16, WS_Y + 1024)
#define MA   WSP(bf16, WS_MA)
#define ACT  WSP(bf16, WS_ACT)
#define H8   WSP(unsigned char, WS_H8)
#define XB   WSP(bf16, WS_XB)
#define RS   WSP(float, WS_RS)
#define NRM  (WSP(unsigned, WS_CTL) + CW_NRM + l * 512)
#define RLB  ((LAS float*)(C.lds + CL_OFF))
#define WL(off) ((const bf16*)(const GAS bf16*)(K->ws + WS_WL + (size_t)l * WL_STRIDE + (off)))

    { KGET();
      prologue_weights(C, (unsigned char*)(GAS unsigned char*)K->ws, IN(1), IN(15), IN(2), IN(7), IN(11), IN(12), IN(13), IN(14), IN(16), IN(17));
      prep_rows(C, IN(0), XB, H8, RS); }
    grid_bar(bar);

#pragma unroll 1
    for (int l = 0; l < DEPTH; ++l) {
        { KGET();
          pg8::Gemm g{XB, WL(WO_IN1), MROWS, NPROJ, DM}; pg8::StaticOrder S; S.init(MROWS, NPROJ, C.G, (int)blockIdx.x);
          pg8::EpiProj E{PA, Gb, KIDX, IN(3) + l * 64, IN(4) + l * 64, RS, RLB, NRM};
          pg8::gemm_phase<pg8::EpiProj, pg8::StaticOrder, true, true, 1024>(C.lds, g, S, E, pg8::NoHook(), C.wave); }
        { KGET();
          pg8::Gemm g{(const bf16*)H8, (const bf16*)(const GAS unsigned char*)(K->ws + WS_WG8 + (size_t)l * 3 * MiB), MROWS, 3072, 512}; pg8::StaticOrder S; S.init(MROWS, 3072, C.G, (int)blockIdx.x);
          pg8::EpiGates E{(unsigned char*)Gb, 1.0f / 32.0f, RS, RLB};
          pg8::gemm_phase<pg8::EpiGates, pg8::StaticOrder, true, true, 512, pg8::NoHook, true>(C.lds, g, S, E, pg8::NoHook(), C.wave); }
        { KGET();
          pg8::Gemm g{WL(WO_VT), XB, 512, MROWS, DM}; pg8::StaticOrder S; S.init(512, MROWS, C.G, (int)blockIdx.x);
          pg8::EpiVT E{VTb, MROWS, RS, RLB};
          pg8::gemm_phase<pg8::EpiVT, pg8::StaticOrder, true, true, 1024>(C.lds, g, S, E, pg8::NoHook(), C.wave); }
        grid_bar(bar);
        { KGET(); select_phase(C, C.vcu >> 5, C.vcu & 31, PA, KIDX, MASK); lds_barrier(); }
        { KGET(); sgu_unit(C, C.vcu >> 5, C.vcu & 31, PA, WL(WO_S), IN(5) + l * 256, IN(6) + l * 256, IN(8) + l * 512, Yb); }
        { KGET();
          const float* lq = IN(9) + l * 128;
          const int ln = lane_id_now();
          float d1 = (ln < 32) ? lq[ln] * lq[32 + ln] : 0.f, d2 = (ln < 32) ? lq[64 + ln] * lq[96 + ln] : 0.f;
          d1 = wave_sum(d1); d2 = wave_sum(d2);
          const float lam_init = 0.8f - 0.6f * expf(-0.3f * (float)l);
          const float lam = expf(d1) - expf(d2) + lam_init;
          AttnArgs A{PA, VTb, nullptr, Yc, CC_Q, CC_K, 256, lam, 1.0f - lam_init, IN(10) + l * 64};
          const int bh = C.vcu >> 3, s8 = C.vcu & 7;
          const unsigned* nr = NRM + (bh >> 2) * 64 + 2 * (bh & 3);
          const float b2 = fmaxf(__uint_as_float(nr[48]) * __uint_as_float(nr[56]), __uint_as_float(nr[49]) * __uint_as_float(nr[57])) * 1.03f;
          if (b2 <= 2500.0f) {
#pragma unroll 1
              for (int j = 0; j < 2; ++j) attn_unit<1, 1, true>(C, A, bh >> 2, bh & 3, j ? 15 - s8 : s8);
          } else {
#pragma unroll 1
              for (int j = 0; j < 2; ++j) attn_unit<1, 1, false>(C, A, bh >> 2, bh & 3, j ? 15 - s8 : s8); } }
        grid_bar(bar);
        { KGET();
          AttnArgs A{PA, VTb, MASK, Ya, CA_Q, CA_K, 0, 0.f, 1.f, nullptr};
          const int bh = C.vcu >> 3, s8 = C.vcu & 7;
          const unsigned* nr = NRM + (bh >> 2) * 64 + 2 * (bh & 3);
          const float b2 = (__uint_as_float(nr[0]) + __uint_as_float(nr[1])) * (__uint_as_float(nr[8]) + __uint_as_float(nr[9])) * 1.03f;
          if (b2 <= 2500.0f) {
#pragma unroll 1
              for (int j = 0; j < 2; ++j) attn_unit<0, 1, true>(C, A, bh >> 2, bh & 3, j ? 15 - s8 : s8);
          } else {
#pragma unroll 1
              for (int j = 0; j < 2; ++j) attn_unit<0, 1, false>(C, A, bh >> 2, bh & 3, j ? 15 - s8 : s8); } }
        grid_bar(bar);
        { KGET();
          pg8::Gemm g{Ya, WL(WO_B), MROWS, DM, 768}; pg8::StaticOrder S; S.init(MROWS, DM, C.G, (int)blockIdx.x);
          pg8::EpiGateC E{(const unsigned char*)Gb, MA}; pg8::HookGate H{(const unsigned char*)Gb};
          pg8::gemm_phase<pg8::EpiGateC, pg8::StaticOrder, true, true, 768, pg8::HookGate>(C.lds, g, S, E, H, C.wave); }
        grid_bar(bar);
        { KGET();
          pg8::Gemm g{MA, WL(WO_O), MROWS, DM, DM}; pg8::StaticOrder S; S.init(MROWS, DM, C.G, (int)blockIdx.x);
          pg8::EpiResid E{(l == 0) ? IN(0) : (const float*)nullptr, XB, XB, RS, nullptr};
          pg8::gemm_phase<pg8::EpiResid, pg8::StaticOrder, true, true, 1024>(C.lds, g, S, E, pg8::NoHook(), C.wave); }
        grid_bar(bar);
        { KGET();
          pg8::Gemm g{XB, WL(WO_F1), MROWS, FF, DM}; pg8::StaticOrder S; S.init(MROWS, FF, C.G, (int)blockIdx.x);
          pg8::EpiAct<1> E{ACT, FF, RS, RLB};
          pg8::gemm_phase<pg8::EpiAct<1>, pg8::StaticOrder, true, true, 1024>(C.lds, g, S, E, pg8::NoHook(), C.wave); }
        grid_bar(bar);
        { KGET();
          pg8::Gemm g{ACT, WL(WO_F2), MROWS, DM, FF}; pg8::StaticOrder S; S.init(MROWS, DM, C.G, (int)blockIdx.x);
          pg8::EpiResid E{nullptr, XB, XB, RS, (l + 1 < DEPTH) ? H8 : (unsigned char*)nullptr};
          pg8::gemm_phase<pg8::EpiResid, pg8::StaticOrder, true, true, 4096>(C.lds, g, S, E, pg8::NoHook(), C.wave); }
        grid_bar(bar);
        if (l + 1 == DEPTH) { KGET(); rmsnorm_rows(C, nullptr, IN(18), nullptr, OUTP, nullptr, XB); }
    }
}

extern "C" void kernel_launch(void* const* d_in, const int* in_sizes, int n_in, void* d_out, int out_size, void* d_ws, size_t ws_size, hipStream_t stream) {
    static int grid = 0;
    if (grid == 0) {
        if (n_in != 19 || in_sizes[0] != MROWS * DM || out_size != MROWS * DM || ws_size < WS_END) { fprintf(stderr, "kernel_launch: unexpected shapes / workspace (n_in %d, ws %zu)\n", n_in, ws_size); grid = -1; return; }
        int dev = 0, cus = 0, per_cu = 0;
        if (hipGetDevice(&dev) != hipSuccess || hipDeviceGetAttribute(&cus, hipDeviceAttributeMultiprocessorCount, dev) != hipSuccess) { grid = -1; return; }
        if (hipFuncSetAttribute((const void*)mk_fwd, hipFuncAttributeMaxDynamicSharedMemorySize, LDS_BYTES) != hipSuccess) { fprintf(stderr, "kernel_launch: hipFuncSetAttribute failed\n"); grid = -1; return; }
        if (hipOccupancyMaxActiveBlocksPerMultiprocessor(&per_cu, (const void*)mk_fwd, NTHREADS, LDS_BYTES) != hipSuccess || per_cu < 1) fprintf(stderr, "kernel_launch: occupancy query says %d\n", per_cu);
        (void)hipGetLastError();
        grid = cus;
    }
    if (grid < 0) return;
    if (hipMemsetAsync((char*)d_ws + WS_CTL, 0, CTL_ZERO_BYTES, stream) != hipSuccess) return;
    Args a{};
    for (int i = 0; i < 19; ++i) a.in[i] = (const float*)d_in[i];
    a.out = (float*)d_out; a.ws = (unsigned char*)d_ws;
    hipLaunchKernelGGL(mk_fwd, dim3(grid), dim3(NTHREADS), LDS_BYTES, stream, a);
}
```

```cpp
#include <hip/hip_runtime.h>
#include <hip/hip_bf16.h>
#include <cstdio>
#include <cstdint>
#include <cmath>
__device__ __forceinline__ int lane_id_now() { int l; asm volatile("v_mbcnt_lo_u32_b32 %0, -1, 0\n\tv_mbcnt_hi_u32_b32 %0, -1, %0" : "=v"(l)); return l; }
namespace pg8 {
#define PG8_LAS __attribute__((address_space(3)))
typedef unsigned short bf16_t;
typedef short bf16x8 __attribute__((ext_vector_type(8)));
typedef float f32x4 __attribute__((ext_vector_type(4)));
typedef unsigned u32x4 __attribute__((ext_vector_type(4)));
constexpr int BM = 256, BK = 64, HALF = 128, HTB = HALF * BK * 2  , STAGE_BYTES = 8 * HTB, NXCD = 8, WGM = 8;

__host__ __device__ __forceinline__ int lds_byte(int r, int c) { const int st = (r >> 4) * 2 + (c >> 5), rr = r & 15, cc = c & 31, ob = rr * 64 + cc * 2; return st * 1024 + (ob ^ (((ob >> 9) & 1) << 5)); }
__host__ __device__ __forceinline__ void stage_rc(int b, int& R, int& C) { const int st = b / 1024, sb = b % 1024, swz = sb ^ (((sb >> 9) & 1) << 5); R = (st >> 1) * 16 + swz / 64; C = (st & 1) * 32 + (swz % 64) / 2; }
__host__ __device__ __forceinline__ int perm32(int rho) { const int n = rho >> 4, i = rho & 15; return 8 * (i >> 2) + 4 * n + (i & 3); }

struct Unit { int pm, pn; };
struct Gemm { const bf16_t* A; const bf16_t* Bt; int M, N, K; };

struct StaticOrder {
    int nM, nN, nwg, G, c;
    __host__ __device__ void init(int M, int N, int G_, int c_) { nM = M / BM; nN = N / BM; nwg = nM * nN; G = G_; c = c_; }
    __host__ __device__ bool next(int i, Unit& u) const {
        const long L = (long)i * G + c; if (L >= nwg) return false;
        int wgid = (int)L; { const int q = nwg / NXCD, r = nwg % NXCD, xcd = wgid % NXCD, off = wgid / NXCD; wgid = (xcd < r ? xcd * (q + 1) : r * (q + 1) + (xcd - r) * q) + off; }
        const int nig = WGM * nN, gid = wgid / nig, fm = gid * WGM, gsz = (nM - fm) < WGM ? (nM - fm) : WGM;
        u.pm = fm + ((wgid % nig) % gsz); u.pn = (wgid % nig) / gsz; return true;
    }
    __device__ __forceinline__ void a_ready(const Unit&) const {}
    __device__ __forceinline__ void done(const Unit&) const {}
};

__device__ __forceinline__ unsigned cvt_pk_bf16(float lo, float hi) { unsigned r; asm volatile("v_cvt_pk_bf16_f32 %0, %1, %2" : "=v"(r) : "v"(lo), "v"(hi)); return r; }
typedef float f32x2 __attribute__((ext_vector_type(2)));
__device__ __forceinline__ f32x2 gelu_pk(f32x2 v) {
    const f32x2 av = __builtin_elementwise_abs(v), d = av * 0.2316418882f + 1.0f;
    f32x2 t; t.x = __builtin_amdgcn_rcpf(d.x); t.y = __builtin_amdgcn_rcpf(d.y);
    f32x2 q = t * 0.5307027145f + (-0.7265760135f); q = q * t + 0.7107068705f; q = q * t + (-0.142248368f); q = q * t + 0.127414796f; q = q * t;
    const f32x2 s = (v * v) * (-0.72134752044f);
    f32x2 e; e.x = __builtin_amdgcn_exp2f(s.x); e.y = __builtin_amdgcn_exp2f(s.y);
    const f32x2 m = v * (q * e), r = v - m;
    f32x2 o; o.x = v.x < 0.f ? m.x : r.x; o.y = v.y < 0.f ? m.y : r.y; return o;
}

template <int ACT  > struct EpiBf16 {
    static constexpr bool PERM = true, AFTER_DRAIN = false; static_assert(ACT == 0 || ACT == 1, "EpiBf16: ACT is 0 (none) or 1 (gelu_pk)");
    bf16_t* O; int ldc; const float* bias; int split_cols; size_t split_stride; float scale0;
    __device__ __forceinline__ void operator()(const f32x4 (&acc)[2][2][4][2], const Unit& u, int wr, int wc, int fr, int fq) const {
        const int row0 = u.pm * BM + wr * 64 + fr; int colt = u.pn * BM; bf16_t* base = O;
        float sc = 1.f; if (split_cols) { const int t = colt / split_cols; base += (size_t)t * split_stride; colt -= t * split_cols; if (t == 0) sc = scale0; }
        const int col0 = colt + wc * 32 + 8 * fq, bcol0 = u.pn * BM + wc * 32 + 8 * fq;
        f32x4 bv[2][2];
#pragma unroll
        for (int bj = 0; bj < 2; ++bj)
#pragma unroll
            for (int n = 0; n < 2; ++n) bv[bj][n] = bias ? *(const f32x4*)(bias + bcol0 + bj * HALF + 4 * n) : (f32x4){0.f, 0.f, 0.f, 0.f};
#pragma unroll
        for (int ai = 0; ai < 2; ++ai)
#pragma unroll
            for (int m = 0; m < 4; ++m) { bf16_t* rowp = base + (size_t)(row0 + ai * HALF + m * 16) * ldc + col0;
#pragma unroll
                for (int bj = 0; bj < 2; ++bj) { f32x4 v0 = acc[ai][bj][m][0] + bv[bj][0], v1 = acc[ai][bj][m][1] + bv[bj][1];
                    if (ACT == 1) { f32x2 a = gelu_pk((f32x2){v0[0], v0[1]}), b = gelu_pk((f32x2){v0[2], v0[3]}), c = gelu_pk((f32x2){v1[0], v1[1]}), d = gelu_pk((f32x2){v1[2], v1[3]});
                        v0 = (f32x4){a.x, a.y, b.x, b.y}; v1 = (f32x4){c.x, c.y, d.x, d.y}; }
                    v0 = v0 * sc; v1 = v1 * sc; u32x4 w; w.x = cvt_pk_bf16(v0[0], v0[1]); w.y = cvt_pk_bf16(v0[2], v0[3]); w.z = cvt_pk_bf16(v1[0], v1[1]); w.w = cvt_pk_bf16(v1[2], v1[3]);
                    *(u32x4*)(rowp + bj * HALF) = w; } }
    }
};
typedef float f32x2c __attribute__((ext_vector_type(2))); typedef __bf16 bf16x2c __attribute__((ext_vector_type(2)));
__device__ __forceinline__ unsigned cvtc(float lo, float hi) { f32x2c v = {lo, hi}; bf16x2c b = __builtin_convertvector(v, bf16x2c); return __builtin_bit_cast(unsigned, b); }
__device__ __forceinline__ float bflo(unsigned w) { return __uint_as_float(w << 16); }
__device__ __forceinline__ float bfhi(unsigned w) { return __uint_as_float(w & 0xffff0000u); }
__device__ __forceinline__ float xsum16_32(float s) {
    s += __int_as_float(__builtin_amdgcn_ds_swizzle(__float_as_int(s), 0x401F));
    auto rr = __builtin_amdgcn_permlane32_swap(__float_as_uint(s), __float_as_uint(s), false, false); return __uint_as_float(rr[0]) + __uint_as_float(rr[1]); }
__device__ __forceinline__ float rstd_row(const float* rs, int row) {
    const f32x4 a = *(const f32x4*)(rs + (size_t)row * 16), b = *(const f32x4*)(rs + (size_t)row * 16 + 4), c = *(const f32x4*)(rs + (size_t)row * 16 + 8), d = *(const f32x4*)(rs + (size_t)row * 16 + 12);
    const float s = (((a[0] + a[1]) + (a[2] + a[3])) + ((b[0] + b[1]) + (b[2] + b[3]))) + (((c[0] + c[1]) + (c[2] + c[3])) + ((d[0] + d[1]) + (d[2] + d[3])));
    return 1.0f / sqrtf(s * (1.0f / 1024.0f) + 1e-6f);
}
__device__ __forceinline__ void rstd_table_rows(PG8_LAS float* rl, const float* rs, int rowbase, int lane) {
    const float* p0 = rs + (size_t)(rowbase + lane) * 16; const float* p1 = rs + (size_t)(rowbase + HALF + lane) * 16;
    const f32x4 a0 = *(const f32x4*)(p0), b0 = *(const f32x4*)(p0 + 4), c0 = *(const f32x4*)(p0 + 8), d0 = *(const f32x4*)(p0 + 12);
    const f32x4 a1 = *(const f32x4*)(p1), b1 = *(const f32x4*)(p1 + 4), c1 = *(const f32x4*)(p1 + 8), d1 = *(const f32x4*)(p1 + 12);
    const float s0 = (((a0[0] + a0[1]) + (a0[2] + a0[3])) + ((b0[0] + b0[1]) + (b0[2] + b0[3]))) + (((c0[0] + c0[1]) + (c0[2] + c0[3])) + ((d0[0] + d0[1]) + (d0[2] + d0[3])));
    const float s1 = (((a1[0] + a1[1]) + (a1[2] + a1[3])) + ((b1[0] + b1[1]) + (b1[2] + b1[3]))) + (((c1[0] + c1[1]) + (c1[2] + c1[3])) + ((d1[0] + d1[1]) + (d1[2] + d1[3])));
    rl[lane] = 1.0f / sqrtf(s0 * (1.0f / 1024.0f) + 1e-6f); rl[64 + lane] = 1.0f / sqrtf(s1 * (1.0f / 1024.0f) + 1e-6f);
}
__device__ __forceinline__ float sigmoidf_fast(float v) { return __builtin_amdgcn_rcpf(1.0f + __builtin_amdgcn_exp2f(-1.4426950408889634f * v)); }

struct EpiProj {
    static constexpr bool PERM = true, AFTER_DRAIN = false;
    bf16_t* P; bf16_t* G; bf16_t* kidx; const float* kg; const float* kb; const float* rs; PG8_LAS float* rlb; unsigned* nrm; mutable int tab_pm = -1;
    __device__ __forceinline__ void operator()(const f32x4 (&acc)[2][2][4][2], const Unit& u, int wr, int wc, int fr_, int fq_) const {
        int fr = fr_, fq = fq_; asm volatile("" : "+v"(fr), "+v"(fq));
        const int row0 = u.pm * BM + wr * 64 + fr;
        PG8_LAS float* rl = rlb + (wr * 4 + wc) * 128; if (u.pm != tab_pm) { rstd_table_rows(rl, rs, u.pm * BM + wr * 64, fr + 16 * fq); tab_pm = u.pm; }
        {
            const int col0 = u.pn * BM + wc * 32 + 8 * fq;
            const bool want = (u.pn < 2) || (u.pn >= 6);
            float mxg[2] = {0.f, 0.f};
#pragma unroll
            for (int ai = 0; ai < 2; ++ai)
#pragma unroll
                for (int m = 0; m < 4; ++m) { bf16_t* rowp = P + (size_t)(row0 + ai * HALF + m * 16) * 2048 + col0; const float rsd = rl[64 * ai + 16 * m + fr];
#pragma unroll
                    for (int bj = 0; bj < 2; ++bj) { const f32x4 v0 = acc[ai][bj][m][0] * rsd, v1 = acc[ai][bj][m][1] * rsd;
                        u32x4 w; w.x = cvtc(v0[0], v0[1]); w.y = cvtc(v0[2], v0[3]); w.z = cvtc(v1[0], v1[1]); w.w = cvtc(v1[2], v1[3]);
                        *(u32x4*)(rowp + bj * HALF) = w;
                        if (want) { float q = ((v0[0] * v0[0] + v0[1] * v0[1]) + (v0[2] * v0[2] + v0[3] * v0[3])) + ((v1[0] * v1[0] + v1[1] * v1[1]) + (v1[2] * v1[2] + v1[3] * v1[3]));
                            q = xsum16_32(q); mxg[bj] = fmaxf(mxg[bj], q); } } }
            if (want) {
#pragma unroll
                for (int bj = 0; bj < 2; ++bj) { float v = mxg[bj];
                    v = fmaxf(v, __int_as_float(__builtin_amdgcn_ds_swizzle(__float_as_int(v), 0x041F))); v = fmaxf(v, __int_as_float(__builtin_amdgcn_ds_swizzle(__float_as_int(v), 0x081F)));
                    v = fmaxf(v, __int_as_float(__builtin_amdgcn_ds_swizzle(__float_as_int(v), 0x101F))); v = fmaxf(v, __int_as_float(__builtin_amdgcn_ds_swizzle(__float_as_int(v), 0x201F)));
                    if ((fr | fq) == 0) atomicMax(nrm + (u.pm >> 4) * 64 + u.pn * 8 + bj * 4 + wc, __float_as_uint(v)); } }
            if (u.pn == 3 && wc == 0) {
                f32x4 gq[2][2], bq[2][2];
#pragma unroll
                for (int bj = 0; bj < 2; ++bj) { gq[bj][0] = *(const f32x4*)(kg + bj * 32 + 8 * fq); gq[bj][1] = *(const f32x4*)(kg + bj * 32 + 8 * fq + 4); bq[bj][0] = *(const f32x4*)(kb + bj * 32 + 8 * fq); bq[bj][1] = *(const f32x4*)(kb + bj * 32 + 8 * fq + 4); }
#pragma unroll
                for (int ai = 0; ai < 2; ++ai)
#pragma unroll
                    for (int m = 0; m < 4; ++m) {
                        const float rsd = rl[64 * ai + 16 * m + fr];
                        f32x4 xs[2][2];
#pragma unroll
                        for (int bj = 0; bj < 2; ++bj)
#pragma unroll
                            for (int n = 0; n < 2; ++n) xs[bj][n] = acc[ai][bj][m][n] * rsd;
                        float s = 0.f;
#pragma unroll
                        for (int bj = 0; bj < 2; ++bj)
#pragma unroll
                            for (int n = 0; n < 2; ++n) { const f32x4 x = xs[bj][n]; s += (x[0] + x[1]) + (x[2] + x[3]); }
                        s = xsum16_32(s);
                        const float mu = s * (1.0f / 64.0f); float q = 0.f;
#pragma unroll
                        for (int bj = 0; bj < 2; ++bj)
#pragma unroll
                            for (int n = 0; n < 2; ++n) { const f32x4 d = xs[bj][n] - mu; q += (d[0] * d[0] + d[1] * d[1]) + (d[2] * d[2] + d[3] * d[3]); }
                        q = xsum16_32(q);
                        const float rstd = 1.0f / sqrtf(q * (1.0f / 64.0f) + 1e-6f);
                        const int R = row0 + ai * HALF + m * 16;
                        bf16_t* kp = kidx + ((size_t)((R >> 5) * 8 + fq) * 32 + (R & 31)) * 8;
#pragma unroll
                        for (int bj = 0; bj < 2; ++bj) { const f32x4 g0 = gq[bj][0], g1 = gq[bj][1], b0 = bq[bj][0], b1 = bq[bj][1];
                            const f32x4 y0 = (xs[bj][0] - mu) * rstd * g0 + b0, y1 = (xs[bj][1] - mu) * rstd * g1 + b1;
                            u32x4 w; w.x = cvtc(y0[0], y0[1]); w.y = cvtc(y0[2], y0[3]); w.z = cvtc(y1[0], y1[1]); w.w = cvtc(y1[2], y1[3]);
                            *(u32x4*)(kp + bj * 4 * 32 * 8) = w; }
                        asm volatile("" ::: "memory");
                    }
            }
        }
    }
};
__device__ __forceinline__ float ub(unsigned w, int i) { return (float)((w >> (8 * i)) & 0xffu); }
__device__ __forceinline__ size_t gate_tile_off(int g, int pm, int pn, int wr, int wc, int fr, int fq) { return ((size_t)((g * 128 + pm) * 4 + pn)) * 65536 + (size_t)((wr * 4 + wc) * 8192 + (fq * 16 + fr) * 16); }
struct EpiGates {
    static constexpr bool PERM = true, AFTER_DRAIN = false;
    unsigned char* G8; float scale; const float* rs; PG8_LAS float* rlb; mutable int tab_pm = -1;
    __device__ __forceinline__ void operator()(const f32x4 (&acc)[2][2][4][2], const Unit& u, int wr, int wc, int fr_, int fq_) const {
        int fr = fr_, fq = fq_; asm volatile("" : "+v"(fr), "+v"(fq));
        PG8_LAS float* rl = rlb + (wr * 4 + wc) * 128; if (u.pm != tab_pm) { rstd_table_rows(rl, rs, u.pm * BM + wr * 64, fr + 16 * fq); tab_pm = u.pm; }
        unsigned char* tp = G8 + gate_tile_off(u.pn >> 2, u.pm, u.pn & 3, wr, wc, fr, fq);
#pragma unroll
        for (int ai = 0; ai < 2; ++ai)
#pragma unroll
            for (int m = 0; m < 4; ++m) { const float ns = -1.4426950408889634f * scale * rl[64 * ai + 16 * m + fr];
                u32x4 w;
#pragma unroll
                for (int bj = 0; bj < 2; ++bj) { const f32x4 v0 = acc[ai][bj][m][0], v1 = acc[ai][bj][m][1];
                    unsigned lo = 0u, hi = 0u;
#pragma unroll
                    for (int e2 = 0; e2 < 4; ++e2) {
                        const float ga = fmaxf(255.0f * __builtin_amdgcn_rcpf(1.0f + __builtin_amdgcn_exp2f(ns * v0[e2])), 1.0f), gb = fmaxf(255.0f * __builtin_amdgcn_rcpf(1.0f + __builtin_amdgcn_exp2f(ns * v1[e2])), 1.0f);
                        lo = __builtin_amdgcn_cvt_pk_u8_f32(ga, e2, lo); hi = __builtin_amdgcn_cvt_pk_u8_f32(gb, e2, hi); }
                    if (bj == 0) { w.x = lo; w.y = hi; } else { w.z = lo; w.w = hi; } }
                *(u32x4*)(tp + (ai * 4 + m) * 1024) = w; }
    }
};
template <int ACT> struct EpiAct {
    static constexpr bool PERM = true, AFTER_DRAIN = false;
    bf16_t* O; int ldc; const float* rs; PG8_LAS float* rlb; mutable int tab_pm = -1;
    __device__ __forceinline__ void operator()(const f32x4 (&acc)[2][2][4][2], const Unit& u, int wr, int wc, int fr_, int fq_) const {
        int fr = fr_, fq = fq_; asm volatile("" : "+v"(fr), "+v"(fq));
        const int row0 = u.pm * BM + wr * 64 + fr; const int col0 = u.pn * BM + wc * 32 + 8 * fq;
        PG8_LAS float* rl = rlb + (wr * 4 + wc) * 128; if (u.pm != tab_pm) { rstd_table_rows(rl, rs, u.pm * BM + wr * 64, fr + 16 * fq); tab_pm = u.pm; }
#pragma unroll
        for (int ai = 0; ai < 2; ++ai)
#pragma unroll
            for (int m = 0; m < 4; ++m) { bf16_t* rowp = O + (size_t)(row0 + ai * HALF + m * 16) * ldc + col0; const float rsd = rl[64 * ai + 16 * m + fr];
#pragma unroll
                for (int bj = 0; bj < 2; ++bj) { f32x4 v0 = acc[ai][bj][m][0] * rsd, v1 = acc[ai][bj][m][1] * rsd;
                    if (ACT == 1) {
#pragma unroll
                        for (int e = 0; e < 4; ++e) { const int ia = __float_as_int(v0[e]), ib = __float_as_int(v1[e]); const float a = __int_as_float(ia > 0 ? ia : 0), b = __int_as_float(ib > 0 ? ib : 0); v0[e] = a * a; v1[e] = b * b; } }
                    u32x4 w; w.x = cvtc(v0[0], v0[1]); w.y = cvtc(v0[2], v0[3]); w.z = cvtc(v1[0], v1[1]); w.w = cvtc(v1[2], v1[3]);
                    *(u32x4*)(rowp + bj * HALF) = w; } }
    }
};
struct EpiVT {
    static constexpr bool PERM = true, AFTER_DRAIN = false;
    bf16_t* O; int ldc; const float* rs; PG8_LAS float* rlb;
    __device__ __forceinline__ void operator()(const f32x4 (&acc)[2][2][4][2], const Unit& u, int wr, int wc, int fr_, int fq_) const {
        int fr = fr_, fq = fq_; asm volatile("" : "+v"(fr), "+v"(fq));
        const int row0 = u.pm * BM + wr * 64 + fr; const int col0 = u.pn * BM + wc * 32 + 8 * fq;
        PG8_LAS float* rl = rlb + (wr * 4 + wc) * 128; { const int L = fr + 16 * fq; rl[L] = rstd_row(rs, u.pn * BM + wc * 32 + (L & 31) + (L >> 5) * HALF); }
#pragma unroll
        for (int bj = 0; bj < 2; ++bj) { float rc[8];
#pragma unroll
            for (int e2 = 0; e2 < 8; ++e2) rc[e2] = rl[bj * 32 + 8 * fq + e2];
#pragma unroll
            for (int ai = 0; ai < 2; ++ai)
#pragma unroll
                for (int m = 0; m < 4; ++m) { bf16_t* rowp = O + (size_t)(row0 + ai * HALF + m * 16) * ldc + col0; const f32x4 v0 = acc[ai][bj][m][0], v1 = acc[ai][bj][m][1];
                    u32x4 w; w.x = cvtc(v0[0] * rc[0], v0[1] * rc[1]); w.y = cvtc(v0[2] * rc[2], v0[3] * rc[3]); w.z = cvtc(v1[0] * rc[4], v1[1] * rc[5]); w.w = cvtc(v1[2] * rc[6], v1[3] * rc[7]);
                    *(u32x4*)(rowp + bj * HALF) = w; } }
    }
};
struct HookGate {
    static constexpr bool ACTIVE = true;
    const unsigned char* G8;
    __device__ __forceinline__ void mid(f32x4 (&acc)[2][2][4][2], const Unit& u, int kt, int wr, int wc, int fr_, int fq_) const {
        if (kt != 4 && kt != 8) return;
        int fr = fr_, fq = fq_; asm volatile("" : "+v"(fr), "+v"(fq));
        const int g0 = kt == 4 ? 0 : 1;
        const unsigned char* np = G8 + gate_tile_off(g0, u.pm, u.pn, wr, wc, fr, fq); const unsigned char* dp = G8 + gate_tile_off(g0 + 1, u.pm, u.pn, wr, wc, fr, fq);
#pragma unroll
        for (int ai = 0; ai < 2; ++ai)
#pragma unroll
            for (int m = 0; m < 4; ++m) { const u32x4 gn = *(const u32x4*)(np + (ai * 4 + m) * 1024), gd = *(const u32x4*)(dp + (ai * 4 + m) * 1024);
                f32x4 r0, r1, r2, r3;
#pragma unroll
                for (int e2 = 0; e2 < 4; ++e2) { r0[e2] = ub(gn.x, e2) * __builtin_amdgcn_rcpf(ub(gd.x, e2)); r1[e2] = ub(gn.y, e2) * __builtin_amdgcn_rcpf(ub(gd.y, e2));
                    r2[e2] = ub(gn.z, e2) * __builtin_amdgcn_rcpf(ub(gd.z, e2)); r3[e2] = ub(gn.w, e2) * __builtin_amdgcn_rcpf(ub(gd.w, e2)); }
                acc[ai][0][m][0] *= r0; acc[ai][0][m][1] *= r1; acc[ai][1][m][0] *= r2; acc[ai][1][m][1] *= r3;
                if (m == 3) asm volatile("" ::: "memory"); }
    }
};
struct EpiGateC {
    static constexpr bool PERM = true, AFTER_DRAIN = false;
    const unsigned char* G8; bf16_t* Mo;
    __device__ __forceinline__ void operator()(const f32x4 (&acc)[2][2][4][2], const Unit& u, int wr, int wc, int fr_, int fq_) const {
        int fr = fr_, fq = fq_; asm volatile("" : "+v"(fr), "+v"(fq));
        const int row0 = u.pm * BM + wr * 64 + fr; const int col0 = u.pn * BM + wc * 32 + 8 * fq;
        const unsigned char* gp = G8 + gate_tile_off(2, u.pm, u.pn, wr, wc, fr, fq); const float s255 = 1.0f / 255.0f;
        u32x4 gall[8];
#pragma unroll
        for (int i = 0; i < 8; ++i) gall[i] = *(const u32x4*)(gp + i * 1024);
#pragma unroll
        for (int ai = 0; ai < 2; ++ai)
#pragma unroll
            for (int m = 0; m < 4; ++m) { const size_t r = (size_t)(row0 + ai * HALF + m * 16); const u32x4 g = gall[ai * 4 + m];
#pragma unroll
                for (int bj = 0; bj < 2; ++bj) { const f32x4 v0 = acc[ai][bj][m][0], v1 = acc[ai][bj][m][1]; const unsigned glo = bj ? g.z : g.x, ghi = bj ? g.w : g.y;
                    u32x4 w; w.x = cvtc(ub(glo, 0) * s255 * v0[0], ub(glo, 1) * s255 * v0[1]); w.y = cvtc(ub(glo, 2) * s255 * v0[2], ub(glo, 3) * s255 * v0[3]); w.z = cvtc(ub(ghi, 0) * s255 * v1[0], ub(ghi, 1) * s255 * v1[1]); w.w = cvtc(ub(ghi, 2) * s255 * v1[2], ub(ghi, 3) * s255 * v1[3]);
                    *(u32x4*)(Mo + r * 1024 + col0 + bj * HALF) = w; }
                asm volatile("" ::: "memory"); }
    }
};
struct EpiResid {
    static constexpr bool PERM = true, AFTER_DRAIN = false;
    const float* base32; const bf16_t* base16; bf16_t* out16; float* rs; unsigned char* out8;
    __device__ __forceinline__ void operator()(const f32x4 (&acc)[2][2][4][2], const Unit& u, int wr, int wc, int fr_, int fq_) const {
        int fr = fr_, fq = fq_; asm volatile("" : "+v"(fr), "+v"(fq));
        const int col0 = u.pn * BM + wc * 32 + 8 * fq;
        typedef unsigned u32x2g __attribute__((ext_vector_type(2)));
#pragma unroll
        for (int ai = 0; ai < 2; ++ai)
#pragma unroll
            for (int m = 0; m < 4; ++m) { const int row = u.pm * BM + ai * HALF + wr * 64 + m * 16 + fr; const size_t off = (size_t)row * 1024 + col0;
                float q = 0.f;
#pragma unroll
                for (int bj = 0; bj < 2; ++bj) { f32x4 b0, b1;
                    if (base32) { b0 = *(const f32x4*)(base32 + off + bj * HALF); b1 = *(const f32x4*)(base32 + off + bj * HALF + 4); }
                    else { const u32x4 p = *(const u32x4*)(base16 + off + bj * HALF); b0 = (f32x4){bflo(p.x), bfhi(p.x), bflo(p.y), bfhi(p.y)}; b1 = (f32x4){bflo(p.z), bfhi(p.z), bflo(p.w), bfhi(p.w)}; }
                    const f32x4 o0 = b0 + acc[ai][bj][m][0], o1 = b1 + acc[ai][bj][m][1];
                    u32x4 w; w.x = cvtc(o0[0], o0[1]); w.y = cvtc(o0[2], o0[3]); w.z = cvtc(o1[0], o1[1]); w.w = cvtc(o1[2], o1[3]);
                    *(u32x4*)(out16 + off + bj * HALF) = w;
                    if (out8) { int lo = __builtin_amdgcn_cvt_pk_fp8_f32(o0[0], o0[1], 0, false); lo = __builtin_amdgcn_cvt_pk_fp8_f32(o0[2], o0[3], lo, true);
                        int hi = __builtin_amdgcn_cvt_pk_fp8_f32(o1[0], o1[1], 0, false); hi = __builtin_amdgcn_cvt_pk_fp8_f32(o1[2], o1[3], hi, true);
                        *(u32x2g*)(out8 + off + bj * HALF) = (u32x2g){(unsigned)lo, (unsigned)hi}; }
                    q += ((o0[0] * o0[0] + o0[1] * o0[1]) + (o0[2] * o0[2] + o0[3] * o0[3])) + ((o1[0] * o1[0] + o1[1] * o1[1]) + (o1[2] * o1[2] + o1[3] * o1[3])); }
                q = xsum16_32(q);
                if (fq == 0) rs[(size_t)row * 16 + u.pn * 4 + wc] = q;
                if (m == 3) asm volatile("" ::: "memory"); }
    }
};
template <bool C, class A, class B> struct Cond_ { typedef A T; };
template <class A, class B> struct Cond_<false, A, B> { typedef B T; };
struct NoHook { static constexpr bool ACTIVE = false; __device__ __forceinline__ void mid(f32x4 (&)[2][2][4][2], const Unit&, int, int, int, int, int) const {} };
template <class Epi, class Sched, bool ALIGN_EPI = false, bool SP2 = false, int KC = 0, class Hook = NoHook, bool FP8 = false>
__device__ __forceinline__ void gemm_phase(PG8_LAS unsigned char* lds, const Gemm g, const Sched& S, const Epi& E, const Hook& H = Hook(), int wave_in = -1) {
    int tid_ = wave_in >= 0 ? wave_in * 64 + lane_id_now() : (int)threadIdx.x; asm volatile("" : "+v"(tid_));
    const int tid = tid_, wid = __builtin_amdgcn_readfirstlane(tid >> 6), lane = tid & 63, wr = wid >> 2, wc = wid & 3, fr = lane & 15, fq = lane >> 4;
    const int K = KC ? KC : g.K, nt = K / BK;
    unsigned voffA[2], voffB[2];
#pragma unroll
    for (int i = 0; i < 2; ++i) { int R, C; stage_rc(tid * 16 + i * 8192, R, C); const int Rb = Epi::PERM ? ((R & ~31) + perm32(R & 31)) : R;
        voffA[i] = (unsigned)(R * K + C) * 2u; voffB[i] = (unsigned)(Rb * K + C) * 2u; }
    const size_t kstep = (size_t)(BK * 2);
    const size_t hstep = (size_t)HALF * K * 2;
    const size_t tstep = 2 * hstep;
    const unsigned ldsw = (unsigned)wid * 1024u;
    const int aoff = lds_byte(wr * 64 + fr, fq * 8), boff = lds_byte(wc * 32 + fr, fq * 8);
#define PG8_SA(b, h) (((b) * 2 + (h)) * HTB)
#define PG8_SB(b, h) ((4 + (b) * 2 + (h)) * HTB)
#define PG8_STAGE(bufoff, gbase, voff) do { _Pragma("unroll") for (int _i = 0; _i < 2; ++_i) \
        __builtin_amdgcn_global_load_lds((const unsigned*)((const char*)(gbase) + (voff)[_i]), (PG8_LAS unsigned*)(lds + (bufoff) + ldsw + _i * 8192), 16, 0, 0); } while (0)
#define PG8_RD16(off) (*(const PG8_LAS bf16x8*)(lds + (off)))
#define PG8_CAT8(lo, hi) __builtin_shufflevector(__builtin_bit_cast(v4i_, (lo)), __builtin_bit_cast(v4i_, (hi)), 0, 1, 2, 3, 4, 5, 6, 7)
#define PG8_LDA(dst, b, h) do { _Pragma("unroll") for (int m = 0; m < 4; ++m) { if constexpr (FP8) dst[m][0] = PG8_CAT8(PG8_RD16(PG8_SA(b, h) + aoff + m * 2048), PG8_RD16(PG8_SA(b, h) + aoff + m * 2048 + 1024)); \
        else { _Pragma("unroll") for (int k = 0; k < 2; ++k) dst[m][k] = PG8_RD16(PG8_SA(b, h) + aoff + m * 2048 + k * 1024); } } } while (0)
#define PG8_LDB(dst, b, h) do { _Pragma("unroll") for (int n = 0; n < 2; ++n) { if constexpr (FP8) dst[n][0] = PG8_CAT8(PG8_RD16(PG8_SB(b, h) + boff + n * 2048), PG8_RD16(PG8_SB(b, h) + boff + n * 2048 + 1024)); \
        else { _Pragma("unroll") for (int k = 0; k < 2; ++k) dst[n][k] = PG8_RD16(PG8_SB(b, h) + boff + n * 2048 + k * 1024); } } } while (0)
#define PG8_MMA(ai, bj, At, Bt) do { __builtin_amdgcn_s_setprio(1); \
        if constexpr (FP8) { _Pragma("unroll") for (int m = 0; m < 4; ++m) _Pragma("unroll") for (int n = 0; n < 2; ++n) \
            asm volatile("v_mfma_f32_16x16x128_f8f6f4 %0, %1, %2, %0" : "+v"(acc[ai][bj][m][n]) : "v"(Bt[n][0]), "v"(At[m][0])); } \
        else { _Pragma("unroll") for (int m = 0; m < 4; ++m) _Pragma("unroll") for (int n = 0; n < 2; ++n) _Pragma("unroll") for (int k = 0; k < 2; ++k) \
            acc[ai][bj][m][n] = __builtin_amdgcn_mfma_f32_16x16x32_bf16(Bt[n][k], At[m][k], acc[ai][bj][m][n], 0, 0, 0); } \
        __builtin_amdgcn_s_setprio(0); } while (0)
#define PG8_WAIT_V(n) asm volatile("s_waitcnt vmcnt(" #n ")" ::: "memory")
#define PG8_WAIT_L(n) asm volatile("s_waitcnt lgkmcnt(" #n ")" ::: "memory")
#define PG8_BAR __builtin_amdgcn_s_barrier()
#define PG8_SCHED __builtin_amdgcn_sched_barrier(0)
    Unit cur, nxt; int ui = 0;
    if (!S.next(0, cur)) return;
    f32x4 acc[2][2][4][2];
#pragma unroll
    for (int a = 0; a < 2; ++a)
#pragma unroll
        for (int b = 0; b < 2; ++b)
#pragma unroll
            for (int m = 0; m < 4; ++m)
#pragma unroll
                for (int n = 0; n < 2; ++n) acc[a][b][m][n] = (f32x4){0.f, 0.f, 0.f, 0.f};
    typedef int v4i_ __attribute__((ext_vector_type(4))); typedef int v8i_ __attribute__((ext_vector_type(8)));
    struct FragSel { typedef v8i_ T8; typedef bf16x8 T16; };
    typedef typename Cond_<FP8, v8i_, bf16x8>::T Frag_;
    Frag_ At[4][FP8 ? 1 : 2], B0[2][FP8 ? 1 : 2], B1[2][FP8 ? 1 : 2];
    const char* cA = (const char*)g.A + (size_t)cur.pm * tstep; const char* cB = (const char*)g.Bt + (size_t)cur.pn * tstep;
    S.a_ready(cur);
    if constexpr (SP2) {
        PG8_STAGE(PG8_SB(0, 0), cB, voffB); PG8_STAGE(PG8_SB(0, 1), cB + hstep, voffB); PG8_STAGE(PG8_SA(0, 0), cA, voffA); PG8_STAGE(PG8_SA(0, 1), cA + hstep, voffA);
        if (wr == 1) PG8_BAR;
        PG8_WAIT_V(2); PG8_BAR;
        PG8_STAGE(PG8_SB(1, 0), cB + kstep, voffB); PG8_STAGE(PG8_SA(1, 0), cA + kstep, voffA); PG8_STAGE(PG8_SB(1, 1), cB + hstep + kstep, voffB);
        PG8_WAIT_V(6); PG8_BAR;
    } else {
        PG8_STAGE(PG8_SB(0, 0), cB, voffB); PG8_STAGE(PG8_SA(0, 0), cA, voffA); PG8_STAGE(PG8_SB(0, 1), cB + hstep, voffB); PG8_STAGE(PG8_SA(0, 1), cA + hstep, voffA);
        if (wr == 1) PG8_BAR;
        PG8_WAIT_V(4); PG8_BAR;
        PG8_STAGE(PG8_SB(1, 0), cB + kstep, voffB); PG8_STAGE(PG8_SA(1, 0), cA + kstep, voffA); PG8_STAGE(PG8_SB(1, 1), cB + hstep + kstep, voffB);
        PG8_WAIT_V(6); PG8_BAR;
    }
    for (;;) {
        const bool has_next = S.next(ui + 1, nxt);
        const char* nA = has_next ? (const char*)g.A + (size_t)nxt.pm * tstep : cA; const char* nB = has_next ? (const char*)g.Bt + (size_t)nxt.pn * tstep : cB;
_Pragma("unroll 1")
        for (int t = 0; t < nt; t += 2) {
            const bool last = (t == nt - 2);
            const char* a1 = cA + (size_t)(t + 1) * kstep;
            const char* a2 = last ? nA : cA + (size_t)(t + 2) * kstep; const char* b2 = last ? nB : cB + (size_t)(t + 2) * kstep;
            const char* a3 = a2 + kstep; const char* b3 = b2 + kstep;
            if (last && has_next) S.a_ready(nxt);
            if constexpr (SP2) {
            PG8_LDB(B0, 0, 0); PG8_LDB(B1, 0, 1); PG8_SCHED; PG8_LDA(At, 0, 0); PG8_STAGE(PG8_SA(1, 1), a1 + hstep, voffA);
            PG8_WAIT_V(8); PG8_WAIT_L(0); PG8_BAR; PG8_MMA(0, 0, At, B0); PG8_MMA(0, 1, At, B1); PG8_BAR; PG8_SCHED;
            PG8_LDA(At, 0, 1); PG8_STAGE(PG8_SB(0, 0), b2, voffB); PG8_STAGE(PG8_SB(0, 1), b2 + hstep, voffB); PG8_STAGE(PG8_SA(0, 0), a2, voffA);
            PG8_WAIT_V(8); PG8_WAIT_L(0); PG8_BAR; PG8_MMA(1, 0, At, B0); PG8_MMA(1, 1, At, B1); PG8_BAR; PG8_SCHED;
            PG8_LDB(B0, 1, 0); PG8_LDB(B1, 1, 1); PG8_SCHED; PG8_LDA(At, 1, 0); PG8_STAGE(PG8_SA(0, 1), a2 + hstep, voffA);
            PG8_WAIT_V(8); PG8_WAIT_L(0); PG8_BAR; PG8_MMA(0, 0, At, B0); PG8_MMA(0, 1, At, B1); PG8_BAR; PG8_SCHED;
            PG8_LDA(At, 1, 1); PG8_STAGE(PG8_SB(1, 0), b3, voffB); PG8_STAGE(PG8_SB(1, 1), b3 + hstep, voffB); PG8_STAGE(PG8_SA(1, 0), a3, voffA);
            PG8_WAIT_V(8); PG8_WAIT_L(0); PG8_BAR; PG8_MMA(1, 0, At, B0); PG8_MMA(1, 1, At, B1); PG8_BAR; PG8_SCHED;
            } else {
            PG8_LDB(B0, 0, 0); PG8_SCHED; PG8_LDA(At, 0, 0); PG8_STAGE(PG8_SA(1, 1), a1 + hstep, voffA);
            PG8_WAIT_L(8); PG8_BAR; PG8_WAIT_L(0); PG8_MMA(0, 0, At, B0); PG8_BAR; PG8_SCHED;
            PG8_LDB(B1, 0, 1); PG8_STAGE(PG8_SB(0, 0), b2, voffB);
            PG8_BAR; PG8_WAIT_L(0); PG8_MMA(0, 1, At, B1); PG8_BAR;
            PG8_LDA(At, 0, 1); PG8_STAGE(PG8_SA(0, 0), a2, voffA);
            PG8_BAR; PG8_WAIT_L(0); PG8_MMA(1, 0, At, B0); PG8_BAR; PG8_SCHED;
            PG8_STAGE(PG8_SB(0, 1), b2 + hstep, voffB);
            PG8_WAIT_V(6); PG8_BAR; PG8_MMA(1, 1, At, B1); PG8_BAR;
            PG8_LDB(B0, 1, 0); PG8_SCHED; PG8_LDA(At, 1, 0); PG8_STAGE(PG8_SA(0, 1), a2 + hstep, voffA);
            PG8_WAIT_L(8); PG8_BAR; PG8_WAIT_L(0); PG8_MMA(0, 0, At, B0); PG8_BAR; PG8_SCHED;
            PG8_LDB(B1, 1, 1); PG8_STAGE(PG8_SB(1, 0), b3, voffB);
            PG8_BAR; PG8_WAIT_L(0); PG8_MMA(0, 1, At, B1); PG8_BAR;
            PG8_LDA(At, 1, 1); PG8_STAGE(PG8_SA(1, 0), a3, voffA);
            PG8_BAR; PG8_WAIT_L(0); PG8_MMA(1, 0, At, B0); PG8_BAR; PG8_SCHED;
            PG8_STAGE(PG8_SB(1, 1), b3 + hstep, voffB);
            PG8_WAIT_V(6); PG8_BAR; PG8_MMA(1, 1, At, B1); PG8_BAR;
            }
            if constexpr (Hook::ACTIVE) { if (t + 2 < nt) H.mid(acc, cur, t + 2, wr, wc, fr, fq); }
        }
        if constexpr (FP8) asm volatile("s_nop 15\n\ts_nop 15\n\ts_nop 15\n\ts_nop 15" ::: "memory");
        if constexpr (ALIGN_EPI) { if (wr == 0) PG8_BAR; }
        if constexpr (!Epi::AFTER_DRAIN) { E(acc, cur, wr, wc, fr, fq); S.done(cur); }
        if (!has_next) break;
#pragma unroll
        for (int a = 0; a < 2; ++a)
#pragma unroll
            for (int b = 0; b < 2; ++b)
#pragma unroll
                for (int m = 0; m < 4; ++m)
#pragma unroll
                    for (int n = 0; n < 2; ++n) acc[a][b][m][n] = (f32x4){0.f, 0.f, 0.f, 0.f};
        cur = nxt; cA = nA; cB = nB; ++ui;
        if constexpr (ALIGN_EPI) { if (wr == 1) PG8_BAR; }
    }
    PG8_WAIT_V(0);
    if constexpr (!ALIGN_EPI) { if (wr == 0) PG8_BAR; }
    PG8_BAR;
    if constexpr (Epi::AFTER_DRAIN) { E.fused(acc, cur, wr, wc, fr, fq, lds, wid, lane); S.done(cur); }
#undef PG8_SA
#undef PG8_SB
#undef PG8_STAGE
#undef PG8_RD16
#undef PG8_CAT8
#undef PG8_LDA
#undef PG8_LDB
#undef PG8_MMA
#undef PG8_WAIT_V
#undef PG8_WAIT_L
#undef PG8_BAR
#undef PG8_SCHED
}
}
#define GAS __attribute__((address_space(1)))
#define LAS __attribute__((address_space(3)))
typedef unsigned short bf16;
typedef unsigned v4u __attribute__((ext_vector_type(4)));
typedef float f32x4 __attribute__((ext_vector_type(4)));
typedef short bf16x8 __attribute__((ext_vector_type(8)));
typedef GAS unsigned gu32;
typedef GAS unsigned long long gu64;
#define RLX_AGENT __ATOMIC_RELAXED, __HIP_MEMORY_SCOPE_AGENT
#define LDS_WAIT() asm volatile("s_waitcnt lgkmcnt(0)" ::: "memory")
#define VM_WAIT() asm volatile("s_waitcnt vmcnt(0)" ::: "memory")
__device__ __forceinline__ unsigned long long rt() { return __builtin_amdgcn_s_memrealtime(); }
__device__ __forceinline__ unsigned f2bf(float f) { unsigned u = __builtin_bit_cast(unsigned, f); return (u + 0x7fffu + ((u >> 16) & 1u)) >> 16; }
__device__ __forceinline__ unsigned pk2(float lo, float hi) { return f2bf(lo) | (f2bf(hi) << 16); }

#define XB_TMO      128
#define XB_XCNT(j)  (256  + 64 * (j))
#define XB_XSUB(j)  (1280 + 64 * (j))
#define XB_XGEN(j)  (2304 + 64 * (j))
#define XB_TOP      3328
#define XB_TOPGEN   3392
#define XCD_BAR_WORDS 3456
#define XB_SPIN_CAP (1u << 22)

__device__ __forceinline__ unsigned xb_ld(unsigned* p)              { return __hip_atomic_load(p, __ATOMIC_RELAXED, __HIP_MEMORY_SCOPE_AGENT); }
__device__ __forceinline__ unsigned xb_add(unsigned* p, unsigned v) { return __hip_atomic_fetch_add(p, v, __ATOMIC_RELAXED, __HIP_MEMORY_SCOPE_AGENT); }
__device__ __forceinline__ unsigned xb_xcc_id() { return (unsigned)__builtin_amdgcn_s_getreg((3 << 11) | 20) & 0xFu; }
#define XB_SPIN(cond, bar) do { unsigned _sp = 0; while (cond) { __builtin_amdgcn_s_sleep(1); \
    if ((++_sp & 255u) == 0u) { if (xb_ld(&(bar)[XB_TMO])) break; if (_sp > XB_SPIN_CAP) { atomicAdd(&(bar)[XB_TMO], 1u); break; } } } } while (0)

struct XcdBarrier {
    unsigned* bar; unsigned x; unsigned w0;
    volatile LAS unsigned* st;
};

__device__ __forceinline__ XcdBarrier xcd_barrier_post(unsigned* bar, volatile LAS unsigned* st) {
    XcdBarrier b; b.bar = bar; b.x = xb_xcc_id(); b.st = st; { unsigned wv_ = (unsigned)__builtin_amdgcn_readfirstlane((int)(threadIdx.x >> 6)); asm volatile("" : "+s"(wv_)); b.w0 = wv_; }
    if (threadIdx.x == 0) (void)xb_add(&bar[XB_XCNT(b.x)], 1u);
    return b;
}
__device__ __forceinline__ void xcd_barrier_complete(unsigned* bar, unsigned x, unsigned& nloc, unsigned& nx) {
    const unsigned G = gridDim.x * gridDim.y * gridDim.z;
    unsigned sum, cnt, mine, sp = 0u;
    for (;;) {
        sum = 0u; cnt = 0u; mine = 0u;
#pragma unroll
        for (unsigned j = 0; j < 16; ++j) { const unsigned c = xb_ld(&bar[XB_XCNT(j)]); sum += c; cnt += (c > 0u) ? 1u : 0u; mine = (j == x) ? c : mine; }
        if (sum == G) break;
        __builtin_amdgcn_s_sleep(1);
        if ((++sp & 255u) == 0u) { if (xb_ld(&bar[XB_TMO])) break; if (sp > XB_SPIN_CAP) { atomicAdd(&bar[XB_TMO], 1u); break; } }
    }
    nloc = mine > 0u ? mine : 1u; nx = cnt > 0u ? cnt : 1u;
}

__device__ __forceinline__ void xcd_barrier(const XcdBarrier& b) {
    asm volatile("s_waitcnt vmcnt(0)" ::: "memory");
    __syncthreads();
    if (b.w0 == 0u && lane_id_now() == 0) {
        unsigned* bar = b.bar;
        __builtin_amdgcn_s_waitcnt(0);
        unsigned nloc = b.st[0], nx = b.st[1];
        if (nloc == 0u) { xcd_barrier_complete(bar, b.x, nloc, nx); b.st[0] = nloc; b.st[1] = nx; }
        const unsigned old = xb_add(&bar[XB_XSUB(b.x)], 1u);
        const unsigned gen = old / nloc;
        if (old + 1u == (gen + 1u) * nloc) {
            __builtin_amdgcn_fence(__ATOMIC_RELEASE, "agent");
            asm volatile("s_waitcnt vmcnt(0)" ::: "memory");
            const unsigned og = xb_add(&bar[XB_TOP], 1u);
            const unsigned tg = og / nx;
            if (og + 1u == (tg + 1u) * nx) xb_add(&bar[XB_TOPGEN], 1u);
            else XB_SPIN(xb_ld(&bar[XB_TOPGEN]) == tg, bar);
            __builtin_amdgcn_fence(__ATOMIC_ACQUIRE, "agent");
            xb_add(&bar[XB_XGEN(b.x)], 1u);
            asm volatile("s_waitcnt vmcnt(0)" ::: "memory");
        } else {
            XB_SPIN(xb_ld(&bar[XB_XGEN(b.x)]) == gen, bar);
            __builtin_amdgcn_fence(__ATOMIC_ACQUIRE, "agent");
            asm volatile("s_waitcnt vmcnt(0)" ::: "memory");
        }
    }
    __syncthreads();
}
constexpr int NWAVES = 8, NTHREADS = 512;
constexpr int NB = 8, SEQ = 4096, DM = 1024, MROWS = NB * SEQ, FF = 4096, NIN = 5444, DEPTH = 2;
constexpr int NPROJ = 2048;
constexpr int CA_Q = 0, CA_K = 256, CI_Q = 512, CI_W = 800, CB_U = 1024, CB_V = 1280, CC_Q = 1536, CC_K = 1792;
constexpr float LOG2E = 1.4426950408889634f;
constexpr float EPS = 1e-6f;
constexpr size_t MiB = 1u << 20;
constexpr size_t WS_CTL = 0, CTL_ZERO_BYTES = 1 * MiB;
constexpr size_t WS_WL = 1 * MiB, WL_STRIDE = 31 * MiB + 256 * 1024;
constexpr size_t WO_IN1 = 0, WO_VT = 10 * MiB, WO_B = 11 * MiB, WO_O = 13 * MiB, WO_F1 = 15 * MiB, WO_F2 = 23 * MiB, WO_S = 31 * MiB;
static_assert(WO_B + 3 * 1024 * 256 * 2 <= WO_O && WO_F2 + 8 * MiB <= WO_S && WO_S + 131072 <= WL_STRIDE && WS_WL + 2 * WL_STRIDE <= 64 * MiB, "weights map");
constexpr size_t WS_H = 64 * MiB;
constexpr size_t WS_Y = WS_H, WS_MASK = WS_H + 48 * MiB;
constexpr size_t WS_PA = 128 * MiB;
constexpr size_t WS_MA = WS_PA, WS_MB = WS_PA + 64 * MiB;
constexpr size_t WS_G = 256 * MiB;
constexpr size_t WS_ACT = 128 * MiB;
constexpr size_t WS_VTA = 448 * MiB;
constexpr size_t WS_KIDX = WS_WL + 4 * MiB;
constexpr size_t WS_WG8 = WS_WL + WL_STRIDE + 4 * MiB;
constexpr size_t WS_RS = WS_WL + 8 * MiB;
constexpr size_t WS_XB = 384 * MiB;
constexpr size_t WS_H8 = 480 * MiB;
constexpr size_t WS_END = 512 * MiB;
constexpr int CW_BAR = 4096;
constexpr int CW_NRM = 16384;
constexpr int RING_BYTES = 131072;
constexpr int HIST_OFF = 131072, HIST_BYTES = 16384;
constexpr int ILIST_OFF = HIST_OFF + HIST_BYTES;
constexpr int MW_OFF = ILIST_OFF + 4096;
constexpr int MISC_OFF = MW_OFF + 4096;
constexpr int LDS_BYTES = MISC_OFF + 512;

#define DI __device__ __forceinline__
typedef float f32x16 __attribute__((ext_vector_type(16)));
typedef float f32x2 __attribute__((ext_vector_type(2)));
typedef __bf16 bf16x2_t __attribute__((ext_vector_type(2)));
typedef unsigned u32x2 __attribute__((ext_vector_type(2)));
#define MFMA32(a, b, c) __builtin_amdgcn_mfma_f32_32x32x16_bf16((a), (b), (c), 0, 0, 0)
DI unsigned cvtpk(float lo, float hi) { f32x2 v = {lo, hi}; bf16x2_t b = __builtin_convertvector(v, bf16x2_t); return __builtin_bit_cast(unsigned, b); }
DI float blo(unsigned w) { return __uint_as_float(w << 16); }
DI float bhi(unsigned w) { return __uint_as_float(w & 0xffff0000u); }
DI float bf1(bf16 h) { return __uint_as_float((unsigned)h << 16); }
DI float fexp2(float x) { return __builtin_amdgcn_exp2f(x); }
DI float swapmax(float m) { auto rr = __builtin_amdgcn_permlane32_swap(__float_as_uint(m), __float_as_uint(m), false, false); return fmaxf(__uint_as_float(rr[0]), __uint_as_float(rr[1])); }
DI float swapsum(float m) { auto rr = __builtin_amdgcn_permlane32_swap(__float_as_uint(m), __float_as_uint(m), false, false); return __uint_as_float(rr[0]) + __uint_as_float(rr[1]); }
#define DPPF(v, ctrl) __int_as_float(__builtin_amdgcn_update_dpp(0, __float_as_int(v), (ctrl), 0xf, 0xf, true))
DI float quad_sum(float v) { v += DPPF(v, 0xB1); v += DPPF(v, 0x4E); return v; }
DI float row_sum(float v) { v = quad_sum(v); v += DPPF(v, 0x141); v += DPPF(v, 0x140); return v; }
DI float wave_sum(float v) { v = row_sum(v);
    return __int_as_float(__builtin_amdgcn_readlane(__float_as_int(v), 0)) + __int_as_float(__builtin_amdgcn_readlane(__float_as_int(v), 16)) + (__int_as_float(__builtin_amdgcn_readlane(__float_as_int(v), 32)) + __int_as_float(__builtin_amdgcn_readlane(__float_as_int(v), 48))); }
DI float gelu_tanh(float x) {
    const float u = 0.7978845608028654f * (x + 0.044715f * x * x * x);
    return x * __builtin_amdgcn_rcpf(1.0f + fexp2(-2.0f * LOG2E * u));
}
DI void wg_barrier() { asm volatile("s_waitcnt vmcnt(0) lgkmcnt(0)" ::: "memory"); __builtin_amdgcn_s_barrier(); asm volatile("" ::: "memory"); }
DI void lds_barrier() { asm volatile("s_waitcnt lgkmcnt(0)" ::: "memory"); __builtin_amdgcn_s_barrier(); asm volatile("" ::: "memory"); }

struct Ctx {
    LAS unsigned char* lds;
    int tid, lane, wave, vcu, G;
    float* out; unsigned char* ws;
};

DI void grid_bar(XcdBarrier b) { asm volatile("" : "+s"(b.bar), "+s"(b.x)); xcd_barrier(b); }
struct TrItem { const float* src; bf16* dst; const float* gain; int ldw, Kd, nvalid, fp8; float scale; };
DI TrItem tr_make(const float* W, int ldw, int k0, int c0, int nvalid, bf16* WT, int Kd, int drow, float scale, int lane, int kdst = -1, const float* gain = nullptr) {
    if (kdst < 0) kdst = k0;
    TrItem t; t.gain = gain ? gain + k0 : nullptr; t.src = W + (size_t)(k0 + (lane >> 5)) * ldw + c0 + (lane & 31); t.dst = WT + (size_t)drow * Kd + kdst; t.ldw = ldw; t.Kd = Kd; t.nvalid = nvalid; t.scale = scale; t.fp8 = 0; return t;
}
DI void tr_load(const TrItem& t, float (&wv)[32], int lane) {
#pragma unroll
    for (int i = 0; i < 32; ++i) wv[i] = ((lane & 31) < t.nvalid) ? t.src[(size_t)(2 * i) * t.ldw] : 0.f;
}
DI void tr_store(const TrItem& t, const float (&wv)[32], LAS float* scr, int lane) {
#pragma unroll
    for (int i = 0; i < 32; ++i) scr[(2 * i + (lane >> 5)) * 33 + (lane & 31)] = wv[i] * t.scale;
    LDS_WAIT(); asm volatile("" ::: "memory");
    const int c = lane & 7;
    f32x4 ga = {1.f, 1.f, 1.f, 1.f}, gb = {1.f, 1.f, 1.f, 1.f};
    if (t.gain) { ga = *(const GAS f32x4*)(t.gain + 8 * c); gb = *(const GAS f32x4*)(t.gain + 8 * c + 4); }
#pragma unroll
    for (int j = 0; j < 4; ++j) { const int n = (lane >> 3) + 8 * j; const LAS float* s = scr + (8 * c) * 33 + n;
        const float e0 = s[0 * 33] * ga[0], e1 = s[1 * 33] * ga[1], e2 = s[2 * 33] * ga[2], e3 = s[3 * 33] * ga[3], e4 = s[4 * 33] * gb[0], e5 = s[5 * 33] * gb[1], e6 = s[6 * 33] * gb[2], e7 = s[7 * 33] * gb[3];
        if (t.fp8) { int lo = __builtin_amdgcn_cvt_pk_fp8_f32(e0, e1, 0, false); lo = __builtin_amdgcn_cvt_pk_fp8_f32(e2, e3, lo, true);
            int hi = __builtin_amdgcn_cvt_pk_fp8_f32(e4, e5, 0, false); hi = __builtin_amdgcn_cvt_pk_fp8_f32(e6, e7, hi, true);
            *(GAS u32x2*)((unsigned char*)t.dst + (size_t)n * t.Kd + 8 * c) = (u32x2){(unsigned)lo, (unsigned)hi}; }
        else { v4u o; o.x = cvtpk(e0, e1); o.y = cvtpk(e2, e3); o.z = cvtpk(e4, e5); o.w = cvtpk(e6, e7);
            *(GAS v4u*)(t.dst + (size_t)n * t.Kd + 8 * c) = o; } }
    LDS_WAIT(); asm volatile("" ::: "memory");
}
DI void win_map(int cb, int& c0, int& nv, int& dsel, int& drow, float& sc) {
    nv = 32; dsel = 0; sc = 1.f;
    if (cb < 8)        { c0 = 0 + 32 * cb;            drow = CA_Q + 32 * cb; sc = 0.125f * LOG2E; }
    else if (cb < 16)  { c0 = 256 + 32 * (cb - 8);    drow = CA_K + 32 * (cb - 8); }
    else if (cb < 24)  { c0 = 512 + 32 * (cb - 16);   drow = 32 * (cb - 16); dsel = 1; }
    else if (cb < 32)  { c0 = 768 + 32 * (cb - 24);   drow = CI_Q + 32 * (cb - 24); sc = 0.125f; }
    else if (cb == 32) { c0 = 1024;                   drow = 768; }
    else if (cb == 33) { c0 = 1056;                   drow = 768 + 128; }
    else if (cb == 34) { c0 = 1088; nv = 4;           drow = CI_W; sc = 0.5f; }
    else if (cb < 43)  { c0 = 1092 + 32 * (cb - 35);  drow = CB_U + 32 * (cb - 35); }
    else if (cb < 51)  { c0 = 1348 + 32 * (cb - 43);  drow = CB_V + 32 * (cb - 43); }
    else if (cb < 59)  { c0 = 1604 + 32 * (cb - 51);  drow = CC_Q + 32 * (cb - 51); sc = 0.17677669529663687f * LOG2E; }
    else if (cb < 67)  { c0 = 1860 + 32 * (cb - 59);  drow = CC_K + 32 * (cb - 59); }
    else if (cb < 75)  { c0 = 2116 + 32 * (cb - 67);  drow = 256 + 32 * (cb - 67); dsel = 1; }
    else               { c0 = 2372 + 32 * (cb - 75);  drow = 32 * (cb - 75); dsel = 2; sc = 32.0f; }
}
constexpr int NCB_IN = 75 + 96;
constexpr int I_IN = NCB_IN * 16, I_B = 32 * 4, I_O = 32 * 16, I_F1 = 128 * 16, I_F2 = 32 * 64;
constexpr int PER_LAYER = I_IN + 3 * I_B + I_O + I_F1 + I_F2;
DI TrItem tr_desc(int it, unsigned char* wsb, const float* g1, const float* g2, const float* w_in, const float* wba, const float* wbb, const float* wbc, const float* w_o, const float* w_f1, const float* w_f2, int lane) {
    const int l = it / PER_LAYER; int r = it % PER_LAYER;
    unsigned char* wl = wsb + WS_WL + (size_t)l * WL_STRIDE;
    if (r < I_IN) { const int cb = r % NCB_IN, kb = r / NCB_IN; int c0, nv, dsel, drow; float sc; win_map(cb, c0, nv, dsel, drow, sc);
        if (dsel == 2) { TrItem t = tr_make(w_in + (size_t)l * DM * NIN, NIN, 64 * kb, c0, nv, (bf16*)(wsb + WS_WG8 + (size_t)l * 3 * MiB), DM, 0, sc, lane, 0, g1 + l * DM); t.gain = g1 + l * DM + 64 * kb;
            t.dst = (bf16*)((unsigned char*)(wsb + WS_WG8 + (size_t)l * 3 * MiB) + (size_t)drow * DM + 64 * kb); t.fp8 = 1; return t; }
        return tr_make(w_in + (size_t)l * DM * NIN, NIN, 64 * kb, c0, nv, (bf16*)(wl + (dsel ? WO_VT : WO_IN1)), DM, drow, sc, lane, -1, g1 + l * DM); }
    r -= I_IN;
    if (r < 3 * I_B) { const int w = r / I_B, q = r % I_B, cb = q % 32, kb = q / 32;
        return tr_make((w == 0 ? wba : (w == 1 ? wbb : wbc)) + (size_t)l * 256 * DM, DM, 64 * kb, 32 * cb, 32, (bf16*)(wl + WO_B), 768, 32 * cb, 1.f, lane, 256 * w + 64 * kb); }
    r -= 3 * I_B;
    if (r < I_O) { const int cb = r % 32, kb = r / 32; return tr_make(w_o + (size_t)l * DM * DM, DM, 64 * kb, 32 * cb, 32, (bf16*)(wl + WO_O), DM, 32 * cb, 1.f, lane); }
    r -= I_O;
    if (r < I_F1) { const int cb = r % 128, kb = r / 128; return tr_make(w_f1 + (size_t)l * DM * FF, FF, 64 * kb, 32 * cb, 32, (bf16*)(wl + WO_F1), DM, 32 * cb, 1.f, lane, -1, g2 + l * DM); }
    r -= I_F1;
    { const int cb = r % 32, kb = r / 32; return tr_make(w_f2 + (size_t)l * FF * DM, DM, 64 * kb, 32 * cb, 32, (bf16*)(wl + WO_F2), FF, 32 * cb, 1.f, lane); }
}
DI void prologue_weights(const Ctx& C, unsigned char* wsb, const float* g1, const float* g2, const float* w_in, const float* w_s, const float* wba, const float* wbb, const float* wbc, const float* w_o, const float* w_f1, const float* w_f2) {
    LAS float* scr = (LAS float*)(C.lds + C.wave * 16384);
    const int gw = C.vcu * NWAVES + C.wave, NGW = C.G * NWAVES;
    {
        constexpr int TOTAL = DEPTH * PER_LAYER;
        float wa[32], wb[32]; TrItem ta, tb;
        int it = gw;
        if (it < TOTAL) { ta = tr_desc(it, wsb, g1, g2, w_in, wba, wbb, wbc, w_o, w_f1, w_f2, C.lane); tr_load(ta, wa, C.lane); }
        while (it < TOTAL) {
            if (it + NGW < TOTAL) { tb = tr_desc(it + NGW, wsb, g1, g2, w_in, wba, wbb, wbc, w_o, w_f1, w_f2, C.lane); tr_load(tb, wb, C.lane); }
            tr_store(ta, wa, scr, C.lane);
            it += NGW; if (it >= TOTAL) break;
            if (it + NGW < TOTAL) { ta = tr_desc(it + NGW, wsb, g1, g2, w_in, wba, wbb, wbc, w_o, w_f1, w_f2, C.lane); tr_load(ta, wa, C.lane); }
            tr_store(tb, wb, scr, C.lane);
            it += NGW;
        }
    }
    const int gt = C.vcu * NTHREADS + C.tid, NGT = C.G * NTHREADS;
    for (int it = gt; it < DEPTH * 160 * 128; it += NGT) { const int l = it / (160 * 128), q = it % (160 * 128), rr = q / 128, ch = q % 128;
        const int row = rr < 64 ? 832 + rr : 928 + (rr - 64);
        *(GAS v4u*)((bf16*)(wsb + WS_WL + (size_t)l * WL_STRIDE + WO_IN1) + (size_t)row * DM + 8 * ch) = (v4u){0u, 0u, 0u, 0u}; }
    for (int it = gt; it < DEPTH * 4 * 128 * 128 / 2; it += NGT) { const int e = 2 * it, l = e / 65536, q = e % 65536, t = (q >> 7) & 127, s = q & 127;
        const float* src = w_s + e; const float a = (s <= t) ? src[0] : 0.f, b = (s + 1 <= t) ? src[1] : 0.f;
        *(GAS unsigned*)((bf16*)(wsb + WS_WL + (size_t)l * WL_STRIDE + WO_S) + q) = cvtpk(a, b); }
}
DI void rmsnorm_rows(const Ctx& C, const float* src, const float* g, bf16* dstb, float* dstf, unsigned char* dst8 = nullptr, const bf16* src16 = nullptr) {
    int tid_ = C.wave * 64 + lane_id_now(); asm volatile("" : "+v"(tid_));
    const int lane = tid_ & 63, wave = __builtin_amdgcn_readfirstlane(tid_ >> 6);
    const int gw = C.vcu * NWAVES + wave, NGW = C.G * NWAVES;
    f32x4 gv[4];
#pragma unroll
    for (int j = 0; j < 4; ++j) gv[j] = *((const GAS f32x4*)g + lane + 64 * j);
    for (int m = gw; m < MROWS; m += NGW) {
        f32x4 v[4]; float s = 0.f;
        if (src16) { const GAS u32x2* xr = (const GAS u32x2*)(src16 + (size_t)m * DM) + lane;
#pragma unroll
            for (int j = 0; j < 4; ++j) { const u32x2 p = xr[64 * j]; v[j] = (f32x4){blo(p.x), bhi(p.x), blo(p.y), bhi(p.y)}; } }
        else { const GAS f32x4* xr = (const GAS f32x4*)(src + (size_t)m * DM) + lane;
#pragma unroll
            for (int j = 0; j < 4; ++j) v[j] = xr[64 * j]; }
#pragma unroll
        for (int j = 0; j < 4; ++j) s += (v[j].x * v[j].x + v[j].y * v[j].y) + (v[j].z * v[j].z + v[j].w * v[j].w);
        const float rstd = 1.0f / sqrtf(wave_sum(s) * (1.0f / DM) + EPS);
        if (dstb) { GAS u32x2* o8 = (GAS u32x2*)(dstb + (size_t)m * DM) + lane;
#pragma unroll
            for (int j = 0; j < 4; ++j) { const f32x4 y = v[j] * rstd * gv[j]; o8[64 * j] = (u32x2){cvtpk(y.x, y.y), cvtpk(y.z, y.w)};
                if (dst8) { int p = __builtin_amdgcn_cvt_pk_fp8_f32(y.x, y.y, 0, false); p = __builtin_amdgcn_cvt_pk_fp8_f32(y.z, y.w, p, true); *((GAS unsigned*)(dst8 + (size_t)m * DM) + lane + 64 * j) = (unsigned)p; } } }
        else { GAS f32x4* o = (GAS f32x4*)(dstf + (size_t)m * DM) + lane;
#pragma unroll
            for (int j = 0; j < 4; ++j) o[64 * j] = v[j] * rstd * gv[j]; }
    }
}

DI void prep_rows(const Ctx& C, const float* src, bf16* xb, unsigned char* x8, float* rs) {
    int tid_ = C.wave * 64 + lane_id_now(); asm volatile("" : "+v"(tid_));
    const int lane = tid_ & 63, wave = __builtin_amdgcn_readfirstlane(tid_ >> 6);
    const int gw = C.vcu * NWAVES + wave, NGW = C.G * NWAVES;
    for (int m = gw; m < MROWS; m += NGW) {
        const GAS f32x4* xr = (const GAS f32x4*)(src + (size_t)m * DM) + lane;
        f32x4 v[4]; float s = 0.f;
#pragma unroll
        for (int j = 0; j < 4; ++j) { v[j] = xr[64 * j]; s += (v[j].x * v[j].x + v[j].y * v[j].y) + (v[j].z * v[j].z + v[j].w * v[j].w); }
        s = wave_sum(s);
        GAS u32x2* o8 = (GAS u32x2*)(xb + (size_t)m * DM) + lane;
#pragma unroll
        for (int j = 0; j < 4; ++j) { o8[64 * j] = (u32x2){cvtpk(v[j].x, v[j].y), cvtpk(v[j].z, v[j].w)};
            int p = __builtin_amdgcn_cvt_pk_fp8_f32(v[j].x, v[j].y, 0, false); p = __builtin_amdgcn_cvt_pk_fp8_f32(v[j].z, v[j].w, p, true); *((GAS unsigned*)(x8 + (size_t)m * DM) + lane + 64 * j) = (unsigned)p; }
        if (lane < 16) *(GAS float*)(rs + (size_t)m * 16 + lane) = lane == 0 ? s : 0.f;
    }
}
DI float relu_bits(float x) { const int i = __float_as_int(x); return __int_as_float(i > 0 ? i : 0); }
DI int pi32(int x) { return (x & 0x13) | ((x & 4) << 1) | ((x & 8) >> 1); }
#define DPPU(v, ctrl) ((unsigned)__builtin_amdgcn_update_dpp(0, (int)(v), (ctrl), 0xf, 0xf, true))
DI unsigned suffix_excl(unsigned T, int lane) {
    unsigned s = T;
    s += DPPU(s, 0x101); s += DPPU(s, 0x102); s += DPPU(s, 0x104); s += DPPU(s, 0x108);
    const unsigned r1 = (unsigned)__builtin_amdgcn_readlane((int)s, 16), r2 = (unsigned)__builtin_amdgcn_readlane((int)s, 32), r3 = (unsigned)__builtin_amdgcn_readlane((int)s, 48);
    s += (lane < 16 ? r1 : 0u) + (lane < 32 ? r2 : 0u) + (lane < 48 ? r3 : 0u);
    return s - T;
}
#ifndef SEL_FAST_MAX
#define SEL_FAST_MAX 256u
#endif
#ifndef SEL_RANK_MAX
#define SEL_RANK_MAX 0u
#endif
constexpr int SC_OFF = 0, HR_OFF = 65536;
constexpr int CL_OFF = 131072;
DI void select_phase(const Ctx& C, int b, int wi, const bf16* projA, const bf16* kidx, unsigned long long* mask) {
    LAS unsigned short* scores = (LAS unsigned short*)(C.lds + SC_OFF);
    LAS unsigned* hist = (LAS unsigned*)(C.lds + HR_OFF);
    int tid_ = C.wave * 64 + lane_id_now(); asm volatile("" : "+v"(tid_));
    const int tid = tid_, lane = tid & 63, wave = __builtin_amdgcn_readfirstlane(tid >> 6), hi = lane >> 5, l31 = lane & 31;
    const size_t rowb = (size_t)b * SEQ;
    unsigned z0 = 0u; asm volatile("" : "+v"(z0)); const v4u zero4 = {z0, z0, z0, z0};
    { LAS v4u* h4 = (LAS v4u*)hist;
#pragma unroll
      for (int k = 0; k < 8; ++k) h4[tid + 512 * k] = zero4; }
    const bf16* kbase = kidx + (((rowb >> 5) * 8 + hi) * 32 + l31) * 8;
    { const int t = 8 * wi + wave;
      if (lane <= (t >> 6)) { const int rem = t - 64 * lane;
          const int c0_ = rem + 1 < 32 ? rem + 1 : 32, c1_ = rem + 1 - 32 < 0 ? 0 : (rem + 1 - 32 < 32 ? rem + 1 - 32 : 32);
          const unsigned w0_ = (unsigned)((1ull << ((c0_ + 1) >> 1)) - 1ull) | ((unsigned)((1ull << (c0_ >> 1)) - 1ull) << 16), w1_ = (unsigned)((1ull << ((c1_ + 1) >> 1)) - 1ull) | ((unsigned)((1ull << (c1_ >> 1)) - 1ull) << 16);
          mask[(rowb + t) * 64 + lane] = ((unsigned long long)w1_ << 32) | w0_; } }
    const int lperm = (lane & 32) + ((lane & 16) ? 2 * (lane & 15) + 1 : 2 * (lane & 15));
#define SEL_QLOAD(QF, CW, t0_) do { const bf16* qp_ = projA + (rowb + (t0_) + (l31 >> 2)) * 2048 + CI_Q + (l31 & 3) * 64 + 8 * hi; \
        _Pragma("unroll") for (int kk = 0; kk < 4; ++kk) QF[kk] = *(const bf16x8*)(qp_ + 16 * kk); \
        _Pragma("unroll") for (int jq = 0; jq < 4; ++jq) CW[jq] = *(const u32x2*)(projA + (rowb + (t0_) + 2 * jq + hi) * 2048 + CI_W); } while (0)
    bf16x8 qf[4], qfn[4]; u32x2 cw[4], cwn[4];
    SEL_QLOAD(qf, cw, 8 * (32 + 31 - wi));
    const int hbase = ((l31 & 3) * 8 + hi) * 512;
    lds_barrier();
#pragma unroll 1
    for (int j = 1; j < 16; ++j) {
    const int t0 = 8 * (32 * j + ((j & 1) ? 31 - wi : wi));
    const int nk = (t0 + 8 + 63) & ~63, ntile = nk >> 5;
    float coef[16];
#pragma unroll
    for (int jq = 0; jq < 4; ++jq) { coef[4 * jq] = blo(cw[jq].x); coef[4 * jq + 1] = bhi(cw[jq].x); coef[4 * jq + 2] = blo(cw[jq].y); coef[4 * jq + 3] = bhi(cw[jq].y); }
#define SEL_LOAD(K, tile) do { const bf16* kp_ = kbase + (size_t)(tile) * (8 * 32 * 8); \
        asm volatile("global_load_dwordx4 %0, %4, off\n\tglobal_load_dwordx4 %1, %4, off offset:1024\n\tglobal_load_dwordx4 %2, %4, off offset:2048\n\tglobal_load_dwordx4 %3, %4, off offset:3072" \
                     : "=&v"(K[0]), "=&v"(K[1]), "=&v"(K[2]), "=&v"(K[3]) : "v"(kp_) : "memory"); } while (0)
#define SEL_WAIT(K, n) asm volatile("s_waitcnt vmcnt(" #n ")" : "+v"(K[0]), "+v"(K[1]), "+v"(K[2]), "+v"(K[3]) :: "memory")
#define SEL_COMP(K, tile) do { const int kv0_ = (tile) * 32; f32x16 acc = {}; \
        _Pragma("unroll") for (int kk = 0; kk < 4; ++kk) acc = MFMA32(qf[kk], K[kk], acc); \
        const int key = kv0_ + l31; const bool edge = kv0_ + 31 > t0; \
        _Pragma("unroll") for (int jq = 0; jq < 4; ++jq) { float sc = 0.f; \
            _Pragma("unroll") for (int h = 0; h < 4; ++h) sc = fmaf(coef[4 * jq + h], relu_bits(acc[4 * jq + h]), sc); \
            const int q = 2 * jq + hi; float x = fmaf(sc, 4096.0f, 32768.0f); x = fminf(fmaxf(x, 0.0f), 65535.0f); \
            unsigned u = (unsigned)(int)x; if (edge && key > t0 + q) u = 0u; \
            scores[q * 4096 + key] = (unsigned short)u; \
            __hip_atomic_fetch_add(hist + hbase + 1024 * jq + (u >> 7), 1u << ((u >> 2) & 16u), __ATOMIC_RELAXED, __HIP_MEMORY_SCOPE_WORKGROUP); } } while (0)
    {
        bf16x8 ka[4], kb[4], kc[4];
        const int cnt = (ntile - wave + 7) >> 3, tlast = wave + 8 * (cnt - 1);
#define SEL_T(i) ((wave + 8 * (i)) < tlast ? (wave + 8 * (i)) : tlast)
        SEL_LOAD(ka, SEL_T(0)); SEL_LOAD(kb, SEL_T(1));
        for (int i = 0; i < cnt; i += 3) {
            SEL_LOAD(kc, SEL_T(i + 2)); SEL_WAIT(ka, 8); SEL_COMP(ka, wave + 8 * i);
            if (i + 1 < cnt) { SEL_LOAD(ka, SEL_T(i + 3)); SEL_WAIT(kb, 8); SEL_COMP(kb, wave + 8 * (i + 1)); }
            if (i + 2 < cnt) { SEL_LOAD(kb, SEL_T(i + 4)); SEL_WAIT(kc, 8); SEL_COMP(kc, wave + 8 * (i + 2)); }
        }
        asm volatile("s_waitcnt vmcnt(0)" : "+v"(ka[0]), "+v"(ka[1]), "+v"(ka[2]), "+v"(ka[3]), "+v"(kb[0]), "+v"(kb[1]), "+v"(kb[2]), "+v"(kb[3]), "+v"(kc[0]), "+v"(kc[1]), "+v"(kc[2]), "+v"(kc[3]) :: "memory");
#undef SEL_T
    }
#undef SEL_WAIT
#undef SEL_LOAD
#undef SEL_COMP
    lds_barrier();
    if (j + 1 < 16) { const int t0n = 8 * (32 * (j + 1) + (((j + 1) & 1) ? 31 - wi : wi)); SEL_QLOAD(qfn, cwn, t0n); }
    {
        const int q = wave, t = t0 + q, nch = nk >> 6;
        LAS unsigned* hq = hist + q * 512;
        LAS unsigned short* sq = scores + q * 4096;
        unsigned bstar, krem, cbin;
        {
            unsigned ps = 0u;
#pragma unroll
            for (int r = 0; r < 4; ++r) { const v4u a = *(LAS v4u*)(hq + 4096 * r + 8 * lane), c = *(LAS v4u*)(hq + 4096 * r + 8 * lane + 4);
                ps += ((a.x + a.y) + (a.z + a.w)) + ((c.x + c.y) + (c.z + c.w)); }
            const unsigned T = (ps & 0xffffu) + (ps >> 16);
            const unsigned above = suffix_excl(T, lane);
            const int src = (int)__builtin_ctzll(__ballot(above < 256u && above + T >= 256u));
            const unsigned aboveS = (unsigned)__builtin_amdgcn_readlane((int)above, src);
            unsigned cb = 0u;
            if (lane < 16) {
#pragma unroll
                for (int r = 0; r < 4; ++r) cb += (unsigned)((const LAS unsigned short*)(hq + 4096 * r))[16 * src + lane]; }
            const unsigned above2 = aboveS + suffix_excl(cb, lane);
            const int is = (int)__builtin_ctzll(__ballot(lane < 16 && above2 < 256u && above2 + cb >= 256u));
            bstar = 16u * (unsigned)src + (unsigned)is; krem = 256u - (unsigned)__builtin_amdgcn_readlane((int)above2, is); cbin = (unsigned)__builtin_amdgcn_readlane((int)cb, is);
        }
        const unsigned long long lt = (1ull << lane) - 1ull;
        LAS unsigned* klist = (LAS unsigned*)(C.lds + CL_OFF) + wave * 512;
        LAS unsigned* whist = klist + 256;
        LAS unsigned short* ilist = (LAS unsigned short*)(C.lds + ILIST_OFF) + wave * 256;
        LAS unsigned long long* mwords = (LAS unsigned long long*)(C.lds + MW_OFF) + wave * 64;
        if (cbin <= SEL_FAST_MAX) {
            unsigned cbase = 0;
            unsigned wlo = 0u, whi = 0u;
            for (int c0 = 0; c0 < nch; c0 += 4) {
                unsigned key4[4]; unsigned long long wp4[4];
#pragma unroll
                for (int u = 0; u < 4; ++u) key4[u] = (unsigned)sq[64 * (c0 + u) + lperm];
#pragma unroll
                for (int u = 0; u < 4; ++u) { const unsigned bin = key4[u] >> 6; const unsigned long long wa = __ballot(bin > bstar); wp4[u] = (c0 + u < nch) ? __ballot(bin == bstar) : 0ull;
                    if (lane == c0 + u) { wlo = (unsigned)wa; whi = (unsigned)(wa >> 32); } }
                if ((wp4[0] | wp4[1]) | (wp4[2] | wp4[3])) {
#pragma unroll
                    for (int u = 0; u < 4; ++u) if (wp4[u]) { const unsigned pos = cbase + (unsigned)__builtin_popcountll(wp4[u] & lt);
                        if ((key4[u] >> 6) == bstar) { klist[pos] = key4[u]; ilist[pos] = (unsigned short)(64 * (c0 + u) + lperm); }
                        cbase += (unsigned)__builtin_popcountll(wp4[u]); } } }
            mwords[lane] = ((unsigned long long)whi << 32) | wlo;
            const int ncc = (int)((cbase + 63u) >> 6);
            if (cbase <= SEL_RANK_MAX) {
                const bool valid = (unsigned)lane < cbase;
                const unsigned key = valid ? klist[lane] : 0u; const unsigned idx = valid ? (unsigned)ilist[lane] : 0u;
                unsigned rank = 0;
                for (int jj = 0; jj < (int)cbase; ++jj) { const unsigned kj = (unsigned)__builtin_amdgcn_readlane((int)key, jj); rank += (kj > key || (kj == key && jj < lane)) ? 1u : 0u; }
                if (valid && rank < krem) __hip_atomic_fetch_or((LAS unsigned*)mwords + (idx >> 5), 1u << (((idx & 31u) >> 1) + 16u * (idx & 1u)), __ATOMIC_RELAXED, __HIP_MEMORY_SCOPE_WORKGROUP);
            } else {
                *(LAS unsigned*)(whist + lane) = z0;
                for (int k = 0; k < ncc; ++k) { const unsigned i = 64u * k + lane; if (i < cbase) __hip_atomic_fetch_add(whist + (klist[i] & 63u), 1u, __ATOMIC_RELAXED, __HIP_MEMORY_SCOPE_WORKGROUP); }
                const unsigned T = whist[lane];
                const unsigned above = suffix_excl(T, lane);
                const int ds = (int)__builtin_ctzll(__ballot(above < krem && above + T >= krem));
                const unsigned krem2 = krem - (unsigned)__builtin_amdgcn_readlane((int)above, ds);
                const unsigned tau = (bstar << 6) | (unsigned)ds;
                unsigned taken = 0;
                for (int k = 0; k < ncc; ++k) { const unsigned i = 64u * k + lane; const bool valid = i < cbase;
                    const unsigned key = valid ? klist[i] : 0u; const unsigned idx = valid ? (unsigned)ilist[i] : 0u;
                    const bool eq = valid && key == tau; const unsigned long long beq = __ballot(eq);
                    const bool sel = valid && (key > tau || (eq && taken + (unsigned)__builtin_popcountll(beq & lt) < krem2));
                    taken += (unsigned)__builtin_popcountll(beq);
                    if (sel) __hip_atomic_fetch_or((LAS unsigned*)mwords + (idx >> 5), 1u << (((idx & 31u) >> 1) + 16u * (idx & 1u)), __ATOMIC_RELAXED, __HIP_MEMORY_SCOPE_WORKGROUP); }
            }
            if (lane < nch) mask[(rowb + t) * 64 + lane] = mwords[lane];
        } else {
            *(LAS unsigned*)(whist + lane) = z0;
            for (int c = 0; c < nch; ++c) { const unsigned key = (unsigned)sq[64 * c + lperm]; if ((key >> 6) == bstar) __hip_atomic_fetch_add(whist + (key & 63u), 1u, __ATOMIC_RELAXED, __HIP_MEMORY_SCOPE_WORKGROUP); }
            const unsigned T = whist[lane];
            const unsigned above = suffix_excl(T, lane);
            const int ds = (int)__builtin_ctzll(__ballot(above < krem && above + T >= krem));
            const unsigned krem2 = krem - (unsigned)__builtin_amdgcn_readlane((int)above, ds);
            const unsigned tau = (bstar << 6) | (unsigned)ds;
            unsigned long long myword = 0ull; unsigned taken = 0;
            for (int c = 0; c < nch; ++c) { const unsigned key = (unsigned)sq[64 * c + lperm];
                const bool eq = key == tau; const unsigned long long beq = __ballot(eq);
                const bool sel = key > tau || (eq && taken + (unsigned)__builtin_popcountll(beq & lt) < krem2);
                taken += (unsigned)__builtin_popcountll(beq);
                const unsigned long long w = __ballot(sel);
                if (lane == c) myword = w; }
            if (lane < nch) mask[(rowb + t) * 64 + lane] = myword;
        }
    }
    { LAS unsigned* hq = hist + wave * 512;
#pragma unroll
      for (int r = 0; r < 4; ++r) { *(LAS v4u*)(hq + 4096 * r + 8 * lane) = zero4; *(LAS v4u*)(hq + 4096 * r + 8 * lane + 4) = zero4; } }
    lds_barrier();
#pragma unroll
    for (int kk = 0; kk < 4; ++kk) { qf[kk] = qfn[kk]; cw[kk] = cwn[kk]; }
    }
#undef SEL_QLOAD
}

constexpr int AT_STAGE = 16384;
struct AttnArgs { const bf16* projA; const bf16* VT; const unsigned long long* mask; bf16* Y; int qcol, kcol, vrow; float lam, oscale; const float* subg; };
template <int MODE, int TPS, bool FAST>
DI void attn_unit(const Ctx& C, const AttnArgs& A, int b, int h, int qb) {
    LAS unsigned char* lds = C.lds;
    int tid_ = C.wave * 64 + lane_id_now(); asm volatile("" : "+v"(tid_));
    const int tid = tid_, lane = tid & 63, wave = __builtin_amdgcn_readfirstlane(tid >> 6), hi = lane >> 5, l31 = lane & 31;
    const size_t rowb = (size_t)b * SEQ; const int q0 = qb * 256, qw0 = q0 + 32 * wave, tq = qw0 + l31;
    const int nkt = (q0 + 256) >> 6;
    const int sk = tid >> 3, sp = tid & 7;
    const bf16* kg = A.projA + (rowb + sk) * 2048 + A.kcol + h * 64 + 8 * sp;
    const bf16* vg = A.VT + (size_t)(A.vrow + h * 64 + sk) * MROWS + rowb + 8 * sp;
    const int kdst = ((sk >> 5) * 8 + sp) * 512 + ((pi32(sk & 31) ^ sp) * 16);
    const int vdst = 8192 + ((sk >> 5) * 8 + sp) * 512 + (((sk & 31) ^ sp) * 16);
    bf16x8 qf[4];
    { const bf16* qp = A.projA + (rowb + tq) * 2048 + A.qcol + h * 64 + 8 * hi;
#pragma unroll
      for (int kk = 0; kk < 4; ++kk) qf[kk] = *(const bf16x8*)(qp + 16 * kk); }
    constexpr int NC = MODE == 1 ? 2 : 1;
    f32x16 O[NC][2], negm[MODE == 0 ? 1 : 1]; float mref[NC], lsum[NC];
    negm[0] = f32x16{};
#pragma unroll
    for (int c = 0; c < NC; ++c) { O[c][0] = f32x16{}; O[c][1] = f32x16{}; mref[c] = 0.f; lsum[c] = 0.f; }
    {
#pragma unroll
      for (int tt = 0; tt < TPS; ++tt) { const v4u kr = *(const GAS v4u*)(kg + (size_t)(tt * 64) * 2048), vr = *(const GAS v4u*)(vg + tt * 64);
        *(LAS v4u*)(lds + tt * AT_STAGE + kdst) = kr; *(LAS v4u*)(lds + tt * AT_STAGE + vdst) = vr; } }
    unsigned long long mw[TPS], mwn[TPS];
#pragma unroll
    for (int tt = 0; tt < TPS; ++tt) { mw[tt] = 0ull; mwn[tt] = 0ull; if (MODE == 0) mw[tt] = A.mask[(rowb + tq) * 64 + tt]; }
    lds_barrier();
    const int nst = nkt / TPS;
    if (wave >= 4) __builtin_amdgcn_s_setprio(1);
    for (int s = 0; s < nst; ++s) {
        v4u kr[TPS], vr[TPS];
        const bool more = s + 1 < nst;
        if (more) {
#pragma unroll
            for (int tt = 0; tt < TPS; ++tt) { const int kvn = ((s + 1) * TPS + tt) * 64; kr[tt] = *(const GAS v4u*)(kg + (size_t)kvn * 2048); vr[tt] = *(const GAS v4u*)(vg + kvn);
                if (MODE == 0) mwn[tt] = A.mask[(rowb + tq) * 64 + (s + 1) * TPS + tt]; } }
#pragma unroll
        for (int tt = 0; tt < TPS; ++tt) {
        const int kt = s * TPS + tt;
        const int kv0 = kt * 64; LAS unsigned char* st = lds + ((s & 1) * TPS + tt) * AT_STAGE;
        if (kv0 <= qw0 + 31) {
            const bool diag = kv0 + 63 > qw0;
#pragma unroll
            for (int c = 0; c < NC; ++c) {
                f32x16 S0, S1;
                if (MODE == 0) {
#pragma unroll
                    for (int kk = 0; kk < 4; ++kk) { const int pb = kk * 2 + hi;
                        const bf16x8 k0 = *(const LAS bf16x8*)(st + (0 * 8 + pb) * 512 + ((l31 ^ pb) * 16)), k1 = *(const LAS bf16x8*)(st + (1 * 8 + pb) * 512 + ((l31 ^ pb) * 16));
                        S0 = MFMA32(k0, qf[kk], kk == 0 ? (FAST ? f32x16{} : negm[0]) : S0); S1 = MFMA32(k1, qf[kk], kk == 0 ? (FAST ? f32x16{} : negm[0]) : S1); }
                } else {
#pragma unroll
                    for (int k2 = 0; k2 < 2; ++k2) { const int kk = 2 * c + k2, pb = kk * 2 + hi;
                        const bf16x8 k0 = *(const LAS bf16x8*)(st + (0 * 8 + pb) * 512 + ((l31 ^ pb) * 16)), k1 = *(const LAS bf16x8*)(st + (1 * 8 + pb) * 512 + ((l31 ^ pb) * 16));
                        S0 = MFMA32(k0, qf[kk], k2 == 0 ? f32x16{} : S0); S1 = MFMA32(k1, qf[kk], k2 == 0 ? f32x16{} : S1); }
                }
                if (MODE == 1 && diag) {
                    const int kb = kv0 + 8 * hi;
#pragma unroll
                    for (int r = 0; r < 16; ++r) { const int key = kb + 16 * (r >> 3) + (r & 7);
                        if (key > tq) S0[r] = -INFINITY; if (key + 32 > tq) S1[r] = -INFINITY; }
                }
                if (!FAST) {
                float mxa = fmaxf(fmaxf(S0[0], S0[1]), S1[0]), mxb = fmaxf(fmaxf(S0[2], S0[3]), S1[1]);
                mxa = fmaxf(fmaxf(mxa, S1[2]), S1[3]);
#pragma unroll
                for (int r = 4; r < 16; r += 4) { mxa = fmaxf(fmaxf(mxa, S0[r]), S0[r + 1]); mxb = fmaxf(fmaxf(mxb, S0[r + 2]), S0[r + 3]); mxa = fmaxf(fmaxf(mxa, S1[r]), S1[r + 1]); mxb = fmaxf(fmaxf(mxb, S1[r + 2]), S1[r + 3]); }
                const float mx = swapmax(fmaxf(mxa, mxb)) - (MODE == 1 ? mref[c] : 0.f);
                if (kt == 0 || __any(mx > 8.0f)) {
                    const float dl = (kt == 0) ? mx : fmaxf(mx, 0.f); const float alpha = fexp2(-dl);
                    mref[c] += dl; lsum[c] *= alpha;
#pragma unroll
                    for (int r = 0; r < 16; ++r) { O[c][0][r] *= alpha; O[c][1][r] *= alpha; }
                    if (MODE == 0) {
#pragma unroll
                        for (int r = 0; r < 16; ++r) { S0[r] -= dl; S1[r] -= dl; negm[0][r] = -mref[c]; } }
                }
                }
                if (MODE == 0 || FAST) {
#pragma unroll
                    for (int r = 0; r < 16; ++r) { S0[r] = fexp2(S0[r]); S1[r] = fexp2(S1[r]); }
                } else {
#pragma unroll
                    for (int r = 0; r < 16; ++r) { S0[r] = fexp2(S0[r] - mref[c]); S1[r] = fexp2(S1[r] - mref[c]); }
                }
                bf16x8 pf[4];
                if (MODE == 0 && FAST) {
                    typedef short s16x2 __attribute__((ext_vector_type(2)));
                    const unsigned long long sh = mw[tt] >> (4 * hi); const unsigned lo = (unsigned)sh, hw = (unsigned)(sh >> 32);
                    unsigned w0[8], w1[8];
#pragma unroll
                    for (int j = 0; j < 8; ++j) { const int cj = 8 * (j >> 2) + (j & 3);
                        const s16x2 m0 = (__builtin_bit_cast(s16x2, lo) << (short)(15 - cj)) >> (short)15, m1 = (__builtin_bit_cast(s16x2, hw) << (short)(15 - cj)) >> (short)15;
                        w0[j] = cvtpk(S0[2 * j], S0[2 * j + 1]) & __builtin_bit_cast(unsigned, m0); w1[j] = cvtpk(S1[2 * j], S1[2 * j + 1]) & __builtin_bit_cast(unsigned, m1); }
                    { v4u w; w = (v4u){w0[0], w0[1], w0[2], w0[3]}; pf[0] = __builtin_bit_cast(bf16x8, w); w = (v4u){w0[4], w0[5], w0[6], w0[7]}; pf[1] = __builtin_bit_cast(bf16x8, w);
                      w = (v4u){w1[0], w1[1], w1[2], w1[3]}; pf[2] = __builtin_bit_cast(bf16x8, w); w = (v4u){w1[4], w1[5], w1[6], w1[7]}; pf[3] = __builtin_bit_cast(bf16x8, w); }
                    const unsigned one2 = 0x3f803f80u; const v4u ow = {one2, one2, one2, one2}; const bf16x8 ones = __builtin_bit_cast(bf16x8, ow);
#pragma unroll
                    for (int cc = 0; cc < 4; ++cc) negm[0] = MFMA32(ones, pf[cc], negm[0]);
                } else {
                if (MODE == 0) {
                    const unsigned long long sh = mw[tt] >> (4 * hi); const int lo = (int)(unsigned)sh, hw = (int)(unsigned)(sh >> 32);
#pragma unroll
                    for (int r = 0; r < 16; ++r) { const int pos = 8 * (r >> 3) + ((r & 7) >> 1) + 16 * (r & 1);
                        S0[r] = __uint_as_float(__float_as_uint(S0[r]) & (unsigned)__builtin_amdgcn_sbfe(lo, pos, 1));
                        S1[r] = __uint_as_float(__float_as_uint(S1[r]) & (unsigned)__builtin_amdgcn_sbfe(hw, pos, 1)); }
                }
                float lsa = 0.f, lsb = 0.f;
#pragma unroll
                for (int r = 0; r < 16; r += 2) { lsa += S0[r] + S1[r]; lsb += S0[r + 1] + S1[r + 1]; }
                lsum[c] += lsa + lsb;
                { v4u w;
                  w = (v4u){cvtpk(S0[0], S0[1]), cvtpk(S0[2], S0[3]), cvtpk(S0[4], S0[5]), cvtpk(S0[6], S0[7])};     pf[0] = __builtin_bit_cast(bf16x8, w);
                  w = (v4u){cvtpk(S0[8], S0[9]), cvtpk(S0[10], S0[11]), cvtpk(S0[12], S0[13]), cvtpk(S0[14], S0[15])}; pf[1] = __builtin_bit_cast(bf16x8, w);
                  w = (v4u){cvtpk(S1[0], S1[1]), cvtpk(S1[2], S1[3]), cvtpk(S1[4], S1[5]), cvtpk(S1[6], S1[7])};     pf[2] = __builtin_bit_cast(bf16x8, w);
                  w = (v4u){cvtpk(S1[8], S1[9]), cvtpk(S1[10], S1[11]), cvtpk(S1[12], S1[13]), cvtpk(S1[14], S1[15])}; pf[3] = __builtin_bit_cast(bf16x8, w); }
                }
#pragma unroll
                for (int dh = 0; dh < 2; ++dh)
#pragma unroll
                    for (int cc = 0; cc < 4; ++cc) { const int pb = cc * 2 + hi;
                        const bf16x8 vf = *(const LAS bf16x8*)(st + 8192 + (dh * 8 + pb) * 512 + ((l31 ^ pb) * 16));
                        O[c][dh] = MFMA32(vf, pf[cc], O[c][dh]); }
            }
        }
        }
        if (more) {
#pragma unroll
            for (int tt = 0; tt < TPS; ++tt) { LAS unsigned char* sn = lds + (((s + 1) & 1) * TPS + tt) * AT_STAGE; *(LAS v4u*)(sn + kdst) = kr[tt]; *(LAS v4u*)(sn + vdst) = vr[tt]; mw[tt] = mwn[tt]; } }
        lds_barrier();
    }
    __builtin_amdgcn_s_setprio(0);
    bf16* yp = A.Y + (rowb + tq) * 768 + h * 64 + 4 * hi;
    if (MODE == 0) {
        const float inv = 1.0f / (FAST ? negm[0][0] : swapsum(lsum[0]));
#pragma unroll
        for (int dh = 0; dh < 2; ++dh)
#pragma unroll
            for (int g4 = 0; g4 < 4; ++g4) { const f32x16& o = O[0][dh];
                *(u32x2*)(yp + 32 * dh + 8 * g4) = (u32x2){cvtpk(o[4 * g4] * inv, o[4 * g4 + 1] * inv), cvtpk(o[4 * g4 + 2] * inv, o[4 * g4 + 3] * inv)}; }
    } else {
        const float i1 = 1.0f / swapsum(lsum[0]), i2 = A.lam / swapsum(lsum[NC - 1]);
        float ss = 0.f;
#pragma unroll
        for (int dh = 0; dh < 2; ++dh)
#pragma unroll
            for (int r = 0; r < 16; ++r) { const float v = O[0][dh][r] * i1 - O[NC - 1][dh][r] * i2; O[0][dh][r] = v; ss += v * v; }
        ss = swapsum(ss);
        const float rstd = A.oscale / sqrtf(ss * (1.0f / 64.0f) + EPS);
#pragma unroll
        for (int dh = 0; dh < 2; ++dh)
#pragma unroll
            for (int g4 = 0; g4 < 4; ++g4) { const f32x16& o = O[0][dh]; const f32x4 gg = *(const f32x4*)(A.subg + 32 * dh + 8 * g4 + 4 * hi);
                *(u32x2*)(yp + 32 * dh + 8 * g4) = (u32x2){cvtpk(o[4 * g4] * rstd * gg[0], o[4 * g4 + 1] * rstd * gg[1]), cvtpk(o[4 * g4 + 2] * rstd * gg[2], o[4 * g4 + 3] * rstd * gg[3])}; }
    }
}

DI void sgu_unit(const Ctx& C, int b, int chunk, const bf16* projA, const bf16* Ws, const float* lng, const float* lnb, const float* bs, bf16* Yb) {
    LAS unsigned char* lds = C.lds;
    int tid_ = C.wave * 64 + lane_id_now(); asm volatile("" : "+v"(tid_));
    const int tid = tid_, lane = tid & 63, wave = __builtin_amdgcn_readfirstlane(tid >> 6), hi = lane >> 5, l31 = lane & 31;
    const size_t R0 = (size_t)b * SEQ + 128 * chunk;
    const int gw = wave >> 1, chh = wave & 1;
    bf16x8 bb[4][8]; u32x2 uw[4][4]; float bias[4];
#pragma unroll
    for (int i = 0; i < 4; ++i) { const int t = 32 * i + l31;
        const bf16* up = projA + (R0 + t) * 2048 + CB_U + 64 * gw + 32 * chh + 4 * hi;
#pragma unroll
        for (int g4 = 0; g4 < 4; ++g4) uw[i][g4] = *(const u32x2*)(up + 8 * g4);
        bias[i] = bs[gw * 128 + t]; }
    {
        const int pos = tid >> 2, g = tid & 3;
        const bf16* vp = projA + (R0 + pos) * 2048 + CB_V + 64 * g;
        float x[64]; float s = 0.f;
#pragma unroll
        for (int j = 0; j < 8; ++j) { const v4u w = *(const GAS v4u*)(vp + 8 * j);
            x[8 * j + 0] = gelu_tanh(blo(w.x)); x[8 * j + 1] = gelu_tanh(bhi(w.x)); x[8 * j + 2] = gelu_tanh(blo(w.y)); x[8 * j + 3] = gelu_tanh(bhi(w.y));
            x[8 * j + 4] = gelu_tanh(blo(w.z)); x[8 * j + 5] = gelu_tanh(bhi(w.z)); x[8 * j + 6] = gelu_tanh(blo(w.w)); x[8 * j + 7] = gelu_tanh(bhi(w.w)); }
#pragma unroll
        for (int i = 0; i < 64; ++i) s += x[i];
        s = quad_sum(s);
        const float mu = s * (1.0f / 256.0f); float q = 0.f;
#pragma unroll
        for (int i = 0; i < 64; ++i) { const float d = x[i] - mu; q += d * d; }
        q = quad_sum(q);
        const float rstd = 1.0f / sqrtf(q * (1.0f / 256.0f) + EPS);
        LAS bf16* dst = (LAS bf16*)lds;
        const int kb = pos >> 3;
#pragma unroll
        for (int i = 0; i < 64; ++i) { const float y = (x[i] - mu) * rstd * lng[64 * g + i] + lnb[64 * g + i];
            dst[(((g * 2 + (i >> 5)) * 16 + kb) * 32 + ((i & 31) ^ (kb & 7))) * 8 + (pos & 7)] = (bf16)(cvtpk(y, 0.f) & 0xffffu); }
    }
#pragma unroll
    for (int i = 0; i < 4; ++i) { const bf16* wp = Ws + ((size_t)gw * 128 + 32 * i + l31) * 128 + 8 * hi;
#pragma unroll
        for (int kk = 0; kk < 2 * i + 2; ++kk) bb[i][kk] = *(const bf16x8*)(wp + 16 * kk); }
    lds_barrier();
#pragma unroll
    for (int i = 0; i < 4; ++i) {
        const int t = 32 * i + l31;
        f32x16 acc = {};
#pragma unroll
        for (int kk = 0; kk < 2 * i + 2; ++kk) { const int kblk = 2 * kk + hi;
            const bf16x8 a = *(const LAS bf16x8*)(lds + (size_t)((((gw * 2 + chh) * 16 + kblk) * 32 + (l31 ^ (kblk & 7))) * 16));
            acc = MFMA32(a, bb[i][kk], acc); }
        bf16* yp = Yb + (R0 + t) * 768 + 64 * gw + 32 * chh + 4 * hi;
#pragma unroll
        for (int g4 = 0; g4 < 4; ++g4) {
            const float u0 = gelu_tanh(blo(uw[i][g4].x)), u1 = gelu_tanh(bhi(uw[i][g4].x)), u2 = gelu_tanh(blo(uw[i][g4].y)), u3 = gelu_tanh(bhi(uw[i][g4].y));
            *(u32x2*)(yp + 8 * g4) = (u32x2){cvtpk(u0 * (acc[4 * g4] + bias[i]), u1 * (acc[4 * g4 + 1] + bias[i])), cvtpk(u2 * (acc[4 * g4 + 2] + bias[i]), u3 * (acc[4 * g4 + 3] + bias[i]))}; }
    }
    lds_barrier();
}

struct Args { const float* in[19]; float* out; unsigned char* ws; };
__global__ void __launch_bounds__(NTHREADS, 2) mk_fwd(Args args) {
    extern __shared__ __attribute__((aligned(16))) unsigned char lds_raw[];
    if (gridDim.x != 256u) return;
    { const unsigned bx_ = blockIdx.x; __builtin_assume(bx_ < 256u); }
    Ctx C;
    C.lds = (LAS unsigned char*)lds_raw;
    C.tid = threadIdx.x; C.lane = C.tid & 63; C.wave = __builtin_amdgcn_readfirstlane(C.tid >> 6);
    C.G = gridDim.x; { const int bx = blockIdx.x; C.vcu = (C.G % 8 == 0) ? (bx % 8) * (C.G / 8) + bx / 8 : bx; }
    C.out = nullptr; C.ws = nullptr;
    typedef const __attribute__((address_space(4))) Args* KArgs;
#define KGET() KArgs K = (KArgs)__builtin_amdgcn_kernarg_segment_ptr(); asm volatile("" : "+s"(K))
#define IN(k) ((const float*)(const GAS float*)(K->in[k]))
#define OUTP ((float*)(GAS float*)(K->out))
    volatile LAS unsigned* MISC = (volatile LAS unsigned*)(C.lds + MISC_OFF);
    if (C.tid < 64) MISC[C.tid] = 0u;
    __syncthreads();
    XcdBarrier bar = xcd_barrier_post((unsigned*)(args.ws + WS_CTL) + CW_BAR, MISC + 8);
#define WSP(T, off) ((T*)(GAS T*)(K->ws + (off)))
#define Hb   WSP(bf16, WS_H)
#define PA   WSP(bf16, WS_PA)
#define Gb   WSP(bf16, WS_G)
#define VTb  WSP(bf16, WS_VTA)
#define KIDX WSP(bf16, WS_KIDX)
#define MASK WSP(unsigned long long, WS_MASK)
#define Ya   WSP(bf16, WS_Y)
#define Yb   WSP(bf16, WS_Y + 512)
#define Yc   WSP(bf16, WS_Y + 1024)
#define MA   WSP(bf16, WS_MA)
#define ACT  WSP(bf16, WS_ACT)
#define H8   WSP(unsigned char, WS_H8)
#define XB   WSP(bf16, WS_XB)
#define RS   WSP(float, WS_RS)
#define NRM  (WSP(unsigned, WS_CTL) + CW_NRM + l * 512)
#define RLB  ((LAS float*)(C.lds + CL_OFF))
#define WL(off) ((const bf16*)(const GAS bf16*)(K->ws + WS_WL + (size_t)l * WL_STRIDE + (off)))

    { KGET();
      prologue_weights(C, (unsigned char*)(GAS unsigned char*)K->ws, IN(1), IN(15), IN(2), IN(7), IN(11), IN(12), IN(13), IN(14), IN(16), IN(17));
      prep_rows(C, IN(0), XB, H8, RS); }
    grid_bar(bar);

#pragma unroll 1
    for (int l = 0; l < DEPTH; ++l) {
        { KGET();
          pg8::Gemm g{XB, WL(WO_IN1), MROWS, NPROJ, DM}; pg8::StaticOrder S; S.init(MROWS, NPROJ, C.G, (int)blockIdx.x);
          pg8::EpiProj E{PA, Gb, KIDX, IN(3) + l * 64, IN(4) + l * 64, RS, RLB, NRM};
          pg8::gemm_phase<pg8::EpiProj, pg8::StaticOrder, true, true, 1024>(C.lds, g, S, E, pg8::NoHook(), C.wave); }
        { KGET();
          pg8::Gemm g{(const bf16*)H8, (const bf16*)(const GAS unsigned char*)(K->ws + WS_WG8 + (size_t)l * 3 * MiB), MROWS, 3072, 512}; pg8::StaticOrder S; S.init(MROWS, 3072, C.G, (int)blockIdx.x);
          pg8::EpiGates E{(unsigned char*)Gb, 1.0f / 32.0f, RS, RLB};
          pg8::gemm_phase<pg8::EpiGates, pg8::StaticOrder, true, true, 512, pg8::NoHook, true>(C.lds, g, S, E, pg8::NoHook(), C.wave); }
        { KGET();
          pg8::Gemm g{WL(WO_VT), XB, 512, MROWS, DM}; pg8::StaticOrder S; S.init(512, MROWS, C.G, (int)blockIdx.x);
          pg8::EpiVT E{VTb, MROWS, RS, RLB};
          pg8::gemm_phase<pg8::EpiVT, pg8::StaticOrder, true, true, 1024>(C.lds, g, S, E, pg8::NoHook(), C.wave); }
        grid_bar(bar);
        { KGET(); select_phase(C, C.vcu >> 5, C.vcu & 31, PA, KIDX, MASK); lds_barrier(); }
        { KGET(); sgu_unit(C, C.vcu >> 5, C.vcu & 31, PA, WL(WO_S), IN(5) + l * 256, IN(6) + l * 256, IN(8) + l * 512, Yb); }
        { KGET();
          const float* lq = IN(9) + l * 128;
          const int ln = lane_id_now();
          float d1 = (ln < 32) ? lq[ln] * lq[32 + ln] : 0.f, d2 = (ln < 32) ? lq[64 + ln] * lq[96 + ln] : 0.f;
          d1 = wave_sum(d1); d2 = wave_sum(d2);
          const float lam_init = 0.8f - 0.6f * expf(-0.3f * (float)l);
          const float lam = expf(d1) - expf(d2) + lam_init;
          AttnArgs A{PA, VTb, nullptr, Yc, CC_Q, CC_K, 256, lam, 1.0f - lam_init, IN(10) + l * 64};
          const int bh = C.vcu >> 3, s8 = C.vcu & 7;
          const unsigned* nr = NRM + (bh >> 2) * 64 + 2 * (bh & 3);
          const float b2 = fmaxf(__uint_as_float(nr[48]) * __uint_as_float(nr[56]), __uint_as_float(nr[49]) * __uint_as_float(nr[57])) * 1.03f;
          if (b2 <= 2500.0f) {
#pragma unroll 1
              for (int j = 0; j < 2; ++j) attn_unit<1, 1, true>(C, A, bh >> 2, bh & 3, j ? 15 - s8 : s8);
          } else {
#pragma unroll 1
              for (int j = 0; j < 2; ++j) attn_unit<1, 1, false>(C, A, bh >> 2, bh & 3, j ? 15 - s8 : s8); } }
        grid_bar(bar);
        { KGET();
          AttnArgs A{PA, VTb, MASK, Ya, CA_Q, CA_K, 0, 0.f, 1.f, nullptr};
          const int bh = C.vcu >> 3, s8 = C.vcu & 7;
          const unsigned* nr = NRM + (bh >> 2) * 64 + 2 * (bh & 3);
          const float b2 = (__uint_as_float(nr[0]) + __uint_as_float(nr[1])) * (__uint_as_float(nr[8]) + __uint_as_float(nr[9])) * 1.03f;
          if (b2 <= 2500.0f) {
#pragma unroll 1
              for (int j = 0; j < 2; ++j) attn_unit<0, 1, true>(C, A, bh >> 2, bh & 3, j ? 15 - s8 : s8);
          } else {
#pragma unroll 1
              for (int j = 0; j < 2; ++j) attn_unit<0, 1, false>(C, A, bh >> 2, bh & 3, j ? 15 - s8 : s8); } }
        grid_bar(bar);
        { KGET();
          pg8::Gemm g{Ya, WL(WO_B), MROWS, DM, 768}; pg8::StaticOrder S; S.init(MROWS, DM, C.G, (int)blockIdx.x);
          pg8::EpiGateC E{(const unsigned char*)Gb, MA}; pg8::HookGate H{(const unsigned char*)Gb};
          pg8::gemm_phase<pg8::EpiGateC, pg8::StaticOrder, true, true, 768, pg8::HookGate>(C.lds, g, S, E, H, C.wave); }
        grid_bar(bar);
        { KGET();
          pg8::Gemm g{MA, WL(WO_O), MROWS, DM, DM}; pg8::StaticOrder S; S.init(MROWS, DM, C.G, (int)blockIdx.x);
          pg8::EpiResid E{(l == 0) ? IN(0) : (const float*)nullptr, XB, XB, RS, nullptr};
          pg8::gemm_phase<pg8::EpiResid, pg8::StaticOrder, true, true, 1024>(C.lds, g, S, E, pg8::NoHook(), C.wave); }
        grid_bar(bar);
        { KGET();
          pg8::Gemm g{XB, WL(WO_F1), MROWS, FF, DM}; pg8::StaticOrder S; S.init(MROWS, FF, C.G, (int)blockIdx.x);
          pg8::EpiAct<1> E{ACT, FF, RS, RLB};
          pg8::gemm_phase<pg8::EpiAct<1>, pg8::StaticOrder, true, true, 1024>(C.lds, g, S, E, pg8::NoHook(), C.wave); }
        grid_bar(bar);
        { KGET();
          pg8::Gemm g{ACT, WL(WO_F2), MROWS, DM, FF}; pg8::StaticOrder S; S.init(MROWS, DM, C.G, (int)blockIdx.x);
          pg8::EpiResid E{nullptr, XB, XB, RS, (l + 1 < DEPTH) ? H8 : (unsigned char*)nullptr};
          pg8::gemm_phase<pg8::EpiResid, pg8::StaticOrder, true, true, 4096>(C.lds, g, S, E, pg8::NoHook(), C.wave); }
        grid_bar(bar);
        if (l + 1 == DEPTH) { KGET(); rmsnorm_rows(C, nullptr, IN(18), nullptr, OUTP, nullptr, XB); }
    }
}

extern "C" void kernel_launch(void* const* d_in, const int* in_sizes, int n_in, void* d_out, int out_size, void* d_ws, size_t ws_size, hipStream_t stream) {
    static int grid = 0;
    if (grid == 0) {
        if (n_in != 19 || in_sizes[0] != MROWS * DM || out_size != MROWS * DM || ws_size < WS_END) { fprintf(stderr, "kernel_launch: unexpected shapes / workspace (n_in %d, ws %zu)\n", n_in, ws_size); grid = -1; return; }
        int dev = 0, cus = 0, per_cu = 0;
        if (hipGetDevice(&dev) != hipSuccess || hipDeviceGetAttribute(&cus, hipDeviceAttributeMultiprocessorCount, dev) != hipSuccess) { grid = -1; return; }
        if (hipFuncSetAttribute((const void*)mk_fwd, hipFuncAttributeMaxDynamicSharedMemorySize, LDS_BYTES) != hipSuccess) { fprintf(stderr, "kernel_launch: hipFuncSetAttribute failed\n"); grid = -1; return; }
        if (hipOccupancyMaxActiveBlocksPerMultiprocessor(&per_cu, (const void*)mk_fwd, NTHREADS, LDS_BYTES) != hipSuccess || per_cu < 1) fprintf(stderr, "kernel_launch: occupancy query says %d\n", per_cu);
        (void)hipGetLastError();
        grid = cus;
    }
    if (grid < 0) return;
    if (hipMemsetAsync((char*)d_ws + WS_CTL, 0, CTL_ZERO_BYTES, stream) != hipSuccess) return;
    Args a{};
    for (int i = 0; i < 19; ++i) a.in[i] = (const float*)d_in[i];
    a.out = (float*)d_out; a.ws = (unsigned char*)d_ws;
    hipLaunchKernelGGL(mk_fwd, dim3(grid), dim3(NTHREADS), LDS_BYTES, stream, a);
}
```

```cpp
#include <hip/hip_runtime.h>
#include <hip/hip_bf16.h>
#include <cstdio>
#include <cstdint>
#include <cmath>
__device__ __forceinline__ int lane_id_now() { int l; asm volatile("v_mbcnt_lo_u32_b32 %0, -1, 0\n\tv_mbcnt_hi_u32_b32 %0, -1, %0" : "=v"(l)); return l; }
namespace pg8 {
#define PG8_LAS __attribute__((address_space(3)))
typedef unsigned short bf16_t;
typedef short bf16x8 __attribute__((ext_vector_type(8)));
typedef float f32x4 __attribute__((ext_vector_type(4)));
typedef unsigned u32x4 __attribute__((ext_vector_type(4)));
constexpr int BM = 256, BK = 64, HALF = 128, HTB = HALF * BK * 2  , STAGE_BYTES = 8 * HTB, NXCD = 8, WGM = 8;

__host__ __device__ __forceinline__ int lds_byte(int r, int c) { const int st = (r >> 4) * 2 + (c >> 5), rr = r & 15, cc = c & 31, ob = rr * 64 + cc * 2; return st * 1024 + (ob ^ (((ob >> 9) & 1) << 5)); }
__host__ __device__ __forceinline__ void stage_rc(int b, int& R, int& C) { const int st = b / 1024, sb = b % 1024, swz = sb ^ (((sb >> 9) & 1) << 5); R = (st >> 1) * 16 + swz / 64; C = (st & 1) * 32 + (swz % 64) / 2; }
__host__ __device__ __forceinline__ int perm32(int rho) { const int n = rho >> 4, i = rho & 15; return 8 * (i >> 2) + 4 * n + (i & 3); }

struct Unit { int pm, pn; };
struct Gemm { const bf16_t* A; const bf16_t* Bt; int M, N, K; };

struct StaticOrder {
    int nM, nN, nwg, G, c;
    __host__ __device__ void init(int M, int N, int G_, int c_) { nM = M / BM; nN = N / BM; nwg = nM * nN; G = G_; c = c_; }
    __host__ __device__ bool next(int i, Unit& u) const {
        const long L = (long)i * G + c; if (L >= nwg) return false;
        int wgid = (int)L; { const int q = nwg / NXCD, r = nwg % NXCD, xcd = wgid % NXCD, off = wgid / NXCD; wgid = (xcd < r ? xcd * (q + 1) : r * (q + 1) + (xcd - r) * q) + off; }
        const int nig = WGM * nN, gid = wgid / nig, fm = gid * WGM, gsz = (nM - fm) < WGM ? (nM - fm) : WGM;
        u.pm = fm + ((wgid % nig) % gsz); u.pn = (wgid % nig) / gsz; return true;
    }
    __device__ __forceinline__ void a_ready(const Unit&) const {}
    __device__ __forceinline__ void done(const Unit&) const {}
};

struct RotOrder : StaticOrder {
    __host__ __device__ bool next(int i, Unit& u) const { if (!StaticOrder::next(i, u)) return false; if (i >= 2) u.pn = (u.pn & ~3) | ((u.pn + 1) & 3); return true; }
};

__device__ __forceinline__ unsigned cvt_pk_bf16(float lo, float hi) { unsigned r; asm volatile("v_cvt_pk_bf16_f32 %0, %1, %2" : "=v"(r) : "v"(lo), "v"(hi)); return r; }
typedef float f32x2 __attribute__((ext_vector_type(2)));
__device__ __forceinline__ f32x2 gelu_pk(f32x2 v) {
    const f32x2 av = __builtin_elementwise_abs(v), d = av * 0.2316418882f + 1.0f;
    f32x2 t; t.x = __builtin_amdgcn_rcpf(d.x); t.y = __builtin_amdgcn_rcpf(d.y);
    f32x2 q = t * 0.5307027145f + (-0.7265760135f); q = q * t + 0.7107068705f; q = q * t + (-0.142248368f); q = q * t + 0.127414796f; q = q * t;
    const f32x2 s = (v * v) * (-0.72134752044f);
    f32x2 e; e.x = __builtin_amdgcn_exp2f(s.x); e.y = __builtin_amdgcn_exp2f(s.y);
    const f32x2 m = v * (q * e), r = v - m;
    f32x2 o; o.x = v.x < 0.f ? m.x : r.x; o.y = v.y < 0.f ? m.y : r.y; return o;
}

template <int ACT  > struct EpiBf16 {
    static constexpr bool PERM = true, AFTER_DRAIN = false; static_assert(ACT == 0 || ACT == 1, "EpiBf16: ACT is 0 (none) or 1 (gelu_pk)");
    bf16_t* O; int ldc; const float* bias; int split_cols; size_t split_stride; float scale0;
    __device__ __forceinline__ void operator()(const f32x4 (&acc)[2][2][4][2], const Unit& u, int wr, int wc, int fr, int fq) const {
        const int row0 = u.pm * BM + wr * 64 + fr; int colt = u.pn * BM; bf16_t* base = O;
        float sc = 1.f; if (split_cols) { const int t = colt / split_cols; base += (size_t)t * split_stride; colt -= t * split_cols; if (t == 0) sc = scale0; }
        const int col0 = colt + wc * 32 + 8 * fq, bcol0 = u.pn * BM + wc * 32 + 8 * fq;
        f32x4 bv[2][2];
#pragma unroll
        for (int bj = 0; bj < 2; ++bj)
#pragma unroll
            for (int n = 0; n < 2; ++n) bv[bj][n] = bias ? *(const f32x4*)(bias + bcol0 + bj * HALF + 4 * n) : (f32x4){0.f, 0.f, 0.f, 0.f};
#pragma unroll
        for (int ai = 0; ai < 2; ++ai)
#pragma unroll
            for (int m = 0; m < 4; ++m) { bf16_t* rowp = base + (size_t)(row0 + ai * HALF + m * 16) * ldc + col0;
#pragma unroll
                for (int bj = 0; bj < 2; ++bj) { f32x4 v0 = acc[ai][bj][m][0] + bv[bj][0], v1 = acc[ai][bj][m][1] + bv[bj][1];
                    if (ACT == 1) { f32x2 a = gelu_pk((f32x2){v0[0], v0[1]}), b = gelu_pk((f32x2){v0[2], v0[3]}), c = gelu_pk((f32x2){v1[0], v1[1]}), d = gelu_pk((f32x2){v1[2], v1[3]});
                        v0 = (f32x4){a.x, a.y, b.x, b.y}; v1 = (f32x4){c.x, c.y, d.x, d.y}; }
                    v0 = v0 * sc; v1 = v1 * sc; u32x4 w; w.x = cvt_pk_bf16(v0[0], v0[1]); w.y = cvt_pk_bf16(v0[2], v0[3]); w.z = cvt_pk_bf16(v1[0], v1[1]); w.w = cvt_pk_bf16(v1[2], v1[3]);
                    *(u32x4*)(rowp + bj * HALF) = w; } }
    }
};
typedef float f32x2c __attribute__((ext_vector_type(2))); typedef __bf16 bf16x2c __attribute__((ext_vector_type(2)));
__device__ __forceinline__ unsigned cvtc(float lo, float hi) { f32x2c v = {lo, hi}; bf16x2c b = __builtin_convertvector(v, bf16x2c); return __builtin_bit_cast(unsigned, b); }
__device__ __forceinline__ float bflo(unsigned w) { return __uint_as_float(w << 16); }
__device__ __forceinline__ float bfhi(unsigned w) { return __uint_as_float(w & 0xffff0000u); }
__device__ __forceinline__ float xsum16_32(float s) {
    s += __int_as_float(__builtin_amdgcn_ds_swizzle(__float_as_int(s), 0x401F));
    auto rr = __builtin_amdgcn_permlane32_swap(__float_as_uint(s), __float_as_uint(s), false, false); return __uint_as_float(rr[0]) + __uint_as_float(rr[1]); }
__device__ __forceinline__ float rstd_row(const float* rs, int row) {
    const f32x4 a = *(const f32x4*)(rs + (size_t)row * 16), b = *(const f32x4*)(rs + (size_t)row * 16 + 4), c = *(const f32x4*)(rs + (size_t)row * 16 + 8), d = *(const f32x4*)(rs + (size_t)row * 16 + 12);
    const float s = (((a[0] + a[1]) + (a[2] + a[3])) + ((b[0] + b[1]) + (b[2] + b[3]))) + (((c[0] + c[1]) + (c[2] + c[3])) + ((d[0] + d[1]) + (d[2] + d[3])));
    return 1.0f / sqrtf(s * (1.0f / 1024.0f) + 1e-6f);
}
__device__ __forceinline__ void rstd_table_rows(PG8_LAS float* rl, const float* rs, int rowbase, int lane) {
    const float* p0 = rs + (size_t)(rowbase + lane) * 16; const float* p1 = rs + (size_t)(rowbase + HALF + lane) * 16;
    const f32x4 a0 = *(const f32x4*)(p0), b0 = *(const f32x4*)(p0 + 4), c0 = *(const f32x4*)(p0 + 8), d0 = *(const f32x4*)(p0 + 12);
    const f32x4 a1 = *(const f32x4*)(p1), b1 = *(const f32x4*)(p1 + 4), c1 = *(const f32x4*)(p1 + 8), d1 = *(const f32x4*)(p1 + 12);
    const float s0 = (((a0[0] + a0[1]) + (a0[2] + a0[3])) + ((b0[0] + b0[1]) + (b0[2] + b0[3]))) + (((c0[0] + c0[1]) + (c0[2] + c0[3])) + ((d0[0] + d0[1]) + (d0[2] + d0[3])));
    const float s1 = (((a1[0] + a1[1]) + (a1[2] + a1[3])) + ((b1[0] + b1[1]) + (b1[2] + b1[3]))) + (((c1[0] + c1[1]) + (c1[2] + c1[3])) + ((d1[0] + d1[1]) + (d1[2] + d1[3])));
    rl[lane] = 1.0f / sqrtf(s0 * (1.0f / 1024.0f) + 1e-6f); rl[64 + lane] = 1.0f / sqrtf(s1 * (1.0f / 1024.0f) + 1e-6f);
}
__device__ __forceinline__ float sigmoidf_fast(float v) { return __builtin_amdgcn_rcpf(1.0f + __builtin_amdgcn_exp2f(-1.4426950408889634f * v)); }

struct EpiProj {
    static constexpr int EPI_VM = 16;
    static constexpr bool PERM = true, AFTER_DRAIN = false;
    bf16_t* P; bf16_t* G; bf16_t* kidx; const float* kg; const float* kb; const float* rs; PG8_LAS float* rlb; unsigned* nrm; mutable int tab_pm = -1;
    __device__ __forceinline__ void operator()(const f32x4 (&acc)[2][2][4][2], const Unit& u, int wr, int wc, int fr_, int fq_) const {
        int fr = fr_, fq = fq_; asm volatile("" : "+v"(fr), "+v"(fq));
        const int row0 = u.pm * BM + wr * 64 + fr;
        PG8_LAS float* rl = rlb + (wr * 4 + wc) * 128; if (u.pm != tab_pm) { rstd_table_rows(rl, rs, u.pm * BM + wr * 64, fr + 16 * fq); tab_pm = u.pm; }
        {
            const int col0 = u.pn * BM + wc * 32 + 8 * fq;
            const bool want = (u.pn < 2) || (u.pn >= 6);
            float mxg[2] = {0.f, 0.f};
#pragma unroll
            for (int ai = 0; ai < 2; ++ai)
#pragma unroll
                for (int m = 0; m < 4; ++m) { bf16_t* rowp = P + (size_t)(u.pm >> 4) * 8388608 + (size_t)(row0 + ai * HALF + m * 16) * 2048 + col0; const float rsd = rl[64 * ai + 16 * m + fr];
#pragma unroll
                    for (int bj = 0; bj < 2; ++bj) { const f32x4 v0 = acc[ai][bj][m][0] * rsd, v1 = acc[ai][bj][m][1] * rsd;
                        u32x4 w; w.x = cvtc(v0[0], v0[1]); w.y = cvtc(v0[2], v0[3]); w.z = cvtc(v1[0], v1[1]); w.w = cvtc(v1[2], v1[3]);
                        *(u32x4*)(rowp + bj * HALF) = w;
                        if (want) { float q = ((v0[0] * v0[0] + v0[1] * v0[1]) + (v0[2] * v0[2] + v0[3] * v0[3])) + ((v1[0] * v1[0] + v1[1] * v1[1]) + (v1[2] * v1[2] + v1[3] * v1[3]));
                            q = xsum16_32(q); mxg[bj] = fmaxf(mxg[bj], q); } } }
            if (want) {
#pragma unroll
                for (int bj = 0; bj < 2; ++bj) { float v = mxg[bj];
                    v = fmaxf(v, __int_as_float(__builtin_amdgcn_ds_swizzle(__float_as_int(v), 0x041F))); v = fmaxf(v, __int_as_float(__builtin_amdgcn_ds_swizzle(__float_as_int(v), 0x081F)));
                    v = fmaxf(v, __int_as_float(__builtin_amdgcn_ds_swizzle(__float_as_int(v), 0x101F))); v = fmaxf(v, __int_as_float(__builtin_amdgcn_ds_swizzle(__float_as_int(v), 0x201F)));
                    if ((fr | fq) == 0) atomicMax(nrm + (u.pm >> 4) * 64 + u.pn * 8 + bj * 4 + wc, __float_as_uint(v)); } }
            if (u.pn == 3 && wc == 0) {
                f32x4 gq[2][2], bq[2][2];
#pragma unroll
                for (int bj = 0; bj < 2; ++bj) { gq[bj][0] = *(const f32x4*)(kg + bj * 32 + 8 * fq); gq[bj][1] = *(const f32x4*)(kg + bj * 32 + 8 * fq + 4); bq[bj][0] = *(const f32x4*)(kb + bj * 32 + 8 * fq); bq[bj][1] = *(const f32x4*)(kb + bj * 32 + 8 * fq + 4); }
#pragma unroll
                for (int ai = 0; ai < 2; ++ai)
#pragma unroll
                    for (int m = 0; m < 4; ++m) {
                        const float rsd = rl[64 * ai + 16 * m + fr];
                        f32x4 xs[2][2];
#pragma unroll
                        for (int bj = 0; bj < 2; ++bj)
#pragma unroll
                            for (int n = 0; n < 2; ++n) xs[bj][n] = acc[ai][bj][m][n] * rsd;
                        float s = 0.f, q = 0.f;
#pragma unroll
                        for (int bj = 0; bj < 2; ++bj)
#pragma unroll
                            for (int n = 0; n < 2; ++n) { const f32x4 x = xs[bj][n]; s += (x[0] + x[1]) + (x[2] + x[3]); q += (x[0] * x[0] + x[1] * x[1]) + (x[2] * x[2] + x[3] * x[3]); }
                        s = xsum16_32(s); q = xsum16_32(q);
                        const float mu = s * (1.0f / 64.0f);
                        const float rstd = __builtin_amdgcn_rsqf(fmaxf(q * (1.0f / 64.0f) - mu * mu, 0.f) + 1e-6f);
                        const int R = row0 + ai * HALF + m * 16;
                        bf16_t* kp = kidx + ((size_t)((R >> 5) * 8 + fq) * 32 + (R & 31)) * 8;
#pragma unroll
                        for (int bj = 0; bj < 2; ++bj) { const f32x4 g0 = gq[bj][0], g1 = gq[bj][1], b0 = bq[bj][0], b1 = bq[bj][1];
                            const f32x4 y0 = (xs[bj][0] - mu) * rstd * g0 + b0, y1 = (xs[bj][1] - mu) * rstd * g1 + b1;
                            u32x4 w; w.x = cvtc(y0[0], y0[1]); w.y = cvtc(y0[2], y0[3]); w.z = cvtc(y1[0], y1[1]); w.w = cvtc(y1[2], y1[3]);
                            *(u32x4*)(kp + bj * 4 * 32 * 8) = w; }
                        asm volatile("" ::: "memory");
                    }
            }
        }
    }
};
__device__ __forceinline__ float ub(unsigned w, int i) { return (float)((w >> (8 * i)) & 0xffu); }
__device__ __forceinline__ size_t gate_tile_off(int g, int pm, int pn, int wr, int wc, int fr, int fq) { return (size_t)(pm >> 4) * 33554432 + 16777216 + ((size_t)((g * 16 + (pm & 15)) * 4 + pn)) * 65536 + (size_t)((wr * 4 + wc) * 8192 + (fq * 16 + fr) * 16); }
struct EpiGates {
    static constexpr int EPI_VM = 8;
    static constexpr bool PERM = true, AFTER_DRAIN = false;
    unsigned char* G8; float scale; const float* rs; PG8_LAS float* rlb; mutable int tab_pm = -1;
    __device__ __forceinline__ void operator()(const f32x4 (&acc)[2][2][4][2], const Unit& u, int wr, int wc, int fr_, int fq_) const {
        int fr = fr_, fq = fq_; asm volatile("" : "+v"(fr), "+v"(fq));
        PG8_LAS float* rl = rlb + (wr * 4 + wc) * 128; if (u.pm != tab_pm) { rstd_table_rows(rl, rs, u.pm * BM + wr * 64, fr + 16 * fq); tab_pm = u.pm; }
        unsigned char* tp = G8 + gate_tile_off(u.pn >> 2, u.pm, u.pn & 3, wr, wc, fr, fq);
#pragma unroll
        for (int ai = 0; ai < 2; ++ai)
#pragma unroll
            for (int m = 0; m < 4; ++m) { const float ns = -1.4426950408889634f * scale * rl[64 * ai + 16 * m + fr];
                u32x4 w;
#pragma unroll
                for (int bj = 0; bj < 2; ++bj) { const f32x4 v0 = acc[ai][bj][m][0], v1 = acc[ai][bj][m][1];
                    unsigned lo = 0u, hi = 0u;
#pragma unroll
                    for (int e2 = 0; e2 < 4; ++e2) {
                        const float ga = fmaxf(__builtin_amdgcn_rcpf(fmaf(__builtin_amdgcn_exp2f(ns * v0[e2]), 1.0f / 255.0f, 1.0f / 255.0f)), 1.0f), gb = fmaxf(__builtin_amdgcn_rcpf(fmaf(__builtin_amdgcn_exp2f(ns * v1[e2]), 1.0f / 255.0f, 1.0f / 255.0f)), 1.0f);
                        lo = __builtin_amdgcn_cvt_pk_u8_f32(ga, e2, lo); hi = __builtin_amdgcn_cvt_pk_u8_f32(gb, e2, hi); }
                    if (bj == 0) { w.x = lo; w.y = hi; } else { w.z = lo; w.w = hi; } }
                *(u32x4*)(tp + (ai * 4 + m) * 1024) = w; }
    }
};
template <int ACT> struct EpiAct {
    static constexpr int EPI_VM = 16;
    static constexpr bool PERM = true, AFTER_DRAIN = false;
    bf16_t* O; int ldc; const float* rs; PG8_LAS float* rlb; mutable int tab_pm = -1;
    __device__ __forceinline__ void operator()(const f32x4 (&acc)[2][2][4][2], const Unit& u, int wr, int wc, int fr_, int fq_) const {
        int fr = fr_, fq = fq_; asm volatile("" : "+v"(fr), "+v"(fq));
        const int row0 = u.pm * BM + wr * 64 + fr; const int col0 = u.pn * BM + wc * 32 + 8 * fq;
        PG8_LAS float* rl = rlb + (wr * 4 + wc) * 128; if (u.pm != tab_pm) { rstd_table_rows(rl, rs, u.pm * BM + wr * 64, fr + 16 * fq); tab_pm = u.pm; }
#pragma unroll
        for (int ai = 0; ai < 2; ++ai)
#pragma unroll
            for (int m = 0; m < 4; ++m) { bf16_t* rowp = O + (size_t)(row0 + ai * HALF + m * 16) * ldc + col0; const float rsd = rl[64 * ai + 16 * m + fr];
#pragma unroll
                for (int bj = 0; bj < 2; ++bj) { f32x4 v0 = acc[ai][bj][m][0] * rsd, v1 = acc[ai][bj][m][1] * rsd;
                    if (ACT == 1) {
#pragma unroll
                        for (int e = 0; e < 4; ++e) { const int ia = __float_as_int(v0[e]), ib = __float_as_int(v1[e]); const float a = __int_as_float(ia > 0 ? ia : 0), b = __int_as_float(ib > 0 ? ib : 0); v0[e] = a * a; v1[e] = b * b; } }
                    u32x4 w; w.x = cvtc(v0[0], v0[1]); w.y = cvtc(v0[2], v0[3]); w.z = cvtc(v1[0], v1[1]); w.w = cvtc(v1[2], v1[3]);
                    *(u32x4*)(rowp + bj * HALF) = w; } }
    }
};
struct EpiVT {
    static constexpr int EPI_VM = 16;
    static constexpr bool PERM = true, AFTER_DRAIN = false;
    bf16_t* O; int ldc; const float* rs; PG8_LAS float* rlb;
    __device__ __forceinline__ void operator()(const f32x4 (&acc)[2][2][4][2], const Unit& u, int wr, int wc, int fr_, int fq_) const {
        int fr = fr_, fq = fq_; asm volatile("" : "+v"(fr), "+v"(fq));
        const int row0 = u.pm * BM + wr * 64 + fr; const int col0 = u.pn * BM + wc * 32 + 8 * fq;
        PG8_LAS float* rl = rlb + (wr * 4 + wc) * 128; { const int L = fr + 16 * fq; rl[L] = rstd_row(rs, u.pn * BM + wc * 32 + (L & 31) + (L >> 5) * HALF); }
#pragma unroll
        for (int bj = 0; bj < 2; ++bj) { float rc[8];
#pragma unroll
            for (int e2 = 0; e2 < 8; ++e2) rc[e2] = rl[bj * 32 + 8 * fq + e2];
#pragma unroll
            for (int ai = 0; ai < 2; ++ai)
#pragma unroll
                for (int m = 0; m < 4; ++m) { bf16_t* rowp = O + (size_t)(row0 + ai * HALF + m * 16) * ldc + col0; const f32x4 v0 = acc[ai][bj][m][0], v1 = acc[ai][bj][m][1];
                    u32x4 w; w.x = cvtc(v0[0] * rc[0], v0[1] * rc[1]); w.y = cvtc(v0[2] * rc[2], v0[3] * rc[3]); w.z = cvtc(v1[0] * rc[4], v1[1] * rc[5]); w.w = cvtc(v1[2] * rc[6], v1[3] * rc[7]);
                    *(u32x4*)(rowp + bj * HALF) = w; } }
    }
};
struct HookGate {
    static constexpr bool ACTIVE = true;
    const unsigned char* G8;
    __device__ __forceinline__ void mid(f32x4 (&acc)[2][2][4][2], const Unit& u, int kt, int wr, int wc, int fr_, int fq_) const {
        if (kt != 4 && kt != 8) return;
        int fr = fr_, fq = fq_; asm volatile("" : "+v"(fr), "+v"(fq));
        const int g0 = kt == 4 ? 0 : 1;
        const unsigned char* np = G8 + gate_tile_off(g0, u.pm, u.pn, wr, wc, fr, fq); const unsigned char* dp = G8 + gate_tile_off(g0 + 1, u.pm, u.pn, wr, wc, fr, fq);
#pragma unroll
        for (int ai = 0; ai < 2; ++ai)
#pragma unroll
            for (int m = 0; m < 4; ++m) { const u32x4 gn = *(const u32x4*)(np + (ai * 4 + m) * 1024), gd = *(const u32x4*)(dp + (ai * 4 + m) * 1024);
                f32x4 r0, r1, r2, r3;
#pragma unroll
                for (int e2 = 0; e2 < 4; ++e2) { r0[e2] = ub(gn.x, e2) * __builtin_amdgcn_rcpf(ub(gd.x, e2)); r1[e2] = ub(gn.y, e2) * __builtin_amdgcn_rcpf(ub(gd.y, e2));
                    r2[e2] = ub(gn.z, e2) * __builtin_amdgcn_rcpf(ub(gd.z, e2)); r3[e2] = ub(gn.w, e2) * __builtin_amdgcn_rcpf(ub(gd.w, e2)); }
                acc[ai][0][m][0] *= r0; acc[ai][0][m][1] *= r1; acc[ai][1][m][0] *= r2; acc[ai][1][m][1] *= r3;
                if (m == 3) asm volatile("" ::: "memory"); }
    }
};
struct EpiGateC {
    static constexpr int EPI_VM = 16;
    static constexpr bool PERM = true, AFTER_DRAIN = false;
    const unsigned char* G8; bf16_t* Mo;
    __device__ __forceinline__ void operator()(const f32x4 (&acc)[2][2][4][2], const Unit& u, int wr, int wc, int fr_, int fq_) const {
        int fr = fr_, fq = fq_; asm volatile("" : "+v"(fr), "+v"(fq));
        const int row0 = u.pm * BM + wr * 64 + fr; const int col0 = u.pn * BM + wc * 32 + 8 * fq;
        const unsigned char* gp = G8 + gate_tile_off(2, u.pm, u.pn, wr, wc, fr, fq); const float s255 = 1.0f / 255.0f;
        u32x4 gall[8];
#pragma unroll
        for (int i = 0; i < 8; ++i) gall[i] = *(const u32x4*)(gp + i * 1024);
#pragma unroll
        for (int ai = 0; ai < 2; ++ai)
#pragma unroll
            for (int m = 0; m < 4; ++m) { const size_t r = (size_t)(row0 + ai * HALF + m * 16); const u32x4 g = gall[ai * 4 + m];
#pragma unroll
                for (int bj = 0; bj < 2; ++bj) { const f32x4 v0 = acc[ai][bj][m][0], v1 = acc[ai][bj][m][1]; const unsigned glo = bj ? g.z : g.x, ghi = bj ? g.w : g.y;
                    u32x4 w; w.x = cvtc(ub(glo, 0) * s255 * v0[0], ub(glo, 1) * s255 * v0[1]); w.y = cvtc(ub(glo, 2) * s255 * v0[2], ub(glo, 3) * s255 * v0[3]); w.z = cvtc(ub(ghi, 0) * s255 * v1[0], ub(ghi, 1) * s255 * v1[1]); w.w = cvtc(ub(ghi, 2) * s255 * v1[2], ub(ghi, 3) * s255 * v1[3]);
                    *(u32x4*)(Mo + r * 1024 + col0 + bj * HALF) = w; }
                asm volatile("" ::: "memory"); }
    }
};
struct EpiResid {
    static constexpr int EPI_VM = 16;
    static constexpr bool PERM = true, AFTER_DRAIN = false;
    const float* base32; const bf16_t* base16; bf16_t* out16; float* rs; unsigned char* out8;
    __device__ __forceinline__ void operator()(const f32x4 (&acc)[2][2][4][2], const Unit& u, int wr, int wc, int fr_, int fq_) const {
        int fr = fr_, fq = fq_; asm volatile("" : "+v"(fr), "+v"(fq));
        const int col0 = u.pn * BM + wc * 32 + 8 * fq;
        typedef unsigned u32x2g __attribute__((ext_vector_type(2)));
#pragma unroll
        for (int ai = 0; ai < 2; ++ai)
#pragma unroll
            for (int m = 0; m < 4; ++m) { const int row = u.pm * BM + ai * HALF + wr * 64 + m * 16 + fr; const size_t off = (size_t)row * 1024 + col0;
                float q = 0.f;
#pragma unroll
                for (int bj = 0; bj < 2; ++bj) { f32x4 b0, b1;
                    if (base32) { b0 = *(const f32x4*)(base32 + off + bj * HALF); b1 = *(const f32x4*)(base32 + off + bj * HALF + 4); }
                    else { const u32x4 p = *(const u32x4*)(base16 + off + bj * HALF); b0 = (f32x4){bflo(p.x), bfhi(p.x), bflo(p.y), bfhi(p.y)}; b1 = (f32x4){bflo(p.z), bfhi(p.z), bflo(p.w), bfhi(p.w)}; }
                    const f32x4 o0 = b0 + acc[ai][bj][m][0], o1 = b1 + acc[ai][bj][m][1];
                    u32x4 w; w.x = cvtc(o0[0], o0[1]); w.y = cvtc(o0[2], o0[3]); w.z = cvtc(o1[0], o1[1]); w.w = cvtc(o1[2], o1[3]);
                    *(u32x4*)(out16 + off + bj * HALF) = w;
                    if (out8) { int lo = __builtin_amdgcn_cvt_pk_fp8_f32(o0[0], o0[1], 0, false); lo = __builtin_amdgcn_cvt_pk_fp8_f32(o0[2], o0[3], lo, true);
                        int hi = __builtin_amdgcn_cvt_pk_fp8_f32(o1[0], o1[1], 0, false); hi = __builtin_amdgcn_cvt_pk_fp8_f32(o1[2], o1[3], hi, true);
                        *(u32x2g*)(out8 + off + bj * HALF) = (u32x2g){(unsigned)lo, (unsigned)hi}; }
                    q += ((o0[0] * o0[0] + o0[1] * o0[1]) + (o0[2] * o0[2] + o0[3] * o0[3])) + ((o1[0] * o1[0] + o1[1] * o1[1]) + (o1[2] * o1[2] + o1[3] * o1[3])); }
                q = xsum16_32(q);
                if (fq == 0) rs[(size_t)row * 16 + u.pn * 4 + wc] = q;
                if (m == 3) asm volatile("" ::: "memory"); }
    }
};
template <bool C, class A, class B> struct Cond_ { typedef A T; };
template <class A, class B> struct Cond_<false, A, B> { typedef B T; };
struct NoHook { static constexpr bool ACTIVE = false; __device__ __forceinline__ void mid(f32x4 (&)[2][2][4][2], const Unit&, int, int, int, int, int) const {} };
template <class Epi, class Sched, bool ALIGN_EPI = false, bool SP2 = false, int KC = 0, class Hook = NoHook, bool FP8 = false>
__device__ __forceinline__ void gemm_phase(PG8_LAS unsigned char* lds, const Gemm g, const Sched& S, const Epi& E, const Hook& H = Hook(), int wave_in = -1) {
    int tid_ = wave_in >= 0 ? wave_in * 64 + lane_id_now() : (int)threadIdx.x; asm volatile("" : "+v"(tid_));
    const int tid = tid_, wid = __builtin_amdgcn_readfirstlane(tid >> 6), lane = tid & 63, wr = wid >> 2, wc = wid & 3, fr = lane & 15, fq = lane >> 4;
    const int K = KC ? KC : g.K, nt = K / BK;
    unsigned voffA[2], voffB[2];
#pragma unroll
    for (int i = 0; i < 2; ++i) { int R, C; stage_rc(tid * 16 + i * 8192, R, C); const int Rb = Epi::PERM ? ((R & ~31) + perm32(R & 31)) : R;
        voffA[i] = (unsigned)(R * K + C) * 2u; voffB[i] = (unsigned)(Rb * K + C) * 2u; }
    const size_t kstep = (size_t)(BK * 2);
    const size_t hstep = (size_t)HALF * K * 2;
    const size_t tstep = 2 * hstep;
    const unsigned ldsw = (unsigned)wid * 1024u;
    const int aoff = lds_byte(wr * 64 + fr, fq * 8), boff = lds_byte(wc * 32 + fr, fq * 8);
#define PG8_SA(b, h) (((b) * 2 + (h)) * HTB)
#define PG8_SB(b, h) ((4 + (b) * 2 + (h)) * HTB)
#define PG8_STAGE(bufoff, gbase, voff) do { _Pragma("unroll") for (int _i = 0; _i < 2; ++_i) \
        __builtin_amdgcn_global_load_lds((const unsigned*)((const char*)(gbase) + (voff)[_i]), (PG8_LAS unsigned*)(lds + (bufoff) + ldsw + _i * 8192), 16, 0, 0); } while (0)
#define PG8_RD16(off) (*(const PG8_LAS bf16x8*)(lds + (off)))
#define PG8_CAT8(lo, hi) __builtin_shufflevector(__builtin_bit_cast(v4i_, (lo)), __builtin_bit_cast(v4i_, (hi)), 0, 1, 2, 3, 4, 5, 6, 7)
#define PG8_LDA(dst, b, h) do { _Pragma("unroll") for (int m = 0; m < 4; ++m) { if constexpr (FP8) dst[m][0] = PG8_CAT8(PG8_RD16(PG8_SA(b, h) + aoff + m * 2048), PG8_RD16(PG8_SA(b, h) + aoff + m * 2048 + 1024)); \
        else { _Pragma("unroll") for (int k = 0; k < 2; ++k) dst[m][k] = PG8_RD16(PG8_SA(b, h) + aoff + m * 2048 + k * 1024); } } } while (0)
#define PG8_LDB(dst, b, h) do { _Pragma("unroll") for (int n = 0; n < 2; ++n) { if constexpr (FP8) dst[n][0] = PG8_CAT8(PG8_RD16(PG8_SB(b, h) + boff + n * 2048), PG8_RD16(PG8_SB(b, h) + boff + n * 2048 + 1024)); \
        else { _Pragma("unroll") for (int k = 0; k < 2; ++k) dst[n][k] = PG8_RD16(PG8_SB(b, h) + boff + n * 2048 + k * 1024); } } } while (0)
#define PG8_MMA(ai, bj, At, Bt) do { __builtin_amdgcn_s_setprio(1); \
        if constexpr (FP8) { _Pragma("unroll") for (int m = 0; m < 4; ++m) _Pragma("unroll") for (int n = 0; n < 2; ++n) \
            asm volatile("v_mfma_f32_16x16x128_f8f6f4 %0, %1, %2, %0" : "+v"(acc[ai][bj][m][n]) : "v"(Bt[n][0]), "v"(At[m][0])); } \
        else { _Pragma("unroll") for (int m = 0; m < 4; ++m) _Pragma("unroll") for (int n = 0; n < 2; ++n) _Pragma("unroll") for (int k = 0; k < 2; ++k) \
            acc[ai][bj][m][n] = __builtin_amdgcn_mfma_f32_16x16x32_bf16(Bt[n][k], At[m][k], acc[ai][bj][m][n], 0, 0, 0); } \
        __builtin_amdgcn_s_setprio(0); } while (0)
#define PG8_WAIT_V(n) asm volatile("s_waitcnt vmcnt(" #n ")" ::: "memory")
#define PG8_WAIT_VN(n) asm volatile("s_waitcnt vmcnt(%0)" :: "n"(n) : "memory")
#define PG8_WAIT_L(n) asm volatile("s_waitcnt lgkmcnt(" #n ")" ::: "memory")
#define PG8_BAR __builtin_amdgcn_s_barrier()
#define PG8_SCHED __builtin_amdgcn_sched_barrier(0)
    Unit cur, nxt; int ui = 0;
    if (!S.next(0, cur)) return;
    f32x4 acc[2][2][4][2];
#pragma unroll
    for (int a = 0; a < 2; ++a)
#pragma unroll
        for (int b = 0; b < 2; ++b)
#pragma unroll
            for (int m = 0; m < 4; ++m)
#pragma unroll
                for (int n = 0; n < 2; ++n) acc[a][b][m][n] = (f32x4){0.f, 0.f, 0.f, 0.f};
    typedef int v4i_ __attribute__((ext_vector_type(4))); typedef int v8i_ __attribute__((ext_vector_type(8)));
    struct FragSel { typedef v8i_ T8; typedef bf16x8 T16; };
    typedef typename Cond_<FP8, v8i_, bf16x8>::T Frag_;
    Frag_ At[4][FP8 ? 1 : 2], B0[2][FP8 ? 1 : 2], B1[2][FP8 ? 1 : 2];
    const char* cA = (const char*)g.A + (size_t)cur.pm * tstep; const char* cB = (const char*)g.Bt + (size_t)cur.pn * tstep;
    S.a_ready(cur);
    if constexpr (SP2) {
        PG8_STAGE(PG8_SB(0, 0), cB, voffB); PG8_STAGE(PG8_SB(0, 1), cB + hstep, voffB); PG8_STAGE(PG8_SA(0, 0), cA, voffA); PG8_STAGE(PG8_SA(0, 1), cA + hstep, voffA);
        if (wr == 1) PG8_BAR;
        PG8_WAIT_V(2); PG8_BAR;
        PG8_STAGE(PG8_SB(1, 0), cB + kstep, voffB); PG8_STAGE(PG8_SA(1, 0), cA + kstep, voffA); PG8_STAGE(PG8_SB(1, 1), cB + hstep + kstep, voffB);
        PG8_WAIT_V(6); PG8_BAR;
    } else {
        PG8_STAGE(PG8_SB(0, 0), cB, voffB); PG8_STAGE(PG8_SA(0, 0), cA, voffA); PG8_STAGE(PG8_SB(0, 1), cB + hstep, voffB); PG8_STAGE(PG8_SA(0, 1), cA + hstep, voffA);
        if (wr == 1) PG8_BAR;
        PG8_WAIT_V(4); PG8_BAR;
        PG8_STAGE(PG8_SB(1, 0), cB + kstep, voffB); PG8_STAGE(PG8_SA(1, 0), cA + kstep, voffA); PG8_STAGE(PG8_SB(1, 1), cB + hstep + kstep, voffB);
        PG8_WAIT_V(6); PG8_BAR;
    }
    for (;;) {
        const bool has_next = S.next(ui + 1, nxt);
        const char* nA = has_next ? (const char*)g.A + (size_t)nxt.pm * tstep : cA; const char* nB = has_next ? (const char*)g.Bt + (size_t)nxt.pn * tstep : cB;
_Pragma("unroll 1")
        for (int t = 0; t < nt; t += 2) {
            const bool last = (t == nt - 2);
            const char* a1 = cA + (size_t)(t + 1) * kstep;
            const char* a2 = last ? nA : cA + (size_t)(t + 2) * kstep; const char* b2 = last ? nB : cB + (size_t)(t + 2) * kstep;
            const char* a3 = a2 + kstep; const char* b3 = b2 + kstep;
            if (last && has_next) S.a_ready(nxt);
            if constexpr (SP2) {
            const bool rx = (Epi::EPI_VM > 0) && (t == 0) && (ui > 0);
            PG8_LDB(B0, 0, 0); PG8_LDB(B1, 0, 1); PG8_SCHED; PG8_LDA(At, 0, 0); PG8_STAGE(PG8_SA(1, 1), a1 + hstep, voffA);
            if (rx) PG8_WAIT_VN(8 + Epi::EPI_VM); else PG8_WAIT_V(8);
            PG8_WAIT_L(0); PG8_BAR; PG8_MMA(0, 0, At, B0); PG8_MMA(0, 1, At, B1); PG8_BAR; PG8_SCHED;
            PG8_LDA(At, 0, 1); PG8_STAGE(PG8_SB(0, 0), b2, voffB); PG8_STAGE(PG8_SB(0, 1), b2 + hstep, voffB); PG8_STAGE(PG8_SA(0, 0), a2, voffA);
            if (rx) PG8_WAIT_VN(8 + Epi::EPI_VM); else PG8_WAIT_V(8);
            PG8_WAIT_L(0); PG8_BAR; PG8_MMA(1, 0, At, B0); PG8_MMA(1, 1, At, B1); PG8_BAR; PG8_SCHED;
            PG8_LDB(B0, 1, 0); PG8_LDB(B1, 1, 1); PG8_SCHED; PG8_LDA(At, 1, 0); PG8_STAGE(PG8_SA(0, 1), a2 + hstep, voffA);
            PG8_WAIT_V(8); PG8_WAIT_L(0); PG8_BAR; PG8_MMA(0, 0, At, B0); PG8_MMA(0, 1, At, B1); PG8_BAR; PG8_SCHED;
            PG8_LDA(At, 1, 1); PG8_STAGE(PG8_SB(1, 0), b3, voffB); PG8_STAGE(PG8_SB(1, 1), b3 + hstep, voffB); PG8_STAGE(PG8_SA(1, 0), a3, voffA);
            PG8_WAIT_V(8); PG8_WAIT_L(0); PG8_BAR; PG8_MMA(1, 0, At, B0); PG8_MMA(1, 1, At, B1); PG8_BAR; PG8_SCHED;
            } else {
            PG8_LDB(B0, 0, 0); PG8_SCHED; PG8_LDA(At, 0, 0); PG8_STAGE(PG8_SA(1, 1), a1 + hstep, voffA);
            PG8_WAIT_L(8); PG8_BAR; PG8_WAIT_L(0); PG8_MMA(0, 0, At, B0); PG8_BAR; PG8_SCHED;
            PG8_LDB(B1, 0, 1); PG8_STAGE(PG8_SB(0, 0), b2, voffB);
            PG8_BAR; PG8_WAIT_L(0); PG8_MMA(0, 1, At, B1); PG8_BAR;
            PG8_LDA(At, 0, 1); PG8_STAGE(PG8_SA(0, 0), a2, voffA);
            PG8_BAR; PG8_WAIT_L(0); PG8_MMA(1, 0, At, B0); PG8_BAR; PG8_SCHED;
            PG8_STAGE(PG8_SB(0, 1), b2 + hstep, voffB);
            PG8_WAIT_V(6); PG8_BAR; PG8_MMA(1, 1, At, B1); PG8_BAR;
            PG8_LDB(B0, 1, 0); PG8_SCHED; PG8_LDA(At, 1, 0); PG8_STAGE(PG8_SA(0, 1), a2 + hstep, voffA);
            PG8_WAIT_L(8); PG8_BAR; PG8_WAIT_L(0); PG8_MMA(0, 0, At, B0); PG8_BAR; PG8_SCHED;
            PG8_LDB(B1, 1, 1); PG8_STAGE(PG8_SB(1, 0), b3, voffB);
            PG8_BAR; PG8_WAIT_L(0); PG8_MMA(0, 1, At, B1); PG8_BAR;
            PG8_LDA(At, 1, 1); PG8_STAGE(PG8_SA(1, 0), a3, voffA);
            PG8_BAR; PG8_WAIT_L(0); PG8_MMA(1, 0, At, B0); PG8_BAR; PG8_SCHED;
            PG8_STAGE(PG8_SB(1, 1), b3 + hstep, voffB);
            PG8_WAIT_V(6); PG8_BAR; PG8_MMA(1, 1, At, B1); PG8_BAR;
            }
            if constexpr (Hook::ACTIVE) { if (t + 2 < nt) H.mid(acc, cur, t + 2, wr, wc, fr, fq); }
        }
        if constexpr (FP8) asm volatile("s_nop 15\n\ts_nop 15\n\ts_nop 15\n\ts_nop 15" ::: "memory");
        if constexpr (ALIGN_EPI) { if (wr == 0) PG8_BAR; }
        if constexpr (!Epi::AFTER_DRAIN) { E(acc, cur, wr, wc, fr, fq); S.done(cur); }
        if (!has_next) break;
#pragma unroll
        for (int a = 0; a < 2; ++a)
#pragma unroll
            for (int b = 0; b < 2; ++b)
#pragma unroll
                for (int m = 0; m < 4; ++m)
#pragma unroll
                    for (int n = 0; n < 2; ++n) acc[a][b][m][n] = (f32x4){0.f, 0.f, 0.f, 0.f};
        cur = nxt; cA = nA; cB = nB; ++ui;
        if constexpr (ALIGN_EPI) { if (wr == 1) PG8_BAR; }
    }
    PG8_WAIT_V(0);
    if constexpr (!ALIGN_EPI) { if (wr == 0) PG8_BAR; }
    PG8_BAR;
    if constexpr (Epi::AFTER_DRAIN) { E.fused(acc, cur, wr, wc, fr, fq, lds, wid, lane); S.done(cur); }
#undef PG8_SA
#undef PG8_SB
#undef PG8_STAGE
#undef PG8_RD16
#undef PG8_CAT8
#undef PG8_LDA
#undef PG8_LDB
#undef PG8_MMA
#undef PG8_WAIT_V
#undef PG8_WAIT_VN
#undef PG8_WAIT_L
#undef PG8_BAR
#undef PG8_SCHED
}
}
#define GAS __attribute__((address_space(1)))
#define LAS __attribute__((address_space(3)))
typedef unsigned short bf16;
typedef unsigned v4u __attribute__((ext_vector_type(4)));
typedef float f32x4 __attribute__((ext_vector_type(4)));
typedef short bf16x8 __attribute__((ext_vector_type(8)));
typedef GAS unsigned gu32;
typedef GAS unsigned long long gu64;
#define RLX_AGENT __ATOMIC_RELAXED, __HIP_MEMORY_SCOPE_AGENT
#define LDS_WAIT() asm volatile("s_waitcnt lgkmcnt(0)" ::: "memory")
#define VM_WAIT() asm volatile("s_waitcnt vmcnt(0)" ::: "memory")
__device__ __forceinline__ unsigned long long rt() { return __builtin_amdgcn_s_memrealtime(); }
__device__ __forceinline__ unsigned f2bf(float f) { unsigned u = __builtin_bit_cast(unsigned, f); return (u + 0x7fffu + ((u >> 16) & 1u)) >> 16; }
__device__ __forceinline__ unsigned pk2(float lo, float hi) { return f2bf(lo) | (f2bf(hi) << 16); }

#define XB_TMO      128
#define XB_XCNT(j)  (256  + 64 * (j))
#define XB_XSUB(j)  (1280 + 64 * (j))
#define XB_XGEN(j)  (2304 + 64 * (j))
#define XB_TOP      3328
#define XB_TOPGEN   3392
#define XCD_BAR_WORDS 3456
#define XB_SPIN_CAP (1u << 22)

__device__ __forceinline__ unsigned xb_ld(unsigned* p)              { return __hip_atomic_load(p, __ATOMIC_RELAXED, __HIP_MEMORY_SCOPE_AGENT); }
__device__ __forceinline__ unsigned xb_add(unsigned* p, unsigned v) { return __hip_atomic_fetch_add(p, v, __ATOMIC_RELAXED, __HIP_MEMORY_SCOPE_AGENT); }
__device__ __forceinline__ unsigned xb_xcc_id() { return (unsigned)__builtin_amdgcn_s_getreg((3 << 11) | 20) & 0xFu; }
#define XB_SPIN(cond, bar) do { unsigned _sp = 0; while (cond) { __builtin_amdgcn_s_sleep(1); \
    if ((++_sp & 255u) == 0u) { if (xb_ld(&(bar)[XB_TMO])) break; if (_sp > XB_SPIN_CAP) { atomicAdd(&(bar)[XB_TMO], 1u); break; } } } } while (0)

struct XcdBarrier {
    unsigned* bar; unsigned x; unsigned w0;
    volatile LAS unsigned* st;
};

__device__ __forceinline__ XcdBarrier xcd_barrier_post(unsigned* bar, volatile LAS unsigned* st) {
    XcdBarrier b; b.bar = bar; b.x = xb_xcc_id(); b.st = st; { unsigned wv_ = (unsigned)__builtin_amdgcn_readfirstlane((int)(threadIdx.x >> 6)); asm volatile("" : "+s"(wv_)); b.w0 = wv_; }
    if (threadIdx.x == 0) (void)xb_add(&bar[XB_XCNT(b.x)], 1u);
    return b;
}
__device__ __forceinline__ void xcd_barrier_complete(unsigned* bar, unsigned x, unsigned& nloc, unsigned& nx) {
    const unsigned G = gridDim.x * gridDim.y * gridDim.z;
    unsigned sum, cnt, mine, sp = 0u;
    for (;;) {
        sum = 0u; cnt = 0u; mine = 0u;
#pragma unroll
        for (unsigned j = 0; j < 16; ++j) { const unsigned c = xb_ld(&bar[XB_XCNT(j)]); sum += c; cnt += (c > 0u) ? 1u : 0u; mine = (j == x) ? c : mine; }
        if (sum == G) break;
        __builtin_amdgcn_s_sleep(1);
        if ((++sp & 255u) == 0u) { if (xb_ld(&bar[XB_TMO])) break; if (sp > XB_SPIN_CAP) { atomicAdd(&bar[XB_TMO], 1u); break; } }
    }
    nloc = mine > 0u ? mine : 1u; nx = cnt > 0u ? cnt : 1u;
}

__device__ __forceinline__ void xcd_barrier(const XcdBarrier& b) {
    asm volatile("s_waitcnt vmcnt(0)" ::: "memory");
    __syncthreads();
    if (b.w0 == 0u && lane_id_now() == 0) {
        unsigned* bar = b.bar;
        __builtin_amdgcn_s_waitcnt(0);
        unsigned nloc = b.st[0], nx = b.st[1];
        if (nloc == 0u) { xcd_barrier_complete(bar, b.x, nloc, nx); b.st[0] = nloc; b.st[1] = nx; }
        const unsigned old = xb_add(&bar[XB_XSUB(b.x)], 1u);
        const unsigned gen = old / nloc;
        if (old + 1u == (gen + 1u) * nloc) {
            __builtin_amdgcn_fence(__ATOMIC_RELEASE, "agent");
            asm volatile("s_waitcnt vmcnt(0)" ::: "memory");
            const unsigned og = xb_add(&bar[XB_TOP], 1u);
            const unsigned tg = og / nx;
            if (og + 1u == (tg + 1u) * nx) xb_add(&bar[XB_TOPGEN], 1u);
            else XB_SPIN(xb_ld(&bar[XB_TOPGEN]) == tg, bar);
            __builtin_amdgcn_fence(__ATOMIC_ACQUIRE, "agent");
            xb_add(&bar[XB_XGEN(b.x)], 1u);
            asm volatile("s_waitcnt vmcnt(0)" ::: "memory");
        } else {
            XB_SPIN(xb_ld(&bar[XB_XGEN(b.x)]) == gen, bar);
            __builtin_amdgcn_fence(__ATOMIC_ACQUIRE, "agent");
            asm volatile("s_waitcnt vmcnt(0)" ::: "memory");
        }
    }
    __syncthreads();
}

__device__ __forceinline__ void group_barrier(unsigned* bar, unsigned* lc, unsigned* gc, unsigned nloc, unsigned k, unsigned w0) {
    asm volatile("s_waitcnt vmcnt(0)" ::: "memory");
    __syncthreads();
    if (w0 == 0u && lane_id_now() == 0) {
        __builtin_amdgcn_s_waitcnt(0);
        const unsigned old = xb_add(lc, 1u);
        const unsigned gen = old / nloc;
        if (old + 1u == (gen + 1u) * nloc) {
            __builtin_amdgcn_fence(__ATOMIC_RELEASE, "agent");
            asm volatile("s_waitcnt vmcnt(0)" ::: "memory");
            (void)xb_add(gc, nloc);
        }
        const unsigned target = 32u * k;
        XB_SPIN(xb_ld(gc) < target, bar);
        __builtin_amdgcn_fence(__ATOMIC_ACQUIRE, "agent");
        asm volatile("s_waitcnt vmcnt(0)" ::: "memory");
    }
    __syncthreads();
}
constexpr int NWAVES = 8, NTHREADS = 512;
constexpr int NB = 8, SEQ = 4096, DM = 1024, MROWS = NB * SEQ, FF = 4096, NIN = 5444, DEPTH = 2;
constexpr int NPROJ = 2048;
constexpr int CA_Q = 0, CA_K = 256, CI_Q = 512, CI_W = 800, CB_U = 1024, CB_V = 1280, CC_Q = 1536, CC_K = 1792;
constexpr float LOG2E = 1.4426950408889634f;
constexpr float EPS = 1e-6f;
constexpr size_t MiB = 1u << 20;
constexpr size_t WS_CTL = 0, CTL_ZERO_BYTES = 1 * MiB;
constexpr size_t WS_WL = 1 * MiB, WL_STRIDE = 31 * MiB + 256 * 1024;
constexpr size_t WO_IN1 = 0, WO_VT = 10 * MiB, WO_B = 11 * MiB, WO_O = 13 * MiB, WO_F1 = 15 * MiB, WO_F2 = 23 * MiB, WO_S = 31 * MiB;
static_assert(WO_B + 3 * 1024 * 256 * 2 <= WO_O && WO_F2 + 8 * MiB <= WO_S && WO_S + 131072 <= WL_STRIDE && WS_WL + 2 * WL_STRIDE <= 64 * MiB, "weights map");
constexpr size_t WS_H = 64 * MiB;
constexpr size_t WS_Y = WS_H, WS_MASK = WS_H + 48 * MiB;
constexpr size_t WS_PA = 128 * MiB;
constexpr size_t WS_MA = WS_PA, WS_MB = WS_PA + 64 * MiB;
constexpr size_t WS_G = 256 * MiB;
constexpr size_t WS_ACT = 128 * MiB;
constexpr size_t WS_VTA = 448 * MiB;
constexpr size_t WS_KIDX = WS_WL + 4 * MiB;
constexpr size_t WS_WG8 = WS_WL + WL_STRIDE + 4 * MiB;
constexpr size_t WS_RS = WS_WL + 8 * MiB;
constexpr size_t WS_XB = 384 * MiB;
constexpr size_t WS_H8 = 480 * MiB;
constexpr size_t WS_END = 512 * MiB;
constexpr int CW_BAR = 4096;
constexpr int CW_GRP = 8192;
constexpr int CW_NRM = 16384;
constexpr int RING_BYTES = 131072;
constexpr int HIST_OFF = 131072, HIST_BYTES = 16384;
constexpr int ILIST_OFF = HIST_OFF + HIST_BYTES;
constexpr int MW_OFF = ILIST_OFF + 4096;
constexpr int MISC_OFF = MW_OFF + 4096;
constexpr int LDS_BYTES = MISC_OFF + 512;

#define DI __device__ __forceinline__
typedef float f32x16 __attribute__((ext_vector_type(16)));
typedef float f32x2 __attribute__((ext_vector_type(2)));
typedef __bf16 bf16x2_t __attribute__((ext_vector_type(2)));
typedef unsigned u32x2 __attribute__((ext_vector_type(2)));
#define MFMA32(a, b, c) __builtin_amdgcn_mfma_f32_32x32x16_bf16((a), (b), (c), 0, 0, 0)
DI unsigned cvtpk(float lo, float hi) { f32x2 v = {lo, hi}; bf16x2_t b = __builtin_convertvector(v, bf16x2_t); return __builtin_bit_cast(unsigned, b); }
DI float blo(unsigned w) { return __uint_as_float(w << 16); }
DI float bhi(unsigned w) { return __uint_as_float(w & 0xffff0000u); }
DI float bf1(bf16 h) { return __uint_as_float((unsigned)h << 16); }
DI float fexp2(float x) { return __builtin_amdgcn_exp2f(x); }
DI float swapmax(float m) { auto rr = __builtin_amdgcn_permlane32_swap(__float_as_uint(m), __float_as_uint(m), false, false); return fmaxf(__uint_as_float(rr[0]), __uint_as_float(rr[1])); }
DI float swapsum(float m) { auto rr = __builtin_amdgcn_permlane32_swap(__float_as_uint(m), __float_as_uint(m), false, false); return __uint_as_float(rr[0]) + __uint_as_float(rr[1]); }
#define DPPF(v, ctrl) __int_as_float(__builtin_amdgcn_update_dpp(0, __float_as_int(v), (ctrl), 0xf, 0xf, true))
DI float quad_sum(float v) { v += DPPF(v, 0xB1); v += DPPF(v, 0x4E); return v; }
DI float row_sum(float v) { v = quad_sum(v); v += DPPF(v, 0x141); v += DPPF(v, 0x140); return v; }
DI float wave_sum(float v) { v = row_sum(v);
    return __int_as_float(__builtin_amdgcn_readlane(__float_as_int(v), 0)) + __int_as_float(__builtin_amdgcn_readlane(__float_as_int(v), 16)) + (__int_as_float(__builtin_amdgcn_readlane(__float_as_int(v), 32)) + __int_as_float(__builtin_amdgcn_readlane(__float_as_int(v), 48))); }
DI float gelu_tanh(float x) {
    const float u = 0.7978845608028654f * (x + 0.044715f * x * x * x);
    return x * __builtin_amdgcn_rcpf(1.0f + fexp2(-2.0f * LOG2E * u));
}
DI void wg_barrier() { asm volatile("s_waitcnt vmcnt(0) lgkmcnt(0)" ::: "memory"); __builtin_amdgcn_s_barrier(); asm volatile("" ::: "memory"); }
DI void lds_barrier() { asm volatile("s_waitcnt lgkmcnt(0)" ::: "memory"); __builtin_amdgcn_s_barrier(); asm volatile("" ::: "memory"); }

struct Ctx {
    LAS unsigned char* lds;
    int tid, lane, wave, vcu, G;
    float* out; unsigned char* ws;
};

constexpr int CW_GLC = 20480, CW_GCN = 28672;
DI void group_bar(XcdBarrier b, unsigned k, unsigned nloc) { asm volatile("" : "+s"(b.bar), "+s"(k), "+s"(nloc)); unsigned* ctl = b.bar - CW_BAR; const unsigned g = blockIdx.x & 7u;
    group_barrier(b.bar, ctl + CW_GLC + 64 * (g * 16 + (b.x & 15u)), ctl + CW_GRP + 64 * g, nloc, k, b.w0); }
DI void grid_bar(XcdBarrier b) { asm volatile("" : "+s"(b.bar), "+s"(b.x)); xcd_barrier(b); }
struct TrItem { const float* src; bf16* dst; const float* gain; int ldw, Kd, nvalid, fp8; float scale; };
DI TrItem tr_make(const float* W, int ldw, int k0, int c0, int nvalid, bf16* WT, int Kd, int drow, float scale, int lane, int kdst = -1, const float* gain = nullptr) {
    if (kdst < 0) kdst = k0;
    TrItem t; t.gain = gain ? gain + k0 : nullptr; t.src = W + (size_t)(k0 + (lane >> 5)) * ldw + c0 + (lane & 31); t.dst = WT + (size_t)drow * Kd + kdst; t.ldw = ldw; t.Kd = Kd; t.nvalid = nvalid; t.scale = scale; t.fp8 = 0; return t;
}
DI void tr_load(const TrItem& t, float (&wv)[32], int lane) {
#pragma unroll
    for (int i = 0; i < 32; ++i) wv[i] = ((lane & 31) < t.nvalid) ? t.src[(size_t)(2 * i) * t.ldw] : 0.f;
}
DI void tr_store(const TrItem& t, const float (&wv)[32], LAS float* scr, int lane) {
#pragma unroll
    for (int i = 0; i < 32; ++i) scr[(2 * i + (lane >> 5)) * 33 + (lane & 31)] = wv[i] * t.scale;
    LDS_WAIT(); asm volatile("" ::: "memory");
    const int c = lane & 7;
    f32x4 ga = {1.f, 1.f, 1.f, 1.f}, gb = {1.f, 1.f, 1.f, 1.f};
    if (t.gain) { ga = *(const GAS f32x4*)(t.gain + 8 * c); gb = *(const GAS f32x4*)(t.gain + 8 * c + 4); }
#pragma unroll
    for (int j = 0; j < 4; ++j) { const int n = (lane >> 3) + 8 * j; const LAS float* s = scr + (8 * c) * 33 + n;
        const float e0 = s[0 * 33] * ga[0], e1 = s[1 * 33] * ga[1], e2 = s[2 * 33] * ga[2], e3 = s[3 * 33] * ga[3], e4 = s[4 * 33] * gb[0], e5 = s[5 * 33] * gb[1], e6 = s[6 * 33] * gb[2], e7 = s[7 * 33] * gb[3];
        if (t.fp8) { int lo = __builtin_amdgcn_cvt_pk_fp8_f32(e0, e1, 0, false); lo = __builtin_amdgcn_cvt_pk_fp8_f32(e2, e3, lo, true);
            int hi = __builtin_amdgcn_cvt_pk_fp8_f32(e4, e5, 0, false); hi = __builtin_amdgcn_cvt_pk_fp8_f32(e6, e7, hi, true);
            *(GAS u32x2*)((unsigned char*)t.dst + (size_t)n * t.Kd + 8 * c) = (u32x2){(unsigned)lo, (unsigned)hi}; }
        else { v4u o; o.x = cvtpk(e0, e1); o.y = cvtpk(e2, e3); o.z = cvtpk(e4, e5); o.w = cvtpk(e6, e7);
            *(GAS v4u*)(t.dst + (size_t)n * t.Kd + 8 * c) = o; } }
    LDS_WAIT(); asm volatile("" ::: "memory");
}
DI void win_map(int cb, int& c0, int& nv, int& dsel, int& drow, float& sc) {
    nv = 32; dsel = 0; sc = 1.f;
    if (cb < 8)        { c0 = 0 + 32 * cb;            drow = CA_Q + 32 * cb; sc = 0.125f * LOG2E; }
    else if (cb < 16)  { c0 = 256 + 32 * (cb - 8);    drow = CA_K + 32 * (cb - 8); }
    else if (cb < 24)  { c0 = 512 + 32 * (cb - 16);   drow = 32 * (cb - 16); dsel = 1; }
    else if (cb < 32)  { c0 = 768 + 32 * (cb - 24);   drow = CI_Q + 32 * (cb - 24); sc = 0.125f; }
    else if (cb == 32) { c0 = 1024;                   drow = 768; }
    else if (cb == 33) { c0 = 1056;                   drow = 768 + 128; }
    else if (cb == 34) { c0 = 1088; nv = 4;           drow = CI_W; sc = 0.5f; }
    else if (cb < 43)  { c0 = 1092 + 32 * (cb - 35);  drow = CB_U + 32 * (cb - 35); }
    else if (cb < 51)  { c0 = 1348 + 32 * (cb - 43);  drow = CB_V + 32 * (cb - 43); }
    else if (cb < 59)  { c0 = 1604 + 32 * (cb - 51);  drow = CC_Q + 32 * (cb - 51); sc = 0.17677669529663687f * LOG2E; }
    else if (cb < 67)  { c0 = 1860 + 32 * (cb - 59);  drow = CC_K + 32 * (cb - 59); }
    else if (cb < 75)  { c0 = 2116 + 32 * (cb - 67);  drow = 256 + 32 * (cb - 67); dsel = 1; }
    else               { c0 = 2372 + 32 * (cb - 75);  drow = 32 * (cb - 75); dsel = 2; sc = 32.0f; }
}
constexpr int NCB_IN = 75 + 96;
constexpr int I_IN = NCB_IN * 16, I_B = 32 * 4, I_O = 32 * 16, I_F1 = 128 * 16, I_F2 = 32 * 64;
constexpr int PER_LAYER = I_IN + 3 * I_B + I_O + I_F1 + I_F2;
DI TrItem tr_desc(int it, unsigned char* wsb, const float* g1, const float* g2, const float* w_in, const float* wba, const float* wbb, const float* wbc, const float* w_o, const float* w_f1, const float* w_f2, int lane) {
    const int l = it / PER_LAYER; int r = it % PER_LAYER;
    unsigned char* wl = wsb + WS_WL + (size_t)l * WL_STRIDE;
    if (r < I_IN) { const int cb = r % NCB_IN, kb = r / NCB_IN; int c0, nv, dsel, drow; float sc; win_map(cb, c0, nv, dsel, drow, sc);
        if (dsel == 2) { TrItem t = tr_make(w_in + (size_t)l * DM * NIN, NIN, 64 * kb, c0, nv, (bf16*)(wsb + WS_WG8 + (size_t)l * 3 * MiB), DM, 0, sc, lane, 0, g1 + l * DM); t.gain = g1 + l * DM + 64 * kb;
            t.dst = (bf16*)((unsigned char*)(wsb + WS_WG8 + (size_t)l * 3 * MiB) + (size_t)drow * DM + 64 * kb); t.fp8 = 1; return t; }
        return tr_make(w_in + (size_t)l * DM * NIN, NIN, 64 * kb, c0, nv, (bf16*)(wl + (dsel ? WO_VT : WO_IN1)), DM, drow, sc, lane, -1, g1 + l * DM); }
    r -= I_IN;
    if (r < 3 * I_B) { const int w = r / I_B, q = r % I_B, cb = q % 32, kb = q / 32;
        return tr_make((w == 0 ? wba : (w == 1 ? wbb : wbc)) + (size_t)l * 256 * DM, DM, 64 * kb, 32 * cb, 32, (bf16*)(wl + WO_B), 768, 32 * cb, 1.f, lane, 256 * w + 64 * kb); }
    r -= 3 * I_B;
    if (r < I_O) { const int cb = r % 32, kb = r / 32; return tr_make(w_o + (size_t)l * DM * DM, DM, 64 * kb, 32 * cb, 32, (bf16*)(wl + WO_O), DM, 32 * cb, 1.f, lane); }
    r -= I_O;
    if (r < I_F1) { const int cb = r % 128, kb = r / 128; return tr_make(w_f1 + (size_t)l * DM * FF, FF, 64 * kb, 32 * cb, 32, (bf16*)(wl + WO_F1), DM, 32 * cb, 1.f, lane, -1, g2 + l * DM); }
    r -= I_F1;
    { const int cb = r % 32, kb = r / 32; return tr_make(w_f2 + (size_t)l * FF * DM, DM, 64 * kb, 32 * cb, 32, (bf16*)(wl + WO_F2), FF, 32 * cb, 1.f, lane); }
}
DI void prologue_weights(const Ctx& C, unsigned char* wsb, const float* g1, const float* g2, const float* w_in, const float* w_s, const float* wba, const float* wbb, const float* wbc, const float* w_o, const float* w_f1, const float* w_f2) {
    LAS float* scr = (LAS float*)(C.lds + C.wave * 16384);
    const int gw = C.vcu * NWAVES + C.wave, NGW = C.G * NWAVES;
    {
        constexpr int TOTAL = DEPTH * PER_LAYER;
        float wa[32], wb[32]; TrItem ta, tb;
        int it = gw;
        if (it < TOTAL) { ta = tr_desc(it, wsb, g1, g2, w_in, wba, wbb, wbc, w_o, w_f1, w_f2, C.lane); tr_load(ta, wa, C.lane); }
        while (it < TOTAL) {
            if (it + NGW < TOTAL) { tb = tr_desc(it + NGW, wsb, g1, g2, w_in, wba, wbb, wbc, w_o, w_f1, w_f2, C.lane); tr_load(tb, wb, C.lane); }
            tr_store(ta, wa, scr, C.lane);
            it += NGW; if (it >= TOTAL) break;
            if (it + NGW < TOTAL) { ta = tr_desc(it + NGW, wsb, g1, g2, w_in, wba, wbb, wbc, w_o, w_f1, w_f2, C.lane); tr_load(ta, wa, C.lane); }
            tr_store(tb, wb, scr, C.lane);
            it += NGW;
        }
    }
    const int gt = C.vcu * NTHREADS + C.tid, NGT = C.G * NTHREADS;
    for (int it = gt; it < DEPTH * 160 * 128; it += NGT) { const int l = it / (160 * 128), q = it % (160 * 128), rr = q / 128, ch = q % 128;
        const int row = rr < 64 ? 832 + rr : 928 + (rr - 64);
        *(GAS v4u*)((bf16*)(wsb + WS_WL + (size_t)l * WL_STRIDE + WO_IN1) + (size_t)row * DM + 8 * ch) = (v4u){0u, 0u, 0u, 0u}; }
    for (int it = gt; it < DEPTH * 4 * 128 * 128 / 2; it += NGT) { const int e = 2 * it, l = e / 65536, q = e % 65536, t = (q >> 7) & 127, s = q & 127;
        const float* src = w_s + e; const float a = (s <= t) ? src[0] : 0.f, b = (s + 1 <= t) ? src[1] : 0.f;
        *(GAS unsigned*)((bf16*)(wsb + WS_WL + (size_t)l * WL_STRIDE + WO_S) + q) = cvtpk(a, b); }
}
DI void rmsnorm_rows(const Ctx& C, const float* src, const float* g, bf16* dstb, float* dstf, unsigned char* dst8 = nullptr, const bf16* src16 = nullptr) {
    int tid_ = C.wave * 64 + lane_id_now(); asm volatile("" : "+v"(tid_));
    const int lane = tid_ & 63, wave = __builtin_amdgcn_readfirstlane(tid_ >> 6);
    const int gw = C.vcu * NWAVES + wave, NGW = C.G * NWAVES;
    f32x4 gv[4];
#pragma unroll
    for (int j = 0; j < 4; ++j) gv[j] = *((const GAS f32x4*)g + lane + 64 * j);
    for (int m = gw; m < MROWS; m += NGW) {
        f32x4 v[4]; float s = 0.f;
        if (src16) { const GAS u32x2* xr = (const GAS u32x2*)(src16 + (size_t)m * DM) + lane;
#pragma unroll
            for (int j = 0; j < 4; ++j) { const u32x2 p = xr[64 * j]; v[j] = (f32x4){blo(p.x), bhi(p.x), blo(p.y), bhi(p.y)}; } }
        else { const GAS f32x4* xr = (const GAS f32x4*)(src + (size_t)m * DM) + lane;
#pragma unroll
            for (int j = 0; j < 4; ++j) v[j] = xr[64 * j]; }
#pragma unroll
        for (int j = 0; j < 4; ++j) s += (v[j].x * v[j].x + v[j].y * v[j].y) + (v[j].z * v[j].z + v[j].w * v[j].w);
        const float rstd = 1.0f / sqrtf(wave_sum(s) * (1.0f / DM) + EPS);
        if (dstb) { GAS u32x2* o8 = (GAS u32x2*)(dstb + (size_t)m * DM) + lane;
#pragma unroll
            for (int j = 0; j < 4; ++j) { const f32x4 y = v[j] * rstd * gv[j]; o8[64 * j] = (u32x2){cvtpk(y.x, y.y), cvtpk(y.z, y.w)};
                if (dst8) { int p = __builtin_amdgcn_cvt_pk_fp8_f32(y.x, y.y, 0, false); p = __builtin_amdgcn_cvt_pk_fp8_f32(y.z, y.w, p, true); *((GAS unsigned*)(dst8 + (size_t)m * DM) + lane + 64 * j) = (unsigned)p; } } }
        else { GAS f32x4* o = (GAS f32x4*)(dstf + (size_t)m * DM) + lane;
#pragma unroll
            for (int j = 0; j < 4; ++j) o[64 * j] = v[j] * rstd * gv[j]; }
    }
}

DI void prep_rows(const Ctx& C, const float* src, bf16* xb, unsigned char* x8, float* rs) {
    int tid_ = C.wave * 64 + lane_id_now(); asm volatile("" : "+v"(tid_));
    const int lane = tid_ & 63, wave = __builtin_amdgcn_readfirstlane(tid_ >> 6);
    const int gw = C.vcu * NWAVES + wave, NGW = C.G * NWAVES;
    for (int m = gw; m < MROWS; m += NGW) {
        const GAS f32x4* xr = (const GAS f32x4*)(src + (size_t)m * DM) + lane;
        f32x4 v[4]; float s = 0.f;
#pragma unroll
        for (int j = 0; j < 4; ++j) { v[j] = xr[64 * j]; s += (v[j].x * v[j].x + v[j].y * v[j].y) + (v[j].z * v[j].z + v[j].w * v[j].w); }
        s = wave_sum(s);
        GAS u32x2* o8 = (GAS u32x2*)(xb + (size_t)m * DM) + lane;
#pragma unroll
        for (int j = 0; j < 4; ++j) { o8[64 * j] = (u32x2){cvtpk(v[j].x, v[j].y), cvtpk(v[j].z, v[j].w)};
            int p = __builtin_amdgcn_cvt_pk_fp8_f32(v[j].x, v[j].y, 0, false); p = __builtin_amdgcn_cvt_pk_fp8_f32(v[j].z, v[j].w, p, true); *((GAS unsigned*)(x8 + (size_t)m * DM) + lane + 64 * j) = (unsigned)p; }
        if (lane < 16) *(GAS float*)(rs + (size_t)m * 16 + lane) = lane == 0 ? s : 0.f;
    }
}
DI float relu_bits(float x) { const int i = __float_as_int(x); return __int_as_float(i > 0 ? i : 0); }
DI int pi32(int x) { return (x & 0x13) | ((x & 4) << 1) | ((x & 8) >> 1); }
#define DPPU(v, ctrl) ((unsigned)__builtin_amdgcn_update_dpp(0, (int)(v), (ctrl), 0xf, 0xf, true))
DI unsigned suffix_excl(unsigned T, int lane) {
    unsigned s = T;
    s += DPPU(s, 0x101); s += DPPU(s, 0x102); s += DPPU(s, 0x104); s += DPPU(s, 0x108);
    const unsigned r1 = (unsigned)__builtin_amdgcn_readlane((int)s, 16), r2 = (unsigned)__builtin_amdgcn_readlane((int)s, 32), r3 = (unsigned)__builtin_amdgcn_readlane((int)s, 48);
    s += (lane < 16 ? r1 : 0u) + (lane < 32 ? r2 : 0u) + (lane < 48 ? r3 : 0u);
    return s - T;
}
#ifndef SEL_FAST_MAX
#define SEL_FAST_MAX 256u
#endif
#ifndef SEL_RANK_MAX
#define SEL_RANK_MAX 0u
#endif
constexpr int SC_OFF = 0, HR_OFF = 65536;
constexpr int CL_OFF = 131072;
DI void select_phase(const Ctx& C, int b, int wi, const bf16* projA, const bf16* kidx, unsigned long long* mask) {
    LAS unsigned short* scores = (LAS unsigned short*)(C.lds + SC_OFF);
    LAS unsigned* hist = (LAS unsigned*)(C.lds + HR_OFF);
    int tid_ = C.wave * 64 + lane_id_now(); asm volatile("" : "+v"(tid_));
    const int tid = tid_, lane = tid & 63, wave = __builtin_amdgcn_readfirstlane(tid >> 6), hi = lane >> 5, l31 = lane & 31;
    const size_t rowb = (size_t)b * SEQ;
    unsigned z0 = 0u; asm volatile("" : "+v"(z0)); const v4u zero4 = {z0, z0, z0, z0};
    { LAS v4u* h4 = (LAS v4u*)hist;
#pragma unroll
      for (int k = 0; k < 8; ++k) h4[tid + 512 * k] = zero4; }
    const bf16* kbase = kidx + (((rowb >> 5) * 8 + hi) * 32 + l31) * 8;
    { const int t = 8 * wi + wave;
      if (lane <= (t >> 6)) { const int rem = t - 64 * lane;
          const int c0_ = rem + 1 < 32 ? rem + 1 : 32, c1_ = rem + 1 - 32 < 0 ? 0 : (rem + 1 - 32 < 32 ? rem + 1 - 32 : 32);
          const unsigned w0_ = (unsigned)((1ull << ((c0_ + 1) >> 1)) - 1ull) | ((unsigned)((1ull << (c0_ >> 1)) - 1ull) << 16), w1_ = (unsigned)((1ull << ((c1_ + 1) >> 1)) - 1ull) | ((unsigned)((1ull << (c1_ >> 1)) - 1ull) << 16);
          mask[(rowb + t) * 64 + lane] = ((unsigned long long)w1_ << 32) | w0_; } }
    const int lperm = (lane & 32) + ((lane & 16) ? 2 * (lane & 15) + 1 : 2 * (lane & 15));
#define SEL_QLOAD(QF, CW, t0_) do { const bf16* qp_ = projA + (rowb + (t0_) + (l31 >> 2)) * 2048 + CI_Q + (l31 & 3) * 64 + 8 * hi; \
        _Pragma("unroll") for (int kk = 0; kk < 4; ++kk) QF[kk] = *(const bf16x8*)(qp_ + 16 * kk); \
        _Pragma("unroll") for (int jq = 0; jq < 4; ++jq) CW[jq] = *(const u32x2*)(projA + (rowb + (t0_) + 2 * jq + hi) * 2048 + CI_W); } while (0)
    bf16x8 qf[4], qfn[4]; u32x2 cw[4], cwn[4];
    SEL_QLOAD(qf, cw, 8 * (32 + 31 - wi));
    const int hbase = ((l31 & 3) * 8 + hi) * 512;
    lds_barrier();
#pragma unroll 1
    for (int j = 1; j < 16; ++j) {
    const int t0 = 8 * (32 * j + ((j & 1) ? 31 - wi : wi));
    const int nk = (t0 + 8 + 63) & ~63, ntile = nk >> 5;
    float coef[16];
#pragma unroll
    for (int jq = 0; jq < 4; ++jq) { coef[4 * jq] = blo(cw[jq].x) * 4096.0f; coef[4 * jq + 1] = bhi(cw[jq].x) * 4096.0f; coef[4 * jq + 2] = blo(cw[jq].y) * 4096.0f; coef[4 * jq + 3] = bhi(cw[jq].y) * 4096.0f; }
#define SEL_LOAD(K, tile) do { const bf16* kp_ = kbase + (size_t)(tile) * (8 * 32 * 8); \
        asm volatile("global_load_dwordx4 %0, %4, off\n\tglobal_load_dwordx4 %1, %4, off offset:1024\n\tglobal_load_dwordx4 %2, %4, off offset:2048\n\tglobal_load_dwordx4 %3, %4, off offset:3072" \
                     : "=&v"(K[0]), "=&v"(K[1]), "=&v"(K[2]), "=&v"(K[3]) : "v"(kp_) : "memory"); } while (0)
#define SEL_WAIT(K, n) asm volatile("s_waitcnt vmcnt(" #n ")" : "+v"(K[0]), "+v"(K[1]), "+v"(K[2]), "+v"(K[3]) :: "memory")
#define SEL_COMP_(K, tile, EDGE) do { const int kv0_ = (tile) * 32; f32x16 acc = {}; \
        _Pragma("unroll") for (int kk = 0; kk < 4; ++kk) acc = MFMA32(qf[kk], K[kk], acc); \
        const int key = kv0_ + l31; \
        _Pragma("unroll") for (int jq = 0; jq < 4; ++jq) { float x = 32768.0f; \
            _Pragma("unroll") for (int h = 0; h < 4; ++h) x = fmaf(coef[4 * jq + h], relu_bits(acc[4 * jq + h]), x); \
            const int q = 2 * jq + hi; x = fminf(fmaxf(x, 0.0f), 65535.0f); \
            unsigned u = (unsigned)(int)x; if (EDGE) { if (key > t0 + q) u = 0u; } \
            scores[q * 4096 + key] = (unsigned short)u; \
            __hip_atomic_fetch_add(hist + hbase + 1024 * jq + (u >> 7), 1u << ((u >> 2) & 16u), __ATOMIC_RELAXED, __HIP_MEMORY_SCOPE_WORKGROUP); } } while (0)
#define SEL_COMP(K, tile) do { if ((tile) * 32 + 31 > t0) SEL_COMP_(K, tile, true); else SEL_COMP_(K, tile, false); } while (0)
    {
        bf16x8 ka[4], kb[4], kc[4];
        const int cnt = (ntile - wave + 7) >> 3, tlast = wave + 8 * (cnt - 1);
#define SEL_T(i) ((wave + 8 * (i)) < tlast ? (wave + 8 * (i)) : tlast)
        SEL_LOAD(ka, SEL_T(0)); SEL_LOAD(kb, SEL_T(1));
        for (int i = 0; i < cnt; i += 3) {
            SEL_LOAD(kc, SEL_T(i + 2)); SEL_WAIT(ka, 8); SEL_COMP(ka, wave + 8 * i);
            if (i + 1 < cnt) { SEL_LOAD(ka, SEL_T(i + 3)); SEL_WAIT(kb, 8); SEL_COMP(kb, wave + 8 * (i + 1)); }
            if (i + 2 < cnt) { SEL_LOAD(kb, SEL_T(i + 4)); SEL_WAIT(kc, 8); SEL_COMP(kc, wave + 8 * (i + 2)); }
        }
        asm volatile("s_waitcnt vmcnt(0)" : "+v"(ka[0]), "+v"(ka[1]), "+v"(ka[2]), "+v"(ka[3]), "+v"(kb[0]), "+v"(kb[1]), "+v"(kb[2]), "+v"(kb[3]), "+v"(kc[0]), "+v"(kc[1]), "+v"(kc[2]), "+v"(kc[3]) :: "memory");
#undef SEL_T
    }
#undef SEL_WAIT
#undef SEL_LOAD
#undef SEL_COMP
#undef SEL_COMP_
    lds_barrier();
    if (j + 1 < 16) { const int t0n = 8 * (32 * (j + 1) + (((j + 1) & 1) ? 31 - wi : wi)); SEL_QLOAD(qfn, cwn, t0n); }
    {
        const int q = wave, t = t0 + q, nch = nk >> 6;
        LAS unsigned* hq = hist + q * 512;
        LAS unsigned short* sq = scores + q * 4096;
        unsigned bstar, krem, cbin;
        {
            unsigned ps = 0u;
#pragma unroll
            for (int r = 0; r < 4; ++r) { const v4u a = *(LAS v4u*)(hq + 4096 * r + 8 * lane), c = *(LAS v4u*)(hq + 4096 * r + 8 * lane + 4);
                ps += ((a.x + a.y) + (a.z + a.w)) + ((c.x + c.y) + (c.z + c.w)); }
            const unsigned T = (ps & 0xffffu) + (ps >> 16);
            const unsigned above = suffix_excl(T, lane);
            const int src = (int)__builtin_ctzll(__ballot(above < 256u && above + T >= 256u));
            const unsigned aboveS = (unsigned)__builtin_amdgcn_readlane((int)above, src);
            unsigned cb = 0u;
            if (lane < 16) {
#pragma unroll
                for (int r = 0; r < 4; ++r) cb += (unsigned)((const LAS unsigned short*)(hq + 4096 * r))[16 * src + lane]; }
            const unsigned above2 = aboveS + suffix_excl(cb, lane);
            const int is = (int)__builtin_ctzll(__ballot(lane < 16 && above2 < 256u && above2 + cb >= 256u));
            bstar = 16u * (unsigned)src + (unsigned)is; krem = 256u - (unsigned)__builtin_amdgcn_readlane((int)above2, is); cbin = (unsigned)__builtin_amdgcn_readlane((int)cb, is);
        }
        const unsigned long long lt = (1ull << lane) - 1ull;
        LAS unsigned* klist = (LAS unsigned*)(C.lds + CL_OFF) + wave * 512;
        LAS unsigned* whist = klist + 256;
        LAS unsigned short* ilist = (LAS unsigned short*)(C.lds + ILIST_OFF) + wave * 256;
        LAS unsigned long long* mwords = (LAS unsigned long long*)(C.lds + MW_OFF) + wave * 64;
        if (cbin <= SEL_FAST_MAX) {
            unsigned cbase = 0;
            unsigned wlo = 0u, whi = 0u;
            for (int c0 = 0; c0 < nch; c0 += 4) {
                unsigned key4[4]; unsigned long long wp4[4];
#pragma unroll
                for (int u = 0; u < 4; ++u) key4[u] = (unsigned)sq[64 * (c0 + u) + lperm];
#pragma unroll
                for (int u = 0; u < 4; ++u) { const unsigned bin = key4[u] >> 6; const unsigned long long wa = __ballot(bin > bstar); wp4[u] = (c0 + u < nch) ? __ballot(bin == bstar) : 0ull;
                    if (lane == c0 + u) { wlo = (unsigned)wa; whi = (unsigned)(wa >> 32); } }
                if ((wp4[0] | wp4[1]) | (wp4[2] | wp4[3])) {
#pragma unroll
                    for (int u = 0; u < 4; ++u) if (wp4[u]) { const unsigned pos = cbase + (unsigned)__builtin_popcountll(wp4[u] & lt);
                        if ((key4[u] >> 6) == bstar) { klist[pos] = key4[u]; ilist[pos] = (unsigned short)(64 * (c0 + u) + lperm); }
                        cbase += (unsigned)__builtin_popcountll(wp4[u]); } } }
            mwords[lane] = ((unsigned long long)whi << 32) | wlo;
            const int ncc = (int)((cbase + 63u) >> 6);
            if (cbase <= SEL_RANK_MAX) {
                const bool valid = (unsigned)lane < cbase;
                const unsigned key = valid ? klist[lane] : 0u; const unsigned idx = valid ? (unsigned)ilist[lane] : 0u;
                unsigned rank = 0;
                for (int jj = 0; jj < (int)cbase; ++jj) { const unsigned kj = (unsigned)__builtin_amdgcn_readlane((int)key, jj); rank += (kj > key || (kj == key && jj < lane)) ? 1u : 0u; }
                if (valid && rank < krem) __hip_atomic_fetch_or((LAS unsigned*)mwords + (idx >> 5), 1u << (((idx & 31u) >> 1) + 16u * (idx & 1u)), __ATOMIC_RELAXED, __HIP_MEMORY_SCOPE_WORKGROUP);
            } else {
                *(LAS unsigned*)(whist + lane) = z0;
                for (int k = 0; k < ncc; ++k) { const unsigned i = 64u * k + lane; if (i < cbase) __hip_atomic_fetch_add(whist + (klist[i] & 63u), 1u, __ATOMIC_RELAXED, __HIP_MEMORY_SCOPE_WORKGROUP); }
                const unsigned T = whist[lane];
                const unsigned above = suffix_excl(T, lane);
                const int ds = (int)__builtin_ctzll(__ballot(above < krem && above + T >= krem));
                const unsigned krem2 = krem - (unsigned)__builtin_amdgcn_readlane((int)above, ds);
                const unsigned tau = (bstar << 6) | (unsigned)ds;
                unsigned taken = 0;
                for (int k = 0; k < ncc; ++k) { const unsigned i = 64u * k + lane; const bool valid = i < cbase;
                    const unsigned key = valid ? klist[i] : 0u; const unsigned idx = valid ? (unsigned)ilist[i] : 0u;
                    const bool eq = valid && key == tau; const unsigned long long beq = __ballot(eq);
                    const bool sel = valid && (key > tau || (eq && taken + (unsigned)__builtin_popcountll(beq & lt) < krem2));
                    taken += (unsigned)__builtin_popcountll(beq);
                    if (sel) __hip_atomic_fetch_or((LAS unsigned*)mwords + (idx >> 5), 1u << (((idx & 31u) >> 1) + 16u * (idx & 1u)), __ATOMIC_RELAXED, __HIP_MEMORY_SCOPE_WORKGROUP); }
            }
            if (lane < nch) mask[(rowb + t) * 64 + lane] = mwords[lane];
        } else {
            *(LAS unsigned*)(whist + lane) = z0;
            for (int c = 0; c < nch; ++c) { const unsigned key = (unsigned)sq[64 * c + lperm]; if ((key >> 6) == bstar) __hip_atomic_fetch_add(whist + (key & 63u), 1u, __ATOMIC_RELAXED, __HIP_MEMORY_SCOPE_WORKGROUP); }
            const unsigned T = whist[lane];
            const unsigned above = suffix_excl(T, lane);
            const int ds = (int)__builtin_ctzll(__ballot(above < krem && above + T >= krem));
            const unsigned krem2 = krem - (unsigned)__builtin_amdgcn_readlane((int)above, ds);
            const unsigned tau = (bstar << 6) | (unsigned)ds;
            unsigned long long myword = 0ull; unsigned taken = 0;
            for (int c = 0; c < nch; ++c) { const unsigned key = (unsigned)sq[64 * c + lperm];
                const bool eq = key == tau; const unsigned long long beq = __ballot(eq);
                const bool sel = key > tau || (eq && taken + (unsigned)__builtin_popcountll(beq & lt) < krem2);
                taken += (unsigned)__builtin_popcountll(beq);
                const unsigned long long w = __ballot(sel);
                if (lane == c) myword = w; }
            if (lane < nch) mask[(rowb + t) * 64 + lane] = myword;
        }
    }
    { LAS unsigned* hq = hist + wave * 512;
#pragma unroll
      for (int r = 0; r < 4; ++r) { *(LAS v4u*)(hq + 4096 * r + 8 * lane) = zero4; *(LAS v4u*)(hq + 4096 * r + 8 * lane + 4) = zero4; } }
    lds_barrier();
#pragma unroll
    for (int kk = 0; kk < 4; ++kk) { qf[kk] = qfn[kk]; cw[kk] = cwn[kk]; }
    }
#undef SEL_QLOAD
}

constexpr int AT_STAGE = 16384;
struct AttnArgs { const bf16* projA; const bf16* VT; const unsigned long long* mask; bf16* Y; int qcol, kcol, vrow; float lam, oscale; const float* subg; };
template <int MODE, int TPS, bool FAST>
DI void attn_unit(const Ctx& C, const AttnArgs& A, int b, int h, int qb) {
    LAS unsigned char* lds = C.lds;
    int tid_ = C.wave * 64 + lane_id_now(); asm volatile("" : "+v"(tid_));
    const int tid = tid_, lane = tid & 63, wave = __builtin_amdgcn_readfirstlane(tid >> 6), hi = lane >> 5, l31 = lane & 31;
    const size_t rowb = (size_t)b * SEQ; const int q0 = qb * 256, qw0 = q0 + 32 * wave, tq = qw0 + l31;
    const int nkt = (q0 + 256) >> 6;
    const int sk = tid >> 3, sp = tid & 7;
    const bf16* kg = A.projA + (rowb + sk) * 2048 + A.kcol + h * 64 + 8 * sp;
    const bf16* vg = A.VT + (size_t)(A.vrow + h * 64 + sk) * MROWS + rowb + 8 * sp;
    const int kdst = ((sk >> 5) * 8 + sp) * 512 + ((pi32(sk & 31) ^ sp) * 16);
    const int vdst = 8192 + ((sk >> 5) * 8 + sp) * 512 + (((sk & 31) ^ sp) * 16);
    bf16x8 qf[4];
    { const bf16* qp = A.projA + (rowb + tq) * 2048 + A.qcol + h * 64 + 8 * hi;
#pragma unroll
      for (int kk = 0; kk < 4; ++kk) qf[kk] = *(const bf16x8*)(qp + 16 * kk); }
    constexpr int NC = MODE == 1 ? 2 : 1;
    f32x16 O[NC][2], negm[MODE == 0 ? 1 : 1]; float mref[NC], lsum[NC];
    negm[0] = f32x16{};
#pragma unroll
    for (int c = 0; c < NC; ++c) { O[c][0] = f32x16{}; O[c][1] = f32x16{}; mref[c] = 0.f; lsum[c] = 0.f; }
    {
#pragma unroll
      for (int tt = 0; tt < TPS; ++tt) { const v4u kr = *(const GAS v4u*)(kg + (size_t)(tt * 64) * 2048), vr = *(const GAS v4u*)(vg + tt * 64);
        *(LAS v4u*)(lds + tt * AT_STAGE + kdst) = kr; *(LAS v4u*)(lds + tt * AT_STAGE + vdst) = vr; } }
    unsigned long long mw[TPS];
#pragma unroll
    for (int tt = 0; tt < TPS; ++tt) mw[tt] = 0ull;
    constexpr int MB_OFF = 98304;
    const int mqi = tid >> 2, mpc = tid & 3;
    const unsigned long long* mgp = (MODE == 0) ? A.mask + (rowb + q0 + mqi) * 64 + 2 * mpc : nullptr;
    if (MODE == 0) { const v4u a0 = *(const GAS v4u*)(mgp), a1 = *(const GAS v4u*)(mgp + 128 * 64);
        LAS unsigned long long* mb = (LAS unsigned long long*)(lds + MB_OFF);
        mb[(2 * mpc) * 256 + mqi] = ((unsigned long long)a0.y << 32) | a0.x; mb[(2 * mpc + 1) * 256 + mqi] = ((unsigned long long)a0.w << 32) | a0.z;
        mb[(2 * mpc) * 256 + mqi + 128] = ((unsigned long long)a1.y << 32) | a1.x; mb[(2 * mpc + 1) * 256 + mqi + 128] = ((unsigned long long)a1.w << 32) | a1.z; }
    lds_barrier();
    const int nst = nkt / TPS;
    if (wave >= 4) __builtin_amdgcn_s_setprio(1);
    for (int s = 0; s < nst; ++s) {
        v4u kr[TPS], vr[TPS];
        const bool more = s + 1 < nst;
        if (more) {
#pragma unroll
            for (int tt = 0; tt < TPS; ++tt) { const int kvn = ((s + 1) * TPS + tt) * 64; kr[tt] = *(const GAS v4u*)(kg + (size_t)kvn * 2048); vr[tt] = *(const GAS v4u*)(vg + kvn);
                } }
        v4u ma0, ma1; const bool mload = (MODE == 0) && TPS == 1 && ((s & 7) == 0) && (8 * ((s >> 3) + 1) < nkt);
        if (mload) { ma0 = *(const GAS v4u*)(mgp + 8 * ((s >> 3) + 1)); ma1 = *(const GAS v4u*)(mgp + 128 * 64 + 8 * ((s >> 3) + 1)); }
        if (MODE == 0) {
#pragma unroll
            for (int tt = 0; tt < TPS; ++tt) { const int kt_ = s * TPS + tt; mw[tt] = *(const LAS unsigned long long*)(lds + MB_OFF + ((kt_ >> 3) & 1) * 16384 + ((kt_ & 7) * 256 + wave * 32 + l31) * 8); } }
#pragma unroll
        for (int tt = 0; tt < TPS; ++tt) {
        const int kt = s * TPS + tt;
        const int kv0 = kt * 64; LAS unsigned char* st = lds + ((s & 1) * TPS + tt) * AT_STAGE;
        if (kv0 <= qw0 + 31) {
            const bool diag = kv0 + 63 > qw0;
            if (MODE == 0 && FAST) {
                typedef short s16x2 __attribute__((ext_vector_type(2)));
                const unsigned long long sh = mw[tt] >> (4 * hi);
                const unsigned one2 = 0x3f803f80u; const v4u ow = {one2, one2, one2, one2}; const bf16x8 ones = __builtin_bit_cast(bf16x8, ow);
#pragma unroll
                for (int hh = 0; hh < 2; ++hh) {
                    f32x16 S; const unsigned mwd = hh ? (unsigned)(sh >> 32) : (unsigned)sh;
#pragma unroll
                    for (int kk = 0; kk < 4; ++kk) { const int pb = kk * 2 + hi;
                        const bf16x8 kfr = *(const LAS bf16x8*)(st + (hh * 8 + pb) * 512 + ((l31 ^ pb) * 16));
                        S = MFMA32(kfr, qf[kk], kk == 0 ? f32x16{} : S); }
#pragma unroll
                    for (int r = 0; r < 16; ++r) S[r] = fexp2(S[r]);
                    unsigned w[8];
#pragma unroll
                    for (int j = 0; j < 8; ++j) { const int cj = 8 * (j >> 2) + (j & 3);
                        const s16x2 m = (__builtin_bit_cast(s16x2, mwd) << (short)(15 - cj)) >> (short)15;
                        w[j] = cvtpk(S[2 * j], S[2 * j + 1]) & __builtin_bit_cast(unsigned, m); }
                    v4u wa = {w[0], w[1], w[2], w[3]}, wb = {w[4], w[5], w[6], w[7]};
                    const bf16x8 pfa = __builtin_bit_cast(bf16x8, wa), pfb = __builtin_bit_cast(bf16x8, wb);
                    negm[0] = MFMA32(ones, pfa, negm[0]); negm[0] = MFMA32(ones, pfb, negm[0]);
#pragma unroll
                    for (int dh = 0; dh < 2; ++dh)
#pragma unroll
                        for (int c2 = 0; c2 < 2; ++c2) { const int pb = (2 * hh + c2) * 2 + hi;
                            const bf16x8 vf = *(const LAS bf16x8*)(st + 8192 + (dh * 8 + pb) * 512 + ((l31 ^ pb) * 16));
                            O[0][dh] = MFMA32(vf, c2 ? pfb : pfa, O[0][dh]); }
                }
            } else
#pragma unroll
            for (int c = 0; c < NC; ++c) {
                f32x16 S0, S1;
                if (MODE == 0) {
#pragma unroll
                    for (int kk = 0; kk < 4; ++kk) { const int pb = kk * 2 + hi;
                        const bf16x8 k0 = *(const LAS bf16x8*)(st + (0 * 8 + pb) * 512 + ((l31 ^ pb) * 16)), k1 = *(const LAS bf16x8*)(st + (1 * 8 + pb) * 512 + ((l31 ^ pb) * 16));
                        S0 = MFMA32(k0, qf[kk], kk == 0 ? (FAST ? f32x16{} : negm[0]) : S0); S1 = MFMA32(k1, qf[kk], kk == 0 ? (FAST ? f32x16{} : negm[0]) : S1); }
                } else {
#pragma unroll
                    for (int k2 = 0; k2 < 2; ++k2) { const int kk = 2 * c + k2, pb = kk * 2 + hi;
                        const bf16x8 k0 = *(const LAS bf16x8*)(st + (0 * 8 + pb) * 512 + ((l31 ^ pb) * 16)), k1 = *(const LAS bf16x8*)(st + (1 * 8 + pb) * 512 + ((l31 ^ pb) * 16));
                        S0 = MFMA32(k0, qf[kk], k2 == 0 ? f32x16{} : S0); S1 = MFMA32(k1, qf[kk], k2 == 0 ? f32x16{} : S1); }
                }
                if (MODE == 1 && diag) {
                    const int kb = kv0 + 8 * hi;
#pragma unroll
                    for (int r = 0; r < 16; ++r) { const int key = kb + 16 * (r >> 3) + (r & 7);
                        if (key > tq) S0[r] = -INFINITY; if (key + 32 > tq) S1[r] = -INFINITY; }
                }
                if (!FAST) {
                float mxa = fmaxf(fmaxf(S0[0], S0[1]), S1[0]), mxb = fmaxf(fmaxf(S0[2], S0[3]), S1[1]);
                mxa = fmaxf(fmaxf(mxa, S1[2]), S1[3]);
#pragma unroll
                for (int r = 4; r < 16; r += 4) { mxa = fmaxf(fmaxf(mxa, S0[r]), S0[r + 1]); mxb = fmaxf(fmaxf(mxb, S0[r + 2]), S0[r + 3]); mxa = fmaxf(fmaxf(mxa, S1[r]), S1[r + 1]); mxb = fmaxf(fmaxf(mxb, S1[r + 2]), S1[r + 3]); }
                const float mx = swapmax(fmaxf(mxa, mxb)) - (MODE == 1 ? mref[c] : 0.f);
                if (kt == 0 || __any(mx > 8.0f)) {
                    const float dl = (kt == 0) ? mx : fmaxf(mx, 0.f); const float alpha = fexp2(-dl);
                    mref[c] += dl; lsum[c] *= alpha;
#pragma unroll
                    for (int r = 0; r < 16; ++r) { O[c][0][r] *= alpha; O[c][1][r] *= alpha; }
                    if (MODE == 0) {
#pragma unroll
                        for (int r = 0; r < 16; ++r) { S0[r] -= dl; S1[r] -= dl; negm[0][r] = -mref[c]; } }
                }
                }
                if (MODE == 0 || FAST) {
#pragma unroll
                    for (int r = 0; r < 16; ++r) { S0[r] = fexp2(S0[r]); S1[r] = fexp2(S1[r]); }
                } else {
#pragma unroll
                    for (int r = 0; r < 16; ++r) { S0[r] = fexp2(S0[r] - mref[c]); S1[r] = fexp2(S1[r] - mref[c]); }
                }
                bf16x8 pf[4];
                if (MODE == 0 && FAST) {
                    typedef short s16x2 __attribute__((ext_vector_type(2)));
                    const unsigned long long sh = mw[tt] >> (4 * hi); const unsigned lo = (unsigned)sh, hw = (unsigned)(sh >> 32);
                    unsigned w0[8], w1[8];
#pragma unroll
                    for (int j = 0; j < 8; ++j) { const int cj = 8 * (j >> 2) + (j & 3);
                        const s16x2 m0 = (__builtin_bit_cast(s16x2, lo) << (short)(15 - cj)) >> (short)15, m1 = (__builtin_bit_cast(s16x2, hw) << (short)(15 - cj)) >> (short)15;
                        w0[j] = cvtpk(S0[2 * j], S0[2 * j + 1]) & __builtin_bit_cast(unsigned, m0); w1[j] = cvtpk(S1[2 * j], S1[2 * j + 1]) & __builtin_bit_cast(unsigned, m1); }
                    { v4u w; w = (v4u){w0[0], w0[1], w0[2], w0[3]}; pf[0] = __builtin_bit_cast(bf16x8, w); w = (v4u){w0[4], w0[5], w0[6], w0[7]}; pf[1] = __builtin_bit_cast(bf16x8, w);
                      w = (v4u){w1[0], w1[1], w1[2], w1[3]}; pf[2] = __builtin_bit_cast(bf16x8, w); w = (v4u){w1[4], w1[5], w1[6], w1[7]}; pf[3] = __builtin_bit_cast(bf16x8, w); }
                    const unsigned one2 = 0x3f803f80u; const v4u ow = {one2, one2, one2, one2}; const bf16x8 ones = __builtin_bit_cast(bf16x8, ow);
#pragma unroll
                    for (int cc = 0; cc < 4; ++cc) negm[0] = MFMA32(ones, pf[cc], negm[0]);
                } else {
                if (MODE == 0) {
                    const unsigned long long sh = mw[tt] >> (4 * hi); const int lo = (int)(unsigned)sh, hw = (int)(unsigned)(sh >> 32);
#pragma unroll
                    for (int r = 0; r < 16; ++r) { const int pos = 8 * (r >> 3) + ((r & 7) >> 1) + 16 * (r & 1);
                        S0[r] = __uint_as_float(__float_as_uint(S0[r]) & (unsigned)__builtin_amdgcn_sbfe(lo, pos, 1));
                        S1[r] = __uint_as_float(__float_as_uint(S1[r]) & (unsigned)__builtin_amdgcn_sbfe(hw, pos, 1)); }
                }
                float lsa = 0.f, lsb = 0.f;
#pragma unroll
                for (int r = 0; r < 16; r += 2) { lsa += S0[r] + S1[r]; lsb += S0[r + 1] + S1[r + 1]; }
                lsum[c] += lsa + lsb;
                { v4u w;
                  w = (v4u){cvtpk(S0[0], S0[1]), cvtpk(S0[2], S0[3]), cvtpk(S0[4], S0[5]), cvtpk(S0[6], S0[7])};     pf[0] = __builtin_bit_cast(bf16x8, w);
                  w = (v4u){cvtpk(S0[8], S0[9]), cvtpk(S0[10], S0[11]), cvtpk(S0[12], S0[13]), cvtpk(S0[14], S0[15])}; pf[1] = __builtin_bit_cast(bf16x8, w);
                  w = (v4u){cvtpk(S1[0], S1[1]), cvtpk(S1[2], S1[3]), cvtpk(S1[4], S1[5]), cvtpk(S1[6], S1[7])};     pf[2] = __builtin_bit_cast(bf16x8, w);
                  w = (v4u){cvtpk(S1[8], S1[9]), cvtpk(S1[10], S1[11]), cvtpk(S1[12], S1[13]), cvtpk(S1[14], S1[15])}; pf[3] = __builtin_bit_cast(bf16x8, w); }
                }
#pragma unroll
                for (int dh = 0; dh < 2; ++dh)
#pragma unroll
                    for (int cc = 0; cc < 4; ++cc) { const int pb = cc * 2 + hi;
                        const bf16x8 vf = *(const LAS bf16x8*)(st + 8192 + (dh * 8 + pb) * 512 + ((l31 ^ pb) * 16));
                        O[c][dh] = MFMA32(vf, pf[cc], O[c][dh]); }
            }
        }
        }
        if (more) {
#pragma unroll
            for (int tt = 0; tt < TPS; ++tt) { LAS unsigned char* sn = lds + (((s + 1) & 1) * TPS + tt) * AT_STAGE; *(LAS v4u*)(sn + kdst) = kr[tt]; *(LAS v4u*)(sn + vdst) = vr[tt]; } }
        if (mload) { LAS unsigned long long* mb = (LAS unsigned long long*)(lds + MB_OFF + (((s >> 3) + 1) & 1) * 16384);
            mb[(2 * mpc) * 256 + mqi] = ((unsigned long long)ma0.y << 32) | ma0.x; mb[(2 * mpc + 1) * 256 + mqi] = ((unsigned long long)ma0.w << 32) | ma0.z;
            mb[(2 * mpc) * 256 + mqi + 128] = ((unsigned long long)ma1.y << 32) | ma1.x; mb[(2 * mpc + 1) * 256 + mqi + 128] = ((unsigned long long)ma1.w << 32) | ma1.z; }
        lds_barrier();
    }
    __builtin_amdgcn_s_setprio(0);
    bf16* yp = A.Y + (rowb + tq) * 768 + h * 64 + 4 * hi;
    if (MODE == 0) {
        const float inv = 1.0f / (FAST ? negm[0][0] : swapsum(lsum[0]));
#pragma unroll
        for (int dh = 0; dh < 2; ++dh)
#pragma unroll
            for (int g4 = 0; g4 < 4; ++g4) { const f32x16& o = O[0][dh];
                *(u32x2*)(yp + 32 * dh + 8 * g4) = (u32x2){cvtpk(o[4 * g4] * inv, o[4 * g4 + 1] * inv), cvtpk(o[4 * g4 + 2] * inv, o[4 * g4 + 3] * inv)}; }
    } else {
        const float i1 = 1.0f / swapsum(lsum[0]), i2 = A.lam / swapsum(lsum[NC - 1]);
        float ss = 0.f;
#pragma unroll
        for (int dh = 0; dh < 2; ++dh)
#pragma unroll
            for (int r = 0; r < 16; ++r) { const float v = O[0][dh][r] * i1 - O[NC - 1][dh][r] * i2; O[0][dh][r] = v; ss += v * v; }
        ss = swapsum(ss);
        const float rstd = A.oscale / sqrtf(ss * (1.0f / 64.0f) + EPS);
#pragma unroll
        for (int dh = 0; dh < 2; ++dh)
#pragma unroll
            for (int g4 = 0; g4 < 4; ++g4) { const f32x16& o = O[0][dh]; const f32x4 gg = *(const f32x4*)(A.subg + 32 * dh + 8 * g4 + 4 * hi);
                *(u32x2*)(yp + 32 * dh + 8 * g4) = (u32x2){cvtpk(o[4 * g4] * rstd * gg[0], o[4 * g4 + 1] * rstd * gg[1]), cvtpk(o[4 * g4 + 2] * rstd * gg[2], o[4 * g4 + 3] * rstd * gg[3])}; }
    }
}

DI void sgu_unit(const Ctx& C, int b, int chunk, const bf16* projA, const bf16* Ws, const float* lng, const float* lnb, const float* bs, bf16* Yb) {
    LAS unsigned char* lds = C.lds;
    int tid_ = C.wave * 64 + lane_id_now(); asm volatile("" : "+v"(tid_));
    const int tid = tid_, lane = tid & 63, wave = __builtin_amdgcn_readfirstlane(tid >> 6), hi = lane >> 5, l31 = lane & 31;
    const size_t R0 = (size_t)b * SEQ + 128 * chunk;
    const int gw = wave >> 1, chh = wave & 1;
    bf16x8 bb[4][8]; u32x2 uw[4][4]; float bias[4];
#pragma unroll
    for (int i = 0; i < 4; ++i) { const int t = 32 * i + l31;
        const bf16* up = projA + (R0 + t) * 2048 + CB_U + 64 * gw + 32 * chh + 4 * hi;
#pragma unroll
        for (int g4 = 0; g4 < 4; ++g4) uw[i][g4] = *(const u32x2*)(up + 8 * g4);
        bias[i] = bs[gw * 128 + t]; }
    {
        const int pos = tid >> 2, g = tid & 3;
        const bf16* vp = projA + (R0 + pos) * 2048 + CB_V + 64 * g;
        float x[64]; float s = 0.f;
#pragma unroll
        for (int j = 0; j < 8; ++j) { const v4u w = *(const GAS v4u*)(vp + 8 * j);
            x[8 * j + 0] = gelu_tanh(blo(w.x)); x[8 * j + 1] = gelu_tanh(bhi(w.x)); x[8 * j + 2] = gelu_tanh(blo(w.y)); x[8 * j + 3] = gelu_tanh(bhi(w.y));
            x[8 * j + 4] = gelu_tanh(blo(w.z)); x[8 * j + 5] = gelu_tanh(bhi(w.z)); x[8 * j + 6] = gelu_tanh(blo(w.w)); x[8 * j + 7] = gelu_tanh(bhi(w.w)); }
#pragma unroll
        for (int i = 0; i < 64; ++i) s += x[i];
        s = quad_sum(s);
        const float mu = s * (1.0f / 256.0f); float q = 0.f;
#pragma unroll
        for (int i = 0; i < 64; ++i) { const float d = x[i] - mu; q += d * d; }
        q = quad_sum(q);
        const float rstd = 1.0f / sqrtf(q * (1.0f / 256.0f) + EPS);
        LAS bf16* dst = (LAS bf16*)lds;
        const int kb = pos >> 3;
#pragma unroll
        for (int i = 0; i < 64; ++i) { const float y = (x[i] - mu) * rstd * lng[64 * g + i] + lnb[64 * g + i];
            dst[(((g * 2 + (i >> 5)) * 16 + kb) * 32 + ((i & 31) ^ (kb & 7))) * 8 + (pos & 7)] = (bf16)(cvtpk(y, 0.f) & 0xffffu); }
    }
#pragma unroll
    for (int i = 0; i < 4; ++i) { const bf16* wp = Ws + ((size_t)gw * 128 + 32 * i + l31) * 128 + 8 * hi;
#pragma unroll
        for (int kk = 0; kk < 2 * i + 2; ++kk) bb[i][kk] = *(const bf16x8*)(wp + 16 * kk); }
    lds_barrier();
#pragma unroll
    for (int i = 0; i < 4; ++i) {
        const int t = 32 * i + l31;
        f32x16 acc = {};
#pragma unroll
        for (int kk = 0; kk < 2 * i + 2; ++kk) { const int kblk = 2 * kk + hi;
            const bf16x8 a = *(const LAS bf16x8*)(lds + (size_t)((((gw * 2 + chh) * 16 + kblk) * 32 + (l31 ^ (kblk & 7))) * 16));
            acc = MFMA32(a, bb[i][kk], acc); }
        bf16* yp = Yb + (R0 + t) * 768 + 64 * gw + 32 * chh + 4 * hi;
#pragma unroll
        for (int g4 = 0; g4 < 4; ++g4) {
            const float u0 = gelu_tanh(blo(uw[i][g4].x)), u1 = gelu_tanh(bhi(uw[i][g4].x)), u2 = gelu_tanh(blo(uw[i][g4].y)), u3 = gelu_tanh(bhi(uw[i][g4].y));
            *(u32x2*)(yp + 8 * g4) = (u32x2){cvtpk(u0 * (acc[4 * g4] + bias[i]), u1 * (acc[4 * g4 + 1] + bias[i])), cvtpk(u2 * (acc[4 * g4 + 2] + bias[i]), u3 * (acc[4 * g4 + 3] + bias[i]))}; }
    }
    lds_barrier();
}

struct Args { const float* in[19]; float* out; unsigned char* ws; };
__global__ void __launch_bounds__(NTHREADS, 2) mk_fwd(Args args) {
    extern __shared__ __attribute__((aligned(16))) unsigned char lds_raw[];
    if (gridDim.x != 256u) return;
    { const unsigned bx_ = blockIdx.x; __builtin_assume(bx_ < 256u); }
    Ctx C;
    C.lds = (LAS unsigned char*)lds_raw;
    C.tid = threadIdx.x; C.lane = C.tid & 63; C.wave = __builtin_amdgcn_readfirstlane(C.tid >> 6);
    C.G = gridDim.x; { const int bx = blockIdx.x; C.vcu = (C.G % 8 == 0) ? (bx % 8) * (C.G / 8) + bx / 8 : bx; }
    C.out = nullptr; C.ws = nullptr;
    typedef const __attribute__((address_space(4))) Args* KArgs;
#define KGET() KArgs K = (KArgs)__builtin_amdgcn_kernarg_segment_ptr(); asm volatile("" : "+s"(K))
#define IN(k) ((const float*)(const GAS float*)(K->in[k]))
#define OUTP ((float*)(GAS float*)(K->out))
    volatile LAS unsigned* MISC = (volatile LAS unsigned*)(C.lds + MISC_OFF);
    if (C.tid < 64) MISC[C.tid] = 0u;
    __syncthreads();
    XcdBarrier bar = xcd_barrier_post((unsigned*)(args.ws + WS_CTL) + CW_BAR, MISC + 8);
    if (threadIdx.x == 0) (void)xb_add((unsigned*)(args.ws + WS_CTL) + CW_GCN + 64 * ((blockIdx.x & 7u) * 16 + (bar.x & 15u)), 1u);
#define WSP(T, off) ((T*)(GAS T*)(K->ws + (off)))
#define Hb   WSP(bf16, WS_H)
#define PA   WSP(bf16, WS_PA)
#define PAB  (PA + (size_t)(C.vcu >> 5) * 8388608)
#define Gb   WSP(bf16, WS_ACT)
#define VTb  WSP(bf16, WS_VTA)
#define KIDX WSP(bf16, WS_KIDX)
#define MASK WSP(unsigned long long, WS_MASK)
#define Ya   WSP(bf16, WS_Y)
#define Yb   WSP(bf16, WS_Y + 512)
#define Yc   WSP(bf16, WS_Y + 1024)
#define MA   ((bf16*)OUTP)
#define ACT  WSP(bf16, WS_ACT)
#define H8   WSP(unsigned char, WS_H8)
#define XB   WSP(bf16, WS_XB)
#define RS   WSP(float, WS_RS)
#define NRM  (WSP(unsigned, WS_CTL) + CW_NRM + l * 512)
#define RLB  ((LAS float*)(C.lds + CL_OFF))
#define WL(off) ((const bf16*)(const GAS bf16*)(K->ws + WS_WL + (size_t)l * WL_STRIDE + (off)))

    { KGET();
      prologue_weights(C, (unsigned char*)(GAS unsigned char*)K->ws, IN(1), IN(15), IN(2), IN(7), IN(11), IN(12), IN(13), IN(14), IN(16), IN(17));
      prep_rows(C, IN(0), XB, H8, RS); }
    grid_bar(bar);

    unsigned gk = 0;
    unsigned gnloc; { unsigned v_ = xb_ld((unsigned*)(args.ws + WS_CTL) + CW_GCN + 64 * ((blockIdx.x & 7u) * 16 + (bar.x & 15u))); gnloc = (unsigned)__builtin_amdgcn_readfirstlane((int)v_); if (gnloc == 0u) gnloc = 1u; }
#pragma unroll 1
    for (int l = 0; l < DEPTH; ++l) {
        { KGET();
          pg8::Gemm g{XB, WL(WO_IN1), MROWS, NPROJ, DM}; pg8::RotOrder S; S.init(MROWS, NPROJ, C.G, (int)blockIdx.x);
          pg8::EpiProj E{PA, Gb, KIDX, IN(3) + l * 64, IN(4) + l * 64, RS, RLB, NRM};
          pg8::gemm_phase<pg8::EpiProj, pg8::RotOrder, true, true, 1024>(C.lds, g, S, E, pg8::NoHook(), C.wave); }
        { KGET();
          pg8::Gemm g{(const bf16*)H8, (const bf16*)(const GAS unsigned char*)(K->ws + WS_WG8 + (size_t)l * 3 * MiB), MROWS, 3072, 512}; pg8::StaticOrder S; S.init(MROWS, 3072, C.G, (int)blockIdx.x);
          pg8::EpiGates E{(unsigned char*)Gb, 1.0f / 32.0f, RS, RLB};
          pg8::gemm_phase<pg8::EpiGates, pg8::StaticOrder, true, false, 512, pg8::NoHook, true>(C.lds, g, S, E, pg8::NoHook(), C.wave); }
        { KGET();
          pg8::Gemm g{WL(WO_VT), XB, 512, MROWS, DM}; pg8::StaticOrder S; S.init(512, MROWS, C.G, (int)blockIdx.x);
          pg8::EpiVT E{VTb, MROWS, RS, RLB};
          pg8::gemm_phase<pg8::EpiVT, pg8::StaticOrder, true, true, 1024>(C.lds, g, S, E, pg8::NoHook(), C.wave); }
        group_bar(bar, ++gk, gnloc);
        { KGET(); select_phase(C, C.vcu >> 5, C.vcu & 31, PAB, KIDX, MASK); lds_barrier(); }
        { KGET(); sgu_unit(C, C.vcu >> 5, C.vcu & 31, PAB, WL(WO_S), IN(5) + l * 256, IN(6) + l * 256, IN(8) + l * 512, Yb); }
        { KGET();
          const float* lq = IN(9) + l * 128;
          const int ln = lane_id_now();
          float d1 = (ln < 32) ? lq[ln] * lq[32 + ln] : 0.f, d2 = (ln < 32) ? lq[64 + ln] * lq[96 + ln] : 0.f;
          d1 = wave_sum(d1); d2 = wave_sum(d2);
          const float lam_init = 0.8f - 0.6f * expf(-0.3f * (float)l);
          const float lam = expf(d1) - expf(d2) + lam_init;
          AttnArgs A{PAB, VTb, nullptr, Yc, CC_Q, CC_K, 256, lam, 1.0f - lam_init, IN(10) + l * 64};
          const int bh = C.vcu >> 3, s8 = C.vcu & 7;
          const unsigned* nr = NRM + (bh >> 2) * 64 + 2 * (bh & 3);
          const float b2 = fmaxf(__uint_as_float(nr[48]) * __uint_as_float(nr[56]), __uint_as_float(nr[49]) * __uint_as_float(nr[57])) * 1.03f;
          if (b2 <= 2500.0f) {
#pragma unroll 1
              for (int j = 0; j < 2; ++j) attn_unit<1, 1, true>(C, A, bh >> 2, bh & 3, j ? 15 - s8 : s8);
          } else {
#pragma unroll 1
              for (int j = 0; j < 2; ++j) attn_unit<1, 1, false>(C, A, bh >> 2, bh & 3, j ? 15 - s8 : s8); } }
        group_bar(bar, ++gk, gnloc);
        { KGET();
          AttnArgs A{PAB, VTb, MASK, Ya, CA_Q, CA_K, 0, 0.f, 1.f, nullptr};
          const int bh = C.vcu >> 3, s8 = C.vcu & 7;
          const unsigned* nr = NRM + (bh >> 2) * 64 + 2 * (bh & 3);
          const float b2 = (__uint_as_float(nr[0]) + __uint_as_float(nr[1])) * (__uint_as_float(nr[8]) + __uint_as_float(nr[9])) * 1.03f;
          if (b2 <= 2500.0f) {
#pragma unroll 1
              for (int j = 0; j < 2; ++j) attn_unit<0, 1, true>(C, A, bh >> 2, bh & 3, j ? 15 - s8 : s8);
          } else {
#pragma unroll 1
              for (int j = 0; j < 2; ++j) attn_unit<0, 1, false>(C, A, bh >> 2, bh & 3, j ? 15 - s8 : s8); } }
        group_bar(bar, ++gk, gnloc);
        { KGET();
          pg8::Gemm g{Ya, WL(WO_B), MROWS, DM, 768}; pg8::StaticOrder S; S.init(MROWS, DM, C.G, (int)blockIdx.x);
          pg8::EpiGateC E{(const unsigned char*)Gb, MA}; pg8::HookGate H{(const unsigned char*)Gb};
          pg8::gemm_phase<pg8::EpiGateC, pg8::StaticOrder, true, true, 768, pg8::HookGate>(C.lds, g, S, E, H, C.wave); }
        group_bar(bar, ++gk, gnloc);
        { KGET();
          pg8::Gemm g{MA, WL(WO_O), MROWS, DM, DM}; pg8::StaticOrder S; S.init(MROWS, DM, C.G, (int)blockIdx.x);
          pg8::EpiResid E{(l == 0) ? IN(0) : (const float*)nullptr, XB, XB, RS, nullptr};
          pg8::gemm_phase<pg8::EpiResid, pg8::StaticOrder, true, true, 1024>(C.lds, g, S, E, pg8::NoHook(), C.wave); }
        group_bar(bar, ++gk, gnloc);
        { KGET();
          pg8::Gemm g{XB, WL(WO_F1), MROWS, FF, DM}; pg8::StaticOrder S; S.init(MROWS, FF, C.G, (int)blockIdx.x);
          pg8::EpiAct<1> E{ACT, FF, RS, RLB};
          pg8::gemm_phase<pg8::EpiAct<1>, pg8::StaticOrder, true, true, 1024>(C.lds, g, S, E, pg8::NoHook(), C.wave); }
        group_bar(bar, ++gk, gnloc);
        { KGET();
          pg8::Gemm g{ACT, WL(WO_F2), MROWS, DM, FF}; pg8::StaticOrder S; S.init(MROWS, DM, C.G, (int)blockIdx.x);
          pg8::EpiResid E{nullptr, XB, XB, RS, (l + 1 < DEPTH) ? H8 : (unsigned char*)nullptr};
          pg8::gemm_phase<pg8::EpiResid, pg8::StaticOrder, true, true, 4096>(C.lds, g, S, E, pg8::NoHook(), C.wave); }
        if (l + 1 < DEPTH) group_bar(bar, ++gk, gnloc); else grid_bar(bar);
        if (l + 1 == DEPTH) { KGET(); rmsnorm_rows(C, nullptr, IN(18), nullptr, OUTP, nullptr, XB); }
    }
}

extern "C" void kernel_launch(void* const* d_in, const int* in_sizes, int n_in, void* d_out, int out_size, void* d_ws, size_t ws_size, hipStream_t stream) {
    static int grid = 0;
    if (grid == 0) {
        if (n_in != 19 || in_sizes[0] != MROWS * DM || out_size != MROWS * DM || ws_size < WS_END) { fprintf(stderr, "kernel_launch: unexpected shapes / workspace (n_in %d, ws %zu)\n", n_in, ws_size); grid = -1; return; }
        int dev = 0, cus = 0, per_cu = 0;
        if (hipGetDevice(&dev) != hipSuccess || hipDeviceGetAttribute(&cus, hipDeviceAttributeMultiprocessorCount, dev) != hipSuccess) { grid = -1; return; }
        if (hipFuncSetAttribute((const void*)mk_fwd, hipFuncAttributeMaxDynamicSharedMemorySize, LDS_BYTES) != hipSuccess) { fprintf(stderr, "kernel_launch: hipFuncSetAttribute failed\n"); grid = -1; return; }
        if (hipOccupancyMaxActiveBlocksPerMultiprocessor(&per_cu, (const void*)mk_fwd, NTHREADS, LDS_BYTES) != hipSuccess || per_cu < 1) fprintf(stderr, "kernel_launch: occupancy query says %d\n", per_cu);
        (void)hipGetLastError();
        grid = cus;
    }
    if (grid < 0) return;
    if (hipMemsetAsync((char*)d_ws + WS_CTL, 0, CTL_ZERO_BYTES, stream) != hipSuccess) return;
    Args a{};
    for (int i = 0; i < 19; ++i) a.in[i] = (const float*)d_in[i];
    a.out = (float*)d_out; a.ws = (unsigned char*)d_ws;
    hipLaunchKernelGGL(mk_fwd, dim3(grid), dim3(NTHREADS), LDS_BYTES, stream, a);
}
```
